# Optimizing an MI355X kernel written in HIP

```python
import math
import jax, jax.numpy as jnp
from jax import lax
import numpy as np

D_MODEL = 1024
BATCH = 2
SEQ = 8192
DEPTH = 4

DEEPNORM_ALPHA = (2 * DEPTH) ** 0.25
DEEPNORM_BETA = (8 * DEPTH) ** -0.25
LN_EPS = 1e-5
N_BRANCHES = 3

SSD_INNER = 2 * D_MODEL
SSD_HEAD_DIM = 64
SSD_HEADS = SSD_INNER // SSD_HEAD_DIM
SSD_GROUPS = 8
SSD_HPG = SSD_HEADS // SSD_GROUPS
SSD_STATE = 128
SSD_CONV = 5
SSD_CHUNK = 128
SSD_CONV_CH = SSD_INNER + 2 * SSD_GROUPS * SSD_STATE

ATT_HEAD_DIM = 64
ATT_PATTERNS = ((128, 1), (512, 4), (2048, 16))
ATT_GROUPS = len(ATT_PATTERNS)
ATT_HPG = 6
ATT_HEADS = ATT_GROUPS * ATT_HPG
ATT_WIDTH = ATT_HEADS * ATT_HEAD_DIM
ATT_OUT = ATT_HPG * ATT_HEAD_DIM
ATT_NEG = -1e30

S5_CH = 16
S5_STATE = 64
S5_WIDTH = 9 * D_MODEL // 8
S5_GROUPS = S5_WIDTH // S5_CH

IN_SIZES = (N_BRANCHES * D_MODEL, SSD_INNER, SSD_CONV_CH, 2 * SSD_HEADS, 3 * ATT_WIDTH, S5_WIDTH)
N_IN = sum(IN_SIZES)

MOE_EXPERTS = 32
MOE_TOP_K = 4
MOE_FF = D_MODEL
SWIGLU_LIMIT = 7.0
SWIGLU_ALPHA = 1.702
MOE_BLOCK = 128

kernel_name = "hybrid_ssd_dilattn_s5_moe_deepnorm"


def layer_norm(x, g, b):
    xf = x.astype(jnp.float32)
    mu = jnp.mean(xf, axis=-1, keepdims=True)
    var = jnp.mean(jnp.square(xf - mu), axis=-1, keepdims=True)
    return ((xf - mu) * lax.rsqrt(var + LN_EPS)).astype(x.dtype) * g + b


def rms_norm(x, w):
    xf = x.astype(jnp.float32)
    return (xf * lax.rsqrt(jnp.mean(xf * xf, axis=-1, keepdims=True) + LN_EPS)).astype(x.dtype) * w


def split_columns(proj):
    idx, acc = [], 0
    for s in IN_SIZES[:-1]:
        acc += s
        idx.append(acc)
    return jnp.split(proj, idx, axis=-1)


def centred_dwconv(x, w, b):
    k_taps = w.shape[0]
    half = k_taps // 2
    seqlen = x.shape[1]
    xp = jnp.pad(x, ((0, 0), (half, half), (0, 0)))
    out = b + w[0] * xp[:, 0:seqlen]
    for k in range(1, k_taps):
        out = out + w[k] * xp[:, k:k + seqlen]
    return out


def ssd_chunked(xin, a_dt, bm, cm):
    bsz, seqlen, ng, nr, hd = xin.shape
    nc = seqlen // SSD_CHUNK
    xc = xin.reshape(bsz, nc, SSD_CHUNK, ng, nr, hd)
    bc = bm.reshape(bsz, nc, SSD_CHUNK, ng, SSD_STATE)
    cc = cm.reshape(bsz, nc, SSD_CHUNK, ng, SSD_STATE)
    acs = jnp.cumsum(a_dt.astype(jnp.float32).reshape(bsz, nc, SSD_CHUNK, ng, nr).transpose(0, 3, 4, 1, 2), axis=-1)
    tri = jnp.tril(jnp.ones((SSD_CHUNK, SSD_CHUNK), bool))
    seg = acs[..., :, None] - acs[..., None, :]
    decay_in = jnp.where(tri, jnp.exp(jnp.where(tri, seg, 0.0)), 0.0)
    cb = jnp.einsum('bclgn,bcsgn->bgcls', cc, bc)
    y_diag = jnp.einsum('bgcls,bgrcls,bcsgrp->bclgrp', cb, decay_in, xc)
    decay_to_end = jnp.exp(acs[..., -1:] - acs)
    states = jnp.einsum('bclgn,bgrcl,bclgrp->bcgrpn', bc, decay_to_end, xc)
    totals = jnp.pad(acs[..., -1], ((0, 0), (0, 0), (0, 0), (1, 0)))
    tcs = jnp.cumsum(totals, axis=-1)
    tri_c = jnp.tril(jnp.ones((nc + 1, nc + 1), bool))
    seg_c = tcs[..., :, None] - tcs[..., None, :]
    decay_chunks = jnp.where(tri_c, jnp.exp(jnp.where(tri_c, seg_c, 0.0)), 0.0)
    states = jnp.pad(states, ((0, 0), (1, 0), (0, 0), (0, 0), (0, 0), (0, 0)))
    carried = jnp.einsum('bgrzc,bcgrpn->bzgrpn', decay_chunks, states)[:, :-1]
    y_off = jnp.einsum('bclgn,bcgrpn,bgrcl->bclgrp', cc, carried, jnp.exp(acs))
    return (y_diag + y_off).reshape(bsz, seqlen, ng, nr, hd)


def ssd_branch(z, xbc, dt, conv_w, conv_b, a_log, dt_bias, d_skip, norm_w):
    bsz, seqlen, _ = z.shape
    xbc = jax.nn.silu(centred_dwconv(xbc, conv_w, conv_b))
    xs, bm, cm = jnp.split(xbc, [SSD_INNER, SSD_INNER + SSD_GROUPS * SSD_STATE], axis=-1)
    xs = xs.reshape(bsz, seqlen, SSD_GROUPS, SSD_HPG, SSD_HEAD_DIM)
    bm = bm.reshape(bsz, seqlen, SSD_GROUPS, SSD_STATE)
    cm = cm.reshape(bsz, seqlen, SSD_GROUPS, SSD_STATE)
    dt = dt.astype(jnp.float32).reshape(bsz, seqlen, 2, SSD_GROUPS, SSD_HPG)
    y = d_skip.reshape(SSD_GROUPS, SSD_HPG)[:, :, None] * xs
    for direction in range(2):
        delta = jax.nn.softplus(dt[:, :, direction] + dt_bias[direction].astype(jnp.float32).reshape(SSD_GROUPS, SSD_HPG))
        a_dt = -jnp.exp(a_log[direction].astype(jnp.float32).reshape(SSD_GROUPS, SSD_HPG)) * delta
        xin = xs * delta[..., None]
        if direction == 1:
            yd = jnp.flip(ssd_chunked(jnp.flip(xin, 1), jnp.flip(a_dt, 1), jnp.flip(bm, 1), jnp.flip(cm, 1)), 1)
        else:
            yd = ssd_chunked(xin, a_dt, bm, cm)
        y = y + yd
    y = y.reshape(bsz, seqlen, SSD_INNER).astype(z.dtype) * jax.nn.silu(z)
    return rms_norm(y, norm_w)


def dilated_window_attention(q, k, v, dil, radius, slopes):
    bsz, seqlen, nh, hd = q.shape
    ls = seqlen // dil
    blk = radius
    nb = -(-ls // blk)
    lp = nb * blk

    def by_class(a):
        return a.reshape(bsz, ls, dil, nh, hd).transpose(0, 2, 3, 1, 4)

    qc = jnp.pad(by_class(q), ((0, 0), (0, 0), (0, 0), (0, lp - ls), (0, 0)))
    kc = jnp.pad(by_class(k), ((0, 0), (0, 0), (0, 0), (blk, lp - ls + blk), (0, 0)))
    vc = jnp.pad(by_class(v), ((0, 0), (0, 0), (0, 0), (blk, lp - ls + blk), (0, 0)))
    qb = qc.reshape(bsz, dil, nh, nb, blk, hd)

    def windows(a):
        return jnp.concatenate([a[:, :, :, o * blk:o * blk + lp].reshape(bsz, dil, nh, nb, blk, hd) for o in range(3)], axis=4)

    kb, vb = windows(kc), windows(vc)
    qpos = jnp.arange(lp).reshape(nb, blk)
    kpos = (jnp.arange(nb)[:, None] - 1) * blk + jnp.arange(3 * blk)[None, :]
    dist = jnp.abs(qpos[:, :, None] - kpos[:, None, :])
    valid = (dist <= radius) & (kpos[:, None, :] >= 0) & (kpos[:, None, :] < ls)
    alibi = -slopes.astype(jnp.float32)[:, None, None, None] * (dil * dist).astype(jnp.float32)
    s = jnp.einsum('bdhnqe,bdhnke->bdhnqk', qb, kb, preferred_element_type=jnp.float32) * (ATT_HEAD_DIM ** -0.5) + alibi[None, None]
    s = jnp.where(valid, s, ATT_NEG)
    m = jnp.max(s, axis=-1, keepdims=True)
    p = jnp.exp(s - m)
    zsum = jnp.sum(p, axis=-1, keepdims=True)
    o = jnp.einsum('bdhnqk,bdhnke->bdhnqe', p, vb.astype(jnp.float32)) / zsum
    lse = (m + jnp.log(zsum))[..., 0]
    o = o.reshape(bsz, dil, nh, lp, hd)[:, :, :, :ls].transpose(0, 3, 1, 2, 4).reshape(bsz, seqlen, nh, hd)
    lse = lse.reshape(bsz, dil, nh, lp)[..., :ls].transpose(0, 3, 1, 2).reshape(bsz, seqlen, nh)
    return o, lse


def attention_branch(qkv):
    bsz, seqlen, _ = qkv.shape
    q, k, v = [a.reshape(bsz, seqlen, ATT_GROUPS, ATT_HPG, ATT_HEAD_DIM) for a in jnp.split(qkv, 3, axis=-1)]
    slopes = (2.0 ** (-8.0 * jnp.arange(1, ATT_HEADS + 1, dtype=jnp.float32) / ATT_HEADS)).reshape(ATT_HPG, ATT_GROUPS)
    outs, lses = [], []
    for g, (window, dil) in enumerate(ATT_PATTERNS):
        o, lse = dilated_window_attention(q[:, :, g], k[:, :, g], v[:, :, g], dil, (window // 2) // dil, slopes[:, g])
        outs.append(o)
        lses.append(lse)
    wts = jax.nn.softmax(jnp.stack(lses, axis=0), axis=0)
    out = wts[0][..., None] * outs[0]
    for g in range(1, ATT_GROUPS):
        out = out + wts[g][..., None] * outs[g]
    return out.reshape(bsz, seqlen, ATT_OUT).astype(qkv.dtype)


def complex_affine_combine(left, right):
    ar_l, ai_l, br_l, bi_l = left
    ar_r, ai_r, br_r, bi_r = right
    return (ar_r * ar_l - ai_r * ai_l,
            ar_r * ai_l + ai_r * ar_l,
            ar_r * br_l - ai_r * bi_l + br_r,
            ar_r * bi_l + ai_r * br_l + bi_r)


def s5_branch(u, a_re, a_im, log_step, b_re, b_im, c_re, c_im, d_skip, glu_w1, glu_w2):
    bsz, seqlen, _ = u.shape
    f32 = jnp.float32
    uf = u.astype(f32)
    ug = uf.reshape(bsz, seqlen, S5_GROUPS, S5_CH)
    y = (uf * d_skip.astype(f32)).reshape(bsz, seqlen, S5_GROUPS, S5_CH)
    br, bi = b_re.astype(f32), b_im.astype(f32)
    for direction in range(2):
        ar, ai = a_re[direction].astype(f32), a_im[direction].astype(f32)
        step = jnp.exp(log_step[direction].astype(f32))[:, None]
        mag = jnp.exp(step * ar)
        abr, abi = mag * jnp.cos(step * ai), mag * jnp.sin(step * ai)
        den = ar * ar + ai * ai
        fr = ((abr - 1.0) * ar + abi * ai) / den
        fi = (abi * ar - (abr - 1.0) * ai) / den
        bbr = fr[..., None] * br - fi[..., None] * bi
        bbi = fr[..., None] * bi + fi[..., None] * br
        u_dir = ug if direction == 0 else jnp.flip(ug, axis=1)
        bu_r = jnp.einsum('blgc,gnc->lbgn', u_dir, bbr)
        bu_i = jnp.einsum('blgc,gnc->lbgn', u_dir, bbi)
        a_r = jnp.broadcast_to(abr[None, None], (seqlen, 1, S5_GROUPS, S5_STATE))
        a_i = jnp.broadcast_to(abi[None, None], (seqlen, 1, S5_GROUPS, S5_STATE))
        _, _, st_r, st_i = lax.associative_scan(complex_affine_combine, (a_r, a_i, bu_r, bu_i), axis=0)
        if direction == 1:
            st_r, st_i = jnp.flip(st_r, axis=0), jnp.flip(st_i, axis=0)
        y = y + jnp.einsum('lbgn,gcn->blgc', st_r, c_re[direction].astype(f32)) \
              - jnp.einsum('lbgn,gcn->blgc', st_i, c_im[direction].astype(f32))
    h = jax.nn.gelu(y.reshape(bsz, seqlen, S5_WIDTH)).astype(u.dtype)
    return (h @ glu_w1) * jax.nn.sigmoid(h @ glu_w2)


def hybrid_mixer(x, w_in, b_gate, ssd_conv_w, ssd_conv_b, ssd_a_log, ssd_dt_bias, ssd_d, ssd_norm_w,
                 s5_a_re, s5_a_im, s5_log_step, s5_b_re, s5_b_im, s5_c_re, s5_c_im, s5_d, s5_glu_w1, s5_glu_w2,
                 w_br_ssd, w_br_attn, w_br_s5, w_out):
    bsz, seqlen, _ = x.shape
    proj = x @ w_in
    gates, z, xbc, dt, qkv, u = split_columns(proj)
    y_ssd = ssd_branch(z, xbc, dt, ssd_conv_w, ssd_conv_b, ssd_a_log, ssd_dt_bias, ssd_d, ssd_norm_w)
    y_att = attention_branch(qkv)
    y_s5 = s5_branch(u, s5_a_re, s5_a_im, s5_log_step, s5_b_re, s5_b_im, s5_c_re, s5_c_im, s5_d, s5_glu_w1, s5_glu_w2)
    g = jax.nn.sigmoid(gates.reshape(bsz, seqlen, N_BRANCHES, D_MODEL) + b_gate)
    merged = g[:, :, 0] * (y_ssd @ w_br_ssd) + g[:, :, 1] * (y_att @ w_br_attn) + g[:, :, 2] * (y_s5 @ w_br_s5)
    return merged @ w_out


def moe_ffn(x, router_w, router_b, w_gu, b_gu, w_dn, b_dn):
    bsz, seqlen, d = x.shape
    ntok = bsz * seqlen
    h = x.reshape(ntok, d)
    logits = (h @ router_w + router_b).astype(jnp.float32)
    top_val, top_idx = lax.top_k(logits, MOE_TOP_K)
    gate = jax.nn.softmax(top_val, axis=-1)
    n_assign = ntok * MOE_TOP_K
    flat_e = top_idx.reshape(-1)
    flat_tok = jnp.repeat(jnp.arange(ntok, dtype=jnp.int32), MOE_TOP_K)
    order = jnp.argsort(flat_e)
    e_sorted = flat_e[order]
    tok_sorted = flat_tok[order]
    gate_sorted = gate.reshape(-1)[order]
    counts = jnp.bincount(flat_e, length=MOE_EXPERTS)
    padded = (counts + MOE_BLOCK - 1) // MOE_BLOCK * MOE_BLOCK
    start = jnp.cumsum(counts) - counts
    pend = jnp.cumsum(padded)
    pstart = pend - padded
    dest = pstart[e_sorted] + jnp.arange(n_assign, dtype=jnp.int32) - start[e_sorted]
    n_blocks = n_assign // MOE_BLOCK + MOE_EXPERTS
    slot_tok = jnp.full((n_blocks * MOE_BLOCK,), ntok, jnp.int32).at[dest].set(tok_sorted)
    h_pad = jnp.concatenate([h, jnp.zeros((1, d), h.dtype)], axis=0)
    xs = h_pad[slot_tok].reshape(n_blocks, MOE_BLOCK, d)
    block_expert = jnp.minimum(jnp.searchsorted(pend, jnp.arange(n_blocks, dtype=pend.dtype) * MOE_BLOCK, side='right'), MOE_EXPERTS - 1)

    def expert_block(args):
        xb, e = args
        hu = xb @ w_gu[e] + b_gu[e]
        x_glu, x_lin = hu[:, :MOE_FF], hu[:, MOE_FF:]
        x_glu = jnp.minimum(x_glu, SWIGLU_LIMIT)
        x_lin = jnp.clip(x_lin, -SWIGLU_LIMIT, SWIGLU_LIMIT)
        act = x_glu * jax.nn.sigmoid(SWIGLU_ALPHA * x_glu) * (x_lin + 1.0)
        return act @ w_dn[e] + b_dn[e]

    ys = lax.map(expert_block, (xs, block_expert)).reshape(-1, d)
    y = ys[dest] * gate_sorted[:, None].astype(ys.dtype)
    return jax.ops.segment_sum(y, tok_sorted, num_segments=ntok).reshape(bsz, seqlen, d)


def setup_inputs(seed: int = 0) -> dict:
    key = jax.random.key(seed)
    ks = iter(jax.random.split(key, 40))
    L = DEPTH

    def nrm(shape, std):
        return jax.random.normal(next(ks), shape, jnp.float32) * std

    def unif(shape, lo, hi):
        return jax.random.uniform(next(ks), shape, jnp.float32, lo, hi)

    dt0 = jnp.exp(unif((L, 2, SSD_HEADS), math.log(1e-3), math.log(1e-1)))
    n_idx = jnp.arange(S5_STATE, dtype=jnp.float32)
    return {
        "x": nrm((BATCH, SEQ, D_MODEL), 1.0),
        "w_in": nrm((L, D_MODEL, N_IN), D_MODEL ** -0.5),
        "b_gate": nrm((L, N_BRANCHES, D_MODEL), 0.1),
        "ssd_conv_w": nrm((L, SSD_CONV, SSD_CONV_CH), SSD_CONV ** -0.5),
        "ssd_conv_b": nrm((L, SSD_CONV_CH), 0.02),
        "ssd_a_log": jnp.log(unif((L, 2, SSD_HEADS), 1.0, 16.0)),
        "ssd_dt_bias": dt0 + jnp.log(-jnp.expm1(-dt0)),
        "ssd_d": 1.0 + nrm((L, SSD_HEADS), 0.1),
        "ssd_norm_w": 1.0 + nrm((L, SSD_INNER), 0.02),
        "s5_a_re": -0.5 + nrm((L, 2, S5_GROUPS, S5_STATE), 0.02),
        "s5_a_im": math.pi * n_idx + nrm((L, 2, S5_GROUPS, S5_STATE), 0.02),
        "s5_log_step": unif((L, 2, S5_GROUPS), math.log(1e-3), math.log(1e-1)),
        "s5_b_re": nrm((L, S5_GROUPS, S5_STATE, S5_CH), (2 * S5_CH) ** -0.5),
        "s5_b_im": nrm((L, S5_GROUPS, S5_STATE, S5_CH), (2 * S5_CH) ** -0.5),
        "s5_c_re": nrm((L, 2, S5_GROUPS, S5_CH, S5_STATE), (2 * S5_STATE) ** -0.5),
        "s5_c_im": nrm((L, 2, S5_GROUPS, S5_CH, S5_STATE), (2 * S5_STATE) ** -0.5),
        "s5_d": nrm((L, S5_WIDTH), 1.0),
        "s5_glu_w1": nrm((L, S5_WIDTH, S5_WIDTH), S5_WIDTH ** -0.5),
        "s5_glu_w2": nrm((L, S5_WIDTH, S5_WIDTH), S5_WIDTH ** -0.5),
        "w_br_ssd": nrm((L, SSD_INNER, D_MODEL), SSD_INNER ** -0.5),
        "w_br_attn": nrm((L, ATT_OUT, D_MODEL), ATT_OUT ** -0.5),
        "w_br_s5": nrm((L, S5_WIDTH, D_MODEL), S5_WIDTH ** -0.5),
        "w_out": nrm((L, D_MODEL, D_MODEL), DEEPNORM_BETA * D_MODEL ** -0.5),
        "ln1_g": 1.0 + nrm((L, D_MODEL), 0.02),
        "ln1_b": nrm((L, D_MODEL), 0.02),
        "router_w": nrm((L, D_MODEL, MOE_EXPERTS), D_MODEL ** -0.5),
        "router_b": nrm((L, MOE_EXPERTS), 0.01),
        "exp_w_gate_up": nrm((L, MOE_EXPERTS, D_MODEL, 2 * MOE_FF), D_MODEL ** -0.5),
        "exp_b_gate_up": nrm((L, MOE_EXPERTS, 2 * MOE_FF), 0.02),
        "exp_w_down": nrm((L, MOE_EXPERTS, MOE_FF, D_MODEL), DEEPNORM_BETA * MOE_FF ** -0.5),
        "exp_b_down": nrm((L, MOE_EXPERTS, D_MODEL), 0.02),
        "ln2_g": 1.0 + nrm((L, D_MODEL), 0.02),
        "ln2_b": nrm((L, D_MODEL), 0.02),
    }


def reference(x, w_in, b_gate, ssd_conv_w, ssd_conv_b, ssd_a_log, ssd_dt_bias, ssd_d, ssd_norm_w,
              s5_a_re, s5_a_im, s5_log_step, s5_b_re, s5_b_im, s5_c_re, s5_c_im, s5_d, s5_glu_w1, s5_glu_w2,
              w_br_ssd, w_br_attn, w_br_s5, w_out, ln1_g, ln1_b,
              router_w, router_b, exp_w_gate_up, exp_b_gate_up, exp_w_down, exp_b_down, ln2_g, ln2_b):
    for layer in range(DEPTH):
        mix = hybrid_mixer(x, w_in[layer], b_gate[layer], ssd_conv_w[layer], ssd_conv_b[layer], ssd_a_log[layer],
                           ssd_dt_bias[layer], ssd_d[layer], ssd_norm_w[layer],
                           s5_a_re[layer], s5_a_im[layer], s5_log_step[layer], s5_b_re[layer], s5_b_im[layer],
                           s5_c_re[layer], s5_c_im[layer], s5_d[layer], s5_glu_w1[layer], s5_glu_w2[layer],
                           w_br_ssd[layer], w_br_attn[layer], w_br_s5[layer], w_out[layer])
        x = layer_norm(DEEPNORM_ALPHA * x + mix, ln1_g[layer], ln1_b[layer])
        ffn = moe_ffn(x, router_w[layer], router_b[layer], exp_w_gate_up[layer], exp_b_gate_up[layer],
                      exp_w_down[layer], exp_b_down[layer])
        x = layer_norm(DEEPNORM_ALPHA * x + ffn, ln2_g[layer], ln2_b[layer])
    return x
```

```cpp
#include <hip/hip_runtime.h>
#include <cstdio>
#include <cstdint>
#include <cstring>
#include <cmath>

#ifndef REPMASK
#define REPMASK 0u
#endif

namespace md {
constexpr int D = 1024, NIN = 13888;
constexpr int C_GATE = 0, C_Z = 3072, C_XBC = 5120, C_DT = 9216, C_QKV = 9280, C_U = 12736;
constexpr int SSD_IN = 2048, SSD_CC = 4096, NH = 32, HP = 64, NG = 8, NS = 128;
constexpr int ATT_W = 1152, ATT_O = 384;
constexpr int S5W = 1152, S5G = 72, S5C = 16, S5N = 64;
constexpr int NE = 32, TOPK = 4, FF = 1024;
constexpr float ALPHA = 1.681792830507429f;
constexpr float EPS = 1e-5f;
}

enum { I_X = 0, I_WIN, I_BGATE, I_CONVW, I_CONVB, I_ALOG, I_DTB, I_SSDD, I_NORMW, I_S5ARE, I_S5AIM, I_S5LS, I_S5BRE, I_S5BIM,
       I_S5CRE, I_S5CIM, I_S5D, I_GLU1, I_GLU2, I_WBSSD, I_WBATT, I_WBS5, I_WOUT, I_LN1G, I_LN1B, I_RW, I_RB, I_WGU, I_BGU,
       I_WDN, I_BDN, I_LN2G, I_LN2B, N_INPUTS };

struct Ctx {
    const float* in[N_INPUTS];
    float* out;
    float *attlse, *gate; unsigned short* mixb;
    int *topidx, *tok_slot;
    unsigned* bar;
    unsigned short *Win_t, *Wglu_t, *Wbs_t, *Wba_t, *Wb5_t, *Wout_t, *Wgu_t, *Wdn_t;
    unsigned short *xbf, *Gb, *Zb, *XBCb, *QKVU; float* dtf;
    unsigned short *yssdb, *yattb, *s5hb, *ys5b, *mergedb;
    unsigned short *x1b, *actb, *ys2; float* slot_gate; int *moe_cnt, *moe_pstart, *slot_tok, *moe_done; unsigned char* x1q;
    unsigned short* ssd_S; float *ssd_tot, *ssd_ssq;
    unsigned short* attob;
    unsigned short *Ug, *s5_W1, *s5_Q, *s5_Yl, *s5_Sin, *s5_Sloc; float* s5_a16;
    int depth, grid;
};

namespace wsz { constexpr size_t WIN = (size_t)14080 * 1024, WGLU = (size_t)2304 * 1152, WBS = (size_t)1024 * 2048, WBA = (size_t)1024 * 384, WB5 = (size_t)1024 * 1152, WOUT = (size_t)1024 * 1024,
    S5W1 = (size_t)72 * 512 * 256, S5Q = (size_t)72 * 256 * 256, A16 = 72 * 2 * 64 * 2; }
static inline size_t align_up(size_t x) { return (x + 255) & ~(size_t)255; }
static size_t build_ctx(Ctx& c, void* const* d_in, void* d_out, void* d_ws, int depth) {
    memset(&c, 0, sizeof(c));
    for (int i = 0; i < N_INPUTS; ++i) c.in[i] = (const float*)d_in[i];
    c.out = (float*)d_out; c.depth = depth;
    char* w = (char*)d_ws; size_t off = 0; const size_t T = 16384;
    auto take = [&](size_t bytes) { char* p = w + off; off = align_up(off + bytes); return p; };
    c.bar = (unsigned*)take(16384);
    c.attlse = (float*)take(3 * T * 6 * 4); c.mixb = (unsigned short*)take(T * 1024 * 2);
    c.gate = (float*)take(T * 4 * 4); c.topidx = (int*)take(T * 4 * 4); c.tok_slot = (int*)take(T * 4 * 4);
    c.Win_t = (unsigned short*)take(2 * wsz::WIN * 2); c.Wglu_t = (unsigned short*)take(2 * wsz::WGLU * 2); c.Wbs_t = (unsigned short*)take(2 * wsz::WBS * 2);
    c.Wba_t = (unsigned short*)take(2 * wsz::WBA * 2); c.Wb5_t = (unsigned short*)take(2 * wsz::WB5 * 2); c.Wout_t = (unsigned short*)take(2 * wsz::WOUT * 2);
    c.Wgu_t = (unsigned short*)take((size_t)32 * 2048 * 1024 * 2); c.Wdn_t = (unsigned short*)take((size_t)32 * 1024 * 1024 * 2);
    c.xbf = (unsigned short*)take(T * 1024 * 2); c.Gb = (unsigned short*)take(T * 3072 * 2); c.Zb = (unsigned short*)take(T * 2048 * 2); c.XBCb = (unsigned short*)take(T * 4096 * 2);
    c.QKVU = (unsigned short*)take(T * 4608 * 2); c.dtf = (float*)take(T * 64 * 4);
    c.x1b = (unsigned short*)take((size_t)(T + 1) * 1024 * 2); c.slot_tok = (int*)take(73728 * 4); c.actb = (unsigned short*)take((size_t)73728 * 1024 * 2); c.ys2 = (unsigned short*)take((size_t)73728 * 1024 * 2);
    c.slot_gate = (float*)take(73728 * 4); c.moe_cnt = (int*)take(8192 * 4); c.moe_pstart = (int*)take(256); c.moe_done = (int*)take(2048); c.x1q = (unsigned char*)take((size_t)(T + 1) * 1024);
    c.ssd_S = (unsigned short*)take((size_t)2 * 2 * 64 * 32 * 8192 * 2); c.ssd_tot = (float*)take(2 * 2 * 64 * 32 * 4); c.ssd_ssq = (float*)take(T * 8 * 4);
    c.attob = (unsigned short*)take(3 * T * 384 * 2);
    c.Ug = (unsigned short*)take(T * 1152 * 2); c.s5_W1 = (unsigned short*)take(2 * wsz::S5W1 * 2); c.s5_Q = (unsigned short*)take(2 * wsz::S5Q * 2);
    c.s5_Yl = (unsigned short*)take((size_t)73728 * 256 * 2); c.s5_Sin = (unsigned short*)take((size_t)73728 * 256 * 2); c.s5_Sloc = (unsigned short*)take((size_t)73728 * 256 * 2); c.s5_a16 = (float*)take(2 * wsz::A16 * 4);
    c.yssdb = (unsigned short*)take(T * 2048 * 2); c.yattb = (unsigned short*)take(T * 384 * 2); c.s5hb = (unsigned short*)take(T * 1152 * 2); c.ys5b = (unsigned short*)take(T * 1152 * 2); c.mergedb = (unsigned short*)take(T * 1024 * 2);
    return off;
}

#define XB_TMO      128
#define XB_XCNT(j)  (256  + 64 * (j))
#define XB_XSUB(j)  (1280 + 64 * (j))
#define XB_XGEN(j)  (2304 + 64 * (j))
#define XB_TOP      3328
#define XB_TOPGEN   3392
#define XCD_BAR_WORDS 3456
#define XB_SPIN_CAP (1u << 18)
#define LAS __attribute__((address_space(3)))

__device__ __forceinline__ unsigned xb_ld(unsigned* p)              { return __hip_atomic_load(p, __ATOMIC_RELAXED, __HIP_MEMORY_SCOPE_AGENT); }
__device__ __forceinline__ unsigned xb_add(unsigned* p, unsigned v) { return __hip_atomic_fetch_add(p, v, __ATOMIC_RELAXED, __HIP_MEMORY_SCOPE_AGENT); }
__device__ __forceinline__ unsigned xb_xcc_id() { return (unsigned)__builtin_amdgcn_s_getreg((3 << 11) | 20) & 0xFu; }
#define XB_SPIN(cond, bar) do { unsigned _sp = 0; while (cond) { __builtin_amdgcn_s_sleep(1); \
    if ((++_sp & 255u) == 0u) { if (xb_ld(&(bar)[XB_TMO])) break; if (_sp > XB_SPIN_CAP) { atomicAdd(&(bar)[XB_TMO], 1u); break; } } } } while (0)

struct XcdBarrier { unsigned* bar; unsigned x; volatile LAS unsigned* st; };

__device__ __forceinline__ XcdBarrier xcd_barrier_post(unsigned* bar, volatile LAS unsigned* st) {
    XcdBarrier b; b.bar = bar; b.x = xb_xcc_id(); b.st = st;
    if (threadIdx.x == 0) (void)xb_add(&bar[XB_XCNT(b.x)], 1u);
    return b;
}
__device__ __forceinline__ void xcd_barrier_complete(unsigned* bar, unsigned x, unsigned& nloc, unsigned& nx) {
    const unsigned G = gridDim.x * gridDim.y * gridDim.z;
    unsigned sum, cnt, mine, sp = 0u;
    for (;;) {
        sum = 0u; cnt = 0u; mine = 0u;
#pragma unroll
        for (unsigned j = 0; j < 16; ++j) { const unsigned c = xb_ld(&bar[XB_XCNT(j)]); sum += c; cnt += (c > 0u) ? 1u : 0u; mine = (j == x) ? c : mine; }
        if (sum == G) break;
        __builtin_amdgcn_s_sleep(1);
        if ((++sp & 255u) == 0u) { if (xb_ld(&bar[XB_TMO])) break; if (sp > XB_SPIN_CAP) { atomicAdd(&bar[XB_TMO], 1u); break; } }
    }
    nloc = mine > 0u ? mine : 1u; nx = cnt > 0u ? cnt : 1u;
}
__device__ __forceinline__ void xcd_barrier(const XcdBarrier& b) {
    asm volatile("s_waitcnt vmcnt(0)" ::: "memory");
    __syncthreads();
    if (threadIdx.x == 0) {
        unsigned* bar = b.bar;
        __builtin_amdgcn_s_waitcnt(0);
        unsigned nloc = b.st[0], nx = b.st[1];
        if (nloc == 0u) { xcd_barrier_complete(bar, b.x, nloc, nx); b.st[0] = nloc; b.st[1] = nx; }
        const unsigned old = xb_add(&bar[XB_XSUB(b.x)], 1u);
        const unsigned gen = old / nloc;
        if (old + 1u == (gen + 1u) * nloc) {
            __builtin_amdgcn_fence(__ATOMIC_RELEASE, "agent");
            asm volatile("s_waitcnt vmcnt(0)" ::: "memory");
            const unsigned og = xb_add(&bar[XB_TOP], 1u);
            const unsigned tg = og / nx;
            if (og + 1u == (tg + 1u) * nx) xb_add(&bar[XB_TOPGEN], 1u);
            else XB_SPIN(xb_ld(&bar[XB_TOPGEN]) == tg, bar);
            __builtin_amdgcn_fence(__ATOMIC_ACQUIRE, "agent");
            xb_add(&bar[XB_XGEN(b.x)], 1u);
            asm volatile("s_waitcnt vmcnt(0)" ::: "memory");
        } else {
            XB_SPIN(xb_ld(&bar[XB_XGEN(b.x)]) == gen, bar);
            __builtin_amdgcn_fence(__ATOMIC_ACQUIRE, "agent");
            asm volatile("s_waitcnt vmcnt(0)" ::: "memory");
        }
    }
    __syncthreads();
}

constexpr int NTHREADS = 512;
constexpr int LDS_BYTES = 163840;

#if defined(__HIP_DEVICE_COMPILE__)
typedef unsigned short bf16_t;
typedef short bf16x8 __attribute__((ext_vector_type(8)));
typedef float f32x4 __attribute__((ext_vector_type(4)));
typedef float f32x2 __attribute__((ext_vector_type(2)));
typedef unsigned u32x4 __attribute__((ext_vector_type(4)));
typedef unsigned u32x2 __attribute__((ext_vector_type(2)));
#define LDS_WAIT() asm volatile("s_waitcnt lgkmcnt(0)" ::: "memory")
#define VM_WAIT() asm volatile("s_waitcnt vmcnt(0)" ::: "memory")

__device__ __forceinline__ f32x4 zero4() { float z = 0.f; asm volatile("" : "+v"(z)); return (f32x4){z, z, z, z}; }
__device__ __forceinline__ u32x4 uzero4() { unsigned z = 0u; asm volatile("" : "+v"(z)); return (u32x4){z, z, z, z}; }
__device__ __forceinline__ unsigned f2bf(float f) { unsigned u = __float_as_uint(f); return (u + 0x7fffu + ((u >> 16) & 1u)) >> 16; }
__device__ __forceinline__ unsigned pk2(float lo, float hi) { return f2bf(lo) | (f2bf(hi) << 16); }
__device__ __forceinline__ float bf2f(unsigned b) { return __uint_as_float(b << 16); }
__device__ __forceinline__ float bflo(unsigned w) { return __uint_as_float(w << 16); }
__device__ __forceinline__ float bfhi(unsigned w) { return __uint_as_float(w & 0xffff0000u); }
typedef __bf16 bf16x2_t __attribute__((ext_vector_type(2)));
__device__ __forceinline__ unsigned cvt_pk_bf16(float lo, float hi) { const f32x2 v = {lo, hi}; return __builtin_bit_cast(unsigned, __builtin_convertvector(v, bf16x2_t)); }
__device__ __forceinline__ float fast_sigmoid(float x) { return __builtin_amdgcn_rcpf(1.0f + __expf(-x)); }
__device__ __forceinline__ f32x4 sig4(f32x4 v) { return (f32x4){fast_sigmoid(v[0]), fast_sigmoid(v[1]), fast_sigmoid(v[2]), fast_sigmoid(v[3])}; }
__device__ __forceinline__ unsigned pk4_fp8(float a, float b, float c2, float d) { int w = 0; w = __builtin_amdgcn_cvt_pk_fp8_f32(a, b, w, false); w = __builtin_amdgcn_cvt_pk_fp8_f32(c2, d, w, true); return (unsigned)w; }
__device__ __forceinline__ u32x4 pack8(f32x4 v0, f32x4 v1) { u32x4 w; w.x = cvt_pk_bf16(v0[0], v0[1]); w.y = cvt_pk_bf16(v0[2], v0[3]); w.z = cvt_pk_bf16(v1[0], v1[1]); w.w = cvt_pk_bf16(v1[2], v1[3]); return w; }

namespace gx {
constexpr int BM = 256, BK = 64, HALF = 128, HTB = HALF * BK * 2, STAGE_BYTES = 8 * HTB, NXCD = 8, WGM = 2;
__device__ __forceinline__ int lds_byte(int r, int c) { const int st = (r >> 4) * 2 + (c >> 5), rr = r & 15, cc = c & 31, ob = rr * 64 + cc * 2; return st * 1024 + (ob ^ (((ob >> 9) & 1) << 5)); }
__device__ __forceinline__ void stage_rc(int b, int& R, int& C) { const int st = b / 1024, sb = b % 1024, swz = sb ^ (((sb >> 9) & 1) << 5); R = (st >> 1) * 16 + swz / 64; C = (st & 1) * 32 + (swz % 64) / 2; }
__device__ __forceinline__ int perm32(int rho) { const int n = rho >> 4, i = rho & 15; return 8 * (i >> 2) + 4 * n + (i & 3); }
struct Unit { int pm, pn, e, f; };
struct Gemm { const bf16_t* A; const bf16_t* Bt; int K; size_t bexp; };
struct StaticOrder {
    int nM, nN, nwg, G, c;
    __device__ void init(int M, int N, int G_, int c_) { nM = M / BM; nN = N / BM; nwg = nM * nN; G = G_; c = c_; }
    __device__ bool next(int i, Unit& u) const {
        const long Lx = (long)i * G + c; if (Lx >= nwg) return false;
        int wgid = (int)Lx; { const int q = nwg / NXCD, r = nwg % NXCD, xcd = wgid % NXCD, off = wgid / NXCD; wgid = (xcd < r ? xcd * (q + 1) : r * (q + 1) + (xcd - r) * q) + off; }
        const int nig = WGM * nN, gid = wgid / nig, fm = gid * WGM, gsz = (nM - fm) < WGM ? (nM - fm) : WGM;
        u.pm = fm + ((wgid % nig) % gsz); u.pn = (wgid % nig) / gsz; u.e = 0; u.f = 0; return true;
    }
};
typedef int v8i32 __attribute__((ext_vector_type(8)));
template <class Epi, class Sched, bool GATHER = false, bool FP8 = false>
__device__ __forceinline__ void gemm_phase(LAS unsigned char* lds, const Gemm g, const Sched& S, const Epi& E, const int* rowidx = nullptr) {
    int tid = threadIdx.x; asm volatile("" : "+v"(tid)); const int wid = __builtin_amdgcn_readfirstlane(tid >> 6), lane = tid & 63, wr = wid >> 2, wc = wid & 3, fr = lane & 15, fq = lane >> 4;
    int K = g.K; asm volatile("" : "+s"(K)); const int nt = K / BK;
    unsigned voffA[2], voffB[2];
#pragma unroll
    for (int i = 0; i < 2; ++i) { int R, C; stage_rc(tid * 16 + i * 8192, R, C); const int Rb = Epi::PERM ? ((R & ~31) + perm32(R & 31)) : R;
        voffA[i] = (unsigned)(R * K + C) * 2u; voffB[i] = (unsigned)(Rb * K + C) * 2u; }
    const size_t kstep = (size_t)(BK * 2);
    const size_t hstep = (size_t)HALF * K * 2;
    const size_t tstep = 2 * hstep;
    const size_t hstepA = GATHER ? 0 : hstep;
    const unsigned ldsw = (unsigned)wid * 1024u;
    const int aoff = lds_byte(wr * 64 + fr, fq * 8), boff = lds_byte(wc * 32 + fr, fq * 8);
#define GX_SA(b, h) (((b) * 2 + (h)) * HTB)
#define GX_SB(b, h) ((4 + (b) * 2 + (h)) * HTB)
#define GX_STAGE(bufoff, gbase, voff) do { _Pragma("unroll") for (int _i = 0; _i < 2; ++_i) \
        __builtin_amdgcn_global_load_lds((const unsigned*)((const char*)(gbase) + (voff)[_i]), (LAS unsigned*)(lds + (bufoff) + ldsw + _i * 8192), 16, 0, 0); } while (0)
#define GX_STAGE_A(bufoff, ptr, half, usenext) do { if (GATHER) { unsigned _v[2]; _Pragma("unroll") for (int _i = 0; _i < 2; ++_i) _v[_i] = (usenext) ? nv[half][_i] : cv[half][_i]; GX_STAGE(bufoff, ptr, _v); } \
        else GX_STAGE(bufoff, (ptr) + (half) * hstepA, voffA); } while (0)
#define GX_IDX(dst, u) do { _Pragma("unroll") for (int _i = 0; _i < 2; ++_i) { int _R, _C; stage_rc(tid * 16 + _i * 8192, _R, _C); _Pragma("unroll") for (int _h = 0; _h < 2; ++_h) \
        dst[_h][_i] = (unsigned)rowidx[(u).pm * 256 + _h * 128 + _R] * (unsigned)(K * 2) + (unsigned)(_C * 2); } } while (0)
#define GX_LDA(dst, b, h) do { _Pragma("unroll") for (int m = 0; m < 4; ++m) _Pragma("unroll") for (int k = 0; k < 2; ++k) dst[m][k] = *(const LAS bf16x8*)(lds + GX_SA(b, h) + aoff + m * 2048 + k * 1024); } while (0)
#define GX_LDB(dst, b, h) do { _Pragma("unroll") for (int n = 0; n < 2; ++n) _Pragma("unroll") for (int k = 0; k < 2; ++k) dst[n][k] = *(const LAS bf16x8*)(lds + GX_SB(b, h) + boff + n * 2048 + k * 1024); } while (0)
#define GX_CAT8(lo, hi) __builtin_bit_cast(v8i32, __builtin_shufflevector(__builtin_bit_cast(u32x4, lo), __builtin_bit_cast(u32x4, hi), 0, 1, 2, 3, 4, 5, 6, 7))
#define GX_MMA(ai, bj, At, Bt) do { __builtin_amdgcn_s_setprio(1); if (FP8) { _Pragma("unroll") for (int m = 0; m < 4; ++m) _Pragma("unroll") for (int n = 0; n < 2; ++n) \
            asm volatile("v_mfma_scale_f32_16x16x128_f8f6f4 %0, %1, %2, %0, %3, %3 op_sel_hi:[0,0,0]" : "+v"(acc[ai][bj][m][n]) : "v"(GX_CAT8(Bt[n][0], Bt[n][1])), "v"(GX_CAT8(At[m][0], At[m][1])), "v"(one_scale)); } \
        else { _Pragma("unroll") for (int m = 0; m < 4; ++m) _Pragma("unroll") for (int n = 0; n < 2; ++n) _Pragma("unroll") for (int k = 0; k < 2; ++k) \
        acc[ai][bj][m][n] = __builtin_amdgcn_mfma_f32_16x16x32_bf16(Bt[n][k], At[m][k], acc[ai][bj][m][n], 0, 0, 0); } __builtin_amdgcn_s_setprio(0); } while (0)
#define GX_WAIT_V(n) asm volatile("s_waitcnt vmcnt(" #n ")" ::: "memory")
#define GX_WAIT_L(n) asm volatile("s_waitcnt lgkmcnt(" #n ")" ::: "memory")
#define GX_BAR __builtin_amdgcn_s_barrier()
#define GX_SCHED __builtin_amdgcn_sched_barrier(0)
    Unit cur, nxt, nn; int ui = 0;
    if (!S.next(0, cur)) return;
    bool has_next = S.next(1, nxt);
    unsigned cv[2][2], nv[2][2], nnv[2][2];
    if (GATHER) { GX_IDX(cv, cur); if (has_next) GX_IDX(nv, nxt); else { _Pragma("unroll") for (int h = 0; h < 2; ++h) _Pragma("unroll") for (int i = 0; i < 2; ++i) nv[h][i] = cv[h][i]; } }
    f32x4 acc[2][2][4][2];
    { float z = 0.f; asm volatile("" : "+v"(z));
#pragma unroll
    for (int a = 0; a < 2; ++a)
#pragma unroll
        for (int b = 0; b < 2; ++b)
#pragma unroll
            for (int m = 0; m < 4; ++m)
#pragma unroll
                for (int n = 0; n < 2; ++n) acc[a][b][m][n] = (f32x4){z, z, z, z}; }
    bf16x8 At[4][2], B0[2][2], B1[2][2]; int one_scale = 0x7f7f7f7f; asm volatile("" : "+v"(one_scale));
    const char* cA = (const char*)g.A + (GATHER ? 0 : (size_t)cur.pm * tstep); const char* cB = (const char*)g.Bt + (size_t)cur.e * g.bexp + (size_t)cur.pn * tstep;
    GX_STAGE(GX_SB(0, 0), cB, voffB); GX_STAGE_A(GX_SA(0, 0), cA, 0, false); GX_STAGE(GX_SB(0, 1), cB + hstep, voffB); GX_STAGE_A(GX_SA(0, 1), cA, 1, false);
    if (wr == 1) GX_BAR;
    GX_WAIT_V(4); GX_BAR;
    GX_STAGE(GX_SB(1, 0), cB + kstep, voffB); GX_STAGE_A(GX_SA(1, 0), cA + kstep, 0, false); GX_STAGE(GX_SB(1, 1), cB + hstep + kstep, voffB);
    GX_WAIT_V(6); GX_BAR;
    for (;;) {
        const char* nA = (has_next && !GATHER) ? (const char*)g.A + (size_t)nxt.pm * tstep : cA; const char* nB = has_next ? (const char*)g.Bt + (size_t)nxt.e * g.bexp + (size_t)nxt.pn * tstep : cB;
#pragma clang loop unroll(disable)
        for (int t = 0; t < nt; t += 2) {
            const bool last = (t == nt - 2);
            const char* a1 = cA + (size_t)(t + 1) * kstep;
            const char* a2 = last ? nA : cA + (size_t)(t + 2) * kstep; const char* b2 = last ? nB : cB + (size_t)(t + 2) * kstep;
            const char* a3 = a2 + kstep; const char* b3 = b2 + kstep;
            GX_LDB(B0, 0, 0); GX_SCHED; GX_LDA(At, 0, 0); GX_STAGE_A(GX_SA(1, 1), a1, 1, false);
            GX_WAIT_L(8); GX_BAR; GX_WAIT_L(0); GX_MMA(0, 0, At, B0); GX_BAR; GX_SCHED;
            GX_LDB(B1, 0, 1); GX_STAGE(GX_SB(0, 0), b2, voffB);
            GX_BAR; GX_WAIT_L(0); GX_MMA(0, 1, At, B1); GX_BAR;
            GX_LDA(At, 0, 1); GX_STAGE_A(GX_SA(0, 0), a2, 0, last);
            GX_BAR; GX_WAIT_L(0); GX_MMA(1, 0, At, B0); GX_BAR; GX_SCHED;
            GX_STAGE(GX_SB(0, 1), b2 + hstep, voffB);
            GX_WAIT_V(6); GX_BAR; GX_MMA(1, 1, At, B1); GX_BAR;
            GX_LDB(B0, 1, 0); GX_SCHED; GX_LDA(At, 1, 0); GX_STAGE_A(GX_SA(0, 1), a2, 1, last);
            GX_WAIT_L(8); GX_BAR; GX_WAIT_L(0); GX_MMA(0, 0, At, B0); GX_BAR; GX_SCHED;
            GX_LDB(B1, 1, 1); GX_STAGE(GX_SB(1, 0), b3, voffB);
            GX_BAR; GX_WAIT_L(0); GX_MMA(0, 1, At, B1); GX_BAR;
            GX_LDA(At, 1, 1); GX_STAGE_A(GX_SA(1, 0), a3, 0, last);
            GX_BAR; GX_WAIT_L(0); GX_MMA(1, 0, At, B0); GX_BAR; GX_SCHED;
            GX_STAGE(GX_SB(1, 1), b3 + hstep, voffB);
            GX_WAIT_V(6); GX_BAR; GX_MMA(1, 1, At, B1); GX_BAR;
        }
        const bool has_nn = has_next && S.next(ui + 2, nn);
        if (GATHER && has_nn) GX_IDX(nnv, nn);
        if (FP8) asm volatile("s_nop 15\n\ts_nop 15" ::: "memory");
        E(acc, cur, wr, wc, fr, fq);
        if (!has_next) break;
        { float z = 0.f; asm volatile("" : "+v"(z));
#pragma unroll
        for (int a = 0; a < 2; ++a)
#pragma unroll
            for (int b = 0; b < 2; ++b)
#pragma unroll
                for (int m = 0; m < 4; ++m)
#pragma unroll
                    for (int n = 0; n < 2; ++n) acc[a][b][m][n] = (f32x4){z, z, z, z}; }
        cur = nxt; cA = nA; cB = nB; ++ui;
        if (GATHER) { _Pragma("unroll") for (int h = 0; h < 2; ++h) _Pragma("unroll") for (int i = 0; i < 2; ++i) { cv[h][i] = nv[h][i]; if (has_nn) nv[h][i] = nnv[h][i]; } }
        nxt = nn; has_next = has_nn;
    }
    GX_WAIT_V(0);
    if (wr == 0) GX_BAR;
    GX_BAR;
#undef GX_SA
#undef GX_SB
#undef GX_STAGE
#undef GX_STAGE_A
#undef GX_IDX
#undef GX_LDA
#undef GX_LDB
#undef GX_MMA
#undef GX_CAT8
#undef GX_WAIT_V
#undef GX_WAIT_L
#undef GX_BAR
#undef GX_SCHED
}
}

template <bool RAWG, bool RAWZ> struct EpiInproj {
    static constexpr bool PERM = true;
    bf16_t *Gb, *Zb, *XBCb, *QKVU; float* dtf; const float* bgate; bf16_t* Ug;
    __device__ __forceinline__ void operator()(const f32x4 (&acc)[2][2][4][2], const gx::Unit& u, int wr, int wc, int fr, int fq) const {
        const int row0 = u.pm * 256 + wr * 64 + fr, cl = wc * 32 + 8 * fq;
        if (u.pn == 54) {
            if (wc < 2) {
#pragma unroll
                for (int ai = 0; ai < 2; ++ai)
#pragma unroll
                    for (int m = 0; m < 4; ++m) { float* rowp = dtf + (size_t)(row0 + ai * 128 + m * 16) * 64 + cl; *(f32x4*)rowp = acc[ai][0][m][0]; *(f32x4*)(rowp + 4) = acc[ai][0][m][1]; }
            }
            return;
        }
        bf16_t* base; int ldc, colt, mode;
        if (u.pn < 12) { base = Gb; ldc = 3072; colt = u.pn * 256; mode = RAWG ? 0 : 1; }
        else if (u.pn < 20) { base = Zb; ldc = 2048; colt = (u.pn - 12) * 256; mode = RAWZ ? 0 : 2; }
        else if (u.pn < 36) { base = XBCb; ldc = 4096; colt = (u.pn - 20) * 256; mode = 0; }
        else { base = QKVU; ldc = 4608; colt = (u.pn - 36) * 256; mode = 0; }
        const bool isu = u.pn >= 50;
#pragma unroll
        for (int bj = 0; bj < 2; ++bj) {
            const int col = colt + bj * 128 + cl;
            f32x4 b0 = zero4(), b1 = b0;
            if (mode == 1) { b0 = *(const f32x4*)(bgate + col); b1 = *(const f32x4*)(bgate + col + 4); }
#pragma unroll
            for (int ai = 0; ai < 2; ++ai)
#pragma unroll
                for (int m = 0; m < 4; ++m) {
                    f32x4 v0 = acc[ai][bj][m][0], v1 = acc[ai][bj][m][1];
                    if (mode == 1) { v0 = sig4(v0 + b0); v1 = sig4(v1 + b1); }
                    else if (mode == 2) { v0 = v0 * sig4(v0); v1 = v1 * sig4(v1); }
                    const u32x4 pk = pack8(v0, v1);
                    if (isu || (u.pn == 49 && bj == 1)) { const int uc = col - 3456; *(u32x4*)(Ug + ((size_t)(uc >> 4) * 16384 + (row0 + ai * 128 + m * 16)) * 16 + (uc & 15)) = pk; }
                    else *(u32x4*)(base + (size_t)(row0 + ai * 128 + m * 16) * ldc + col) = pk;
                }
        }
    }
};

struct EpiGlu {
    static constexpr bool PERM = true;
    bf16_t* O;
    __device__ __forceinline__ void operator()(const f32x4 (&acc)[2][2][4][2], const gx::Unit& u, int wr, int wc, int fr, int fq) const {
        const int row0 = u.pm * 256 + wr * 64 + fr, col = u.pn * 128 + wc * 32 + 8 * fq;
#pragma unroll
        for (int ai = 0; ai < 2; ++ai)
#pragma unroll
            for (int m = 0; m < 4; ++m) {
                const f32x4 v0 = acc[ai][0][m][0] * sig4(acc[ai][1][m][0]), v1 = acc[ai][0][m][1] * sig4(acc[ai][1][m][1]);
                *(u32x4*)(O + (size_t)(row0 + ai * 128 + m * 16) * 1152 + col) = pack8(v0, v1);
            }
    }
};
template <int STEP> struct EpiBranch {
    static constexpr bool PERM = true;
    const bf16_t* G; bf16_t* mb; const float* ssq;
    __device__ __forceinline__ void operator()(const f32x4 (&acc)[2][2][4][2], const gx::Unit& u, int wr, int wc, int fr, int fq) const {
        const int row0 = u.pm * 256 + wr * 64 + fr, cl = u.pn * 256 + wc * 32 + 8 * fq;
#pragma unroll
        for (int ai = 0; ai < 2; ++ai) {
            u32x4 gw[4][2], pw[4][2]; float rs[4];
#pragma unroll
            for (int m = 0; m < 4; ++m) { const size_t row = (size_t)(row0 + ai * 128 + m * 16);
#pragma unroll
                for (int bj = 0; bj < 2; ++bj) { const int col = cl + bj * 128; gw[m][bj] = *(const u32x4*)(G + row * 3072 + STEP * 1024 + col); if (STEP > 0) pw[m][bj] = *(const u32x4*)(mb + row * 1024 + col); }
                if (STEP == 0) { const f32x4 qa = *(const f32x4*)(ssq + row * 8), qb = *(const f32x4*)(ssq + row * 8 + 4);
                    rs[m] = __builtin_amdgcn_rsqf((((qa[0] + qa[1]) + (qa[2] + qa[3])) + ((qb[0] + qb[1]) + (qb[2] + qb[3]))) * (1.0f / 2048.0f) + md::EPS); } }
#pragma unroll
            for (int m = 0; m < 4; ++m)
#pragma unroll
                for (int bj = 0; bj < 2; ++bj) { const size_t row = (size_t)(row0 + ai * 128 + m * 16); const int col = cl + bj * 128; const u32x4 g4 = gw[m][bj];
                    const f32x4 g0 = (f32x4){bflo(g4.x), bfhi(g4.x), bflo(g4.y), bfhi(g4.y)}, g1 = (f32x4){bflo(g4.z), bfhi(g4.z), bflo(g4.w), bfhi(g4.w)};
                    f32x4 v0 = acc[ai][bj][m][0] * g0, v1 = acc[ai][bj][m][1] * g1;
                    if (STEP == 0) { v0 *= rs[m]; v1 *= rs[m]; }
                    if (STEP > 0) { const u32x4 p4 = pw[m][bj]; v0 += (f32x4){bflo(p4.x), bfhi(p4.x), bflo(p4.y), bfhi(p4.y)}; v1 += (f32x4){bflo(p4.z), bfhi(p4.z), bflo(p4.w), bfhi(p4.w)}; }
                    *(u32x4*)(mb + row * 1024 + col) = pack8(v0, v1); }
        }
    }
};
struct EpiBf16 {
    static constexpr bool PERM = true;
    bf16_t* C;
    __device__ __forceinline__ void operator()(const f32x4 (&acc)[2][2][4][2], const gx::Unit& u, int wr, int wc, int fr, int fq) const {
        const int row0 = u.pm * 256 + wr * 64 + fr, cl = u.pn * 256 + wc * 32 + 8 * fq;
#pragma unroll
        for (int ai = 0; ai < 2; ++ai)
#pragma unroll
            for (int m = 0; m < 4; ++m)
#pragma unroll
                for (int bj = 0; bj < 2; ++bj) *(u32x4*)(C + (size_t)(row0 + ai * 128 + m * 16) * 1024 + cl + bj * 128) = pack8(acc[ai][bj][m][0], acc[ai][bj][m][1]);
    }
};

__device__ __forceinline__ void cvt_item(const float* Wsrc  , int ldn, bf16_t* dst  , int K, int k0, LAS float* scr, int lane, const float* kscale) {
#pragma unroll
    for (int hb = 0; hb < 2; ++hb) {
        float v[32];
#pragma unroll
        for (int i = 0; i < 32; ++i) v[i] = __builtin_nontemporal_load(Wsrc + (size_t)(k0 + 32 * hb + i) * ldn + lane);
        if (kscale) {
#pragma unroll
            for (int i = 0; i < 32; ++i) v[i] *= kscale[k0 + 32 * hb + i];
        }
#pragma unroll
        for (int i = 0; i < 32; ++i) scr[(32 * hb + i) * 65 + lane] = v[i];
    }
    LDS_WAIT(); asm volatile("" ::: "memory");
    const int cch = lane & 7;
#pragma unroll
    for (int j = 0; j < 8; ++j) { const int n = (lane >> 3) + 8 * j; const LAS float* sp = scr + (8 * cch) * 65 + n;
        u32x4 o; o.x = cvt_pk_bf16(sp[0 * 65], sp[1 * 65]); o.y = cvt_pk_bf16(sp[2 * 65], sp[3 * 65]); o.z = cvt_pk_bf16(sp[4 * 65], sp[5 * 65]); o.w = cvt_pk_bf16(sp[6 * 65], sp[7 * 65]);
        *(u32x4*)(dst + (size_t)n * K + k0 + 8 * cch) = o; }
    LDS_WAIT(); asm volatile("" ::: "memory");
}
__device__ __forceinline__ void cvt8_load(float (&v)[64], const float* Wsrc, int ldn, int k0, int lane) {
#pragma unroll
    for (int i = 0; i < 64; ++i) v[i] = __builtin_nontemporal_load(Wsrc + (size_t)(k0 + i) * ldn + lane);
}
__device__ __forceinline__ void cvt8_put(const float (&v)[64], LAS float* scr, int lane, float wmul) {
#pragma unroll
    for (int i = 0; i < 64; ++i) scr[i * 65 + lane] = v[i] * wmul;
}
__device__ __forceinline__ void cvt8_out(unsigned char* dst  , int Kb  , int k0, LAS float* scr, int lane) {
    LDS_WAIT(); asm volatile("" ::: "memory");
    const LAS float* sp = scr + lane;
#pragma unroll
    for (int j = 0; j < 4; ++j) { u32x4 o;
        o.x = pk4_fp8(sp[(16 * j + 0) * 65], sp[(16 * j + 1) * 65], sp[(16 * j + 2) * 65], sp[(16 * j + 3) * 65]); o.y = pk4_fp8(sp[(16 * j + 4) * 65], sp[(16 * j + 5) * 65], sp[(16 * j + 6) * 65], sp[(16 * j + 7) * 65]);
        o.z = pk4_fp8(sp[(16 * j + 8) * 65], sp[(16 * j + 9) * 65], sp[(16 * j + 10) * 65], sp[(16 * j + 11) * 65]); o.w = pk4_fp8(sp[(16 * j + 12) * 65], sp[(16 * j + 13) * 65], sp[(16 * j + 14) * 65], sp[(16 * j + 15) * 65]);
        *(u32x4*)(dst + (size_t)lane * Kb + k0 + 16 * j) = o; }
    LDS_WAIT(); asm volatile("" ::: "memory");
}
template <bool SMALL, bool MOE>
__device__ __forceinline__ void prologue_weights(const Ctx& c, int l, int par, LAS unsigned char* lds, int first_wg, int n_wg) {
    int tid_ = threadIdx.x; asm volatile("" : "+v"(tid_)); const int wave = __builtin_amdgcn_readfirstlane(tid_ >> 6), lane = tid_ & 63;
    LAS float* scr = (LAS float*)(lds + wave * 16640);
    const int gw = ((int)blockIdx.x - first_wg) * 8 + wave, NGW = n_wg * 8;
    constexpr int N_WIN = 16 * 217, N_GLU = 18 * 18, N_BS = 32 * 16, N_BA = 6 * 16, N_B5 = 18 * 16, N_WO = 16 * 16, N_GU = 32 * 16 * 32, N_DN = 32 * 16 * 16;
    constexpr int N_SMALL = N_WIN + 2 * N_GLU + N_BS + N_BA + N_B5 + N_WO;
    if (SMALL) {
        bf16_t* Win_t = c.Win_t + par * wsz::WIN; bf16_t* Wglu_t = c.Wglu_t + par * wsz::WGLU; bf16_t* Wbs_t = c.Wbs_t + par * wsz::WBS; bf16_t* Wba_t = c.Wba_t + par * wsz::WBA; bf16_t* Wb5_t = c.Wb5_t + par * wsz::WB5; bf16_t* Wout_t = c.Wout_t + par * wsz::WOUT;
#pragma unroll 1
        for (int it = gw; it < N_SMALL; it += NGW) {
            int r = it; const float* src; bf16_t* dst; int ldn, K, kb; const float* ksc = nullptr;
            if (r < N_WIN) { kb = r / 217; const int n0 = (r % 217) * 64; const int drow = n0 < 9216 ? n0 : (n0 < 9280 ? 13824 + (n0 - 9216) : n0 - 64);
                src = c.in[I_WIN] + (size_t)l * 1024 * md::NIN + n0; ldn = md::NIN; dst = Win_t + (size_t)drow * 1024; K = 1024; }
            else if ((r -= N_WIN) < 2 * N_GLU) { const int w = r / N_GLU; r -= w * N_GLU; kb = r / 18; const int sb = r % 18; const int drow = 256 * (sb / 2) + 64 * (sb % 2) + 128 * w;
                src = c.in[w ? I_GLU2 : I_GLU1] + (size_t)l * 1152 * 1152 + sb * 64; ldn = 1152; dst = Wglu_t + (size_t)drow * 1152; K = 1152; }
            else if ((r -= 2 * N_GLU) < N_BS) { kb = r / 16; const int sb = r % 16; src = c.in[I_WBSSD] + (size_t)l * 2048 * 1024 + sb * 64; ldn = 1024; dst = Wbs_t + (size_t)(sb * 64) * 2048; K = 2048; ksc = c.in[I_NORMW] + (size_t)l * 2048; }
            else if ((r -= N_BS) < N_BA) { kb = r / 16; const int sb = r % 16; src = c.in[I_WBATT] + (size_t)l * 384 * 1024 + sb * 64; ldn = 1024; dst = Wba_t + (size_t)(sb * 64) * 384; K = 384; }
            else if ((r -= N_BA) < N_B5) { kb = r / 16; const int sb = r % 16; src = c.in[I_WBS5] + (size_t)l * 1152 * 1024 + sb * 64; ldn = 1024; dst = Wb5_t + (size_t)(sb * 64) * 1152; K = 1152; }
            else { r -= N_B5; kb = r / 16; const int sb = r % 16; src = c.in[I_WOUT] + (size_t)l * 1024 * 1024 + sb * 64; ldn = 1024; dst = Wout_t + (size_t)(sb * 64) * 1024; K = 1024; }
            cvt_item(src, ldn, dst, K, kb * 64, scr, lane, ksc);
        }
        for (long i = (long)((int)blockIdx.x - first_wg) * NTHREADS + tid_; i < 192 * 1024 / 8; i += (long)n_wg * NTHREADS) *(u32x4*)(Win_t + (size_t)13888 * 1024 + i * 8) = uzero4();
    }
    if (MOE) {
#define MOE_ITEM(r_, src, ldn, dst, kb) do { int r = (r_); \
            if (r < N_GU) { const int e = r / (16 * 32); r -= e * 16 * 32; kb = r / 32; const int sb = r % 32; const int s2 = sb & 15; const int drow = e * 2048 + 256 * (s2 / 2) + 64 * (s2 % 2) + (sb >= 16 ? 128 : 0); \
                src = c.in[I_WGU] + ((size_t)l * 32 + e) * 1024 * 2048 + sb * 64; ldn = 2048; dst = (unsigned char*)c.Wgu_t + (size_t)drow * 1024; } \
            else { r -= N_GU; const int e = r / (16 * 16); r -= e * 16 * 16; kb = r / 16; const int sb = r % 16; \
                src = c.in[I_WDN] + ((size_t)l * 32 + e) * 1024 * 1024 + sb * 64; ldn = 1024; dst = (unsigned char*)c.Wdn_t + (size_t)(e * 1024 + sb * 64) * 1024; } } while (0)
        float v[64]; const float* src; unsigned char* dst; int ldn, kb; int it = gw;
        if (it < N_GU + N_DN) { MOE_ITEM(it, src, ldn, dst, kb); cvt8_load(v, src, ldn, kb * 64, lane); }
#pragma unroll 1
        for (; it < N_GU + N_DN; it += NGW) {
            cvt8_put(v, scr, lane, 64.0f);
            unsigned char* dcur = dst; const int kcur = kb;
            if (it + NGW < N_GU + N_DN) { MOE_ITEM(it + NGW, src, ldn, dst, kb); cvt8_load(v, src, ldn, kb * 64, lane); }
            cvt8_out(dcur, 1024, kcur * 64, scr, lane);
        }
#undef MOE_ITEM
    }
}
__device__ __forceinline__ void cvt_x8(const float* x, bf16_t* o, long i) {
    const f32x4 a = *(const f32x4*)(x + i * 8), b = *(const f32x4*)(x + i * 8 + 4);
    *(u32x4*)(o + i * 8) = pack8(a, b);
}
#endif

#define LOOP(count, stmt) do { unsigned t_ = threadIdx.x; asm volatile("" : "+v"(t_)); const long gth_ = (long)c.grid * NTHREADS; for (long i = (long)blockIdx.x * NTHREADS + t_; i < (long)(count); i += gth_) { stmt; } } while (0)
#define SYNC() xcd_barrier(bar)
constexpr int ox_T = 16384;

#if defined(__HIP_DEVICE_COMPILE__)
constexpr int LDS_TAB = 131072;
constexpr int NSLOT_MAX = 65536 + 32 * 256;
#define SWZ_XOR(v, k) __int_as_float(__builtin_amdgcn_ds_swizzle(__float_as_int(v), ((k) << 10) | 0x1f))
__device__ __forceinline__ float wave_sum(float v) {
    v += SWZ_XOR(v, 1); v += SWZ_XOR(v, 2); v += SWZ_XOR(v, 4); v += SWZ_XOR(v, 8); v += SWZ_XOR(v, 16);
    return __int_as_float(__builtin_amdgcn_readlane(__float_as_int(v), 0)) + __int_as_float(__builtin_amdgcn_readlane(__float_as_int(v), 32));
}
__device__ __forceinline__ void moe_count(const Ctx& c, LAS unsigned char* lds) {
    int tid = threadIdx.x; asm volatile("" : "+v"(tid));
    LAS int* cl = (LAS int*)lds;
    for (int gi = blockIdx.x; gi < ox_T / 64; gi += c.grid) {
        if (tid < 32) cl[tid] = 0;
        __syncthreads();
        if (tid < 256) atomicAdd((int*)(cl + c.topidx[gi * 256 + tid]), 1);
        __syncthreads();
        if (tid < 32) c.moe_cnt[gi * 32 + tid] = cl[tid];
        __syncthreads();
    }
}
__device__ __forceinline__ void moe_assign(const Ctx& c, LAS unsigned char* lds) {
    int tid = threadIdx.x; asm volatile("" : "+v"(tid));
    LAS int* tbl = (LAS int*)lds;
    LAS int* total = tbl + 8192;
    LAS int* pstart = total + 32;
    LAS int* base = pstart + 40;
    LAS int* eids = base + 32;
    __syncthreads();
    for (int i = tid; i < 8192; i += NTHREADS) tbl[i] = c.moe_cnt[i];
    __syncthreads();
    if (tid < 32) { int s = 0; for (int gi = 0; gi < 256; ++gi) s += tbl[gi * 32 + tid]; total[tid] = s; }
    __syncthreads();
    if (tid == 0) { int p = 0; for (int e = 0; e < 32; ++e) { pstart[e] = p; p += (total[e] + 255) / 256 * 256; } pstart[32] = p; }
    __syncthreads();
    if (blockIdx.x == 0 && tid < 33) c.moe_pstart[tid] = pstart[tid];
    if (blockIdx.x == 0 && tid < 288) c.moe_done[tid] = 0;
    for (int e = blockIdx.x; e < 32; e += c.grid) {
        const int r0 = pstart[e] + total[e], r1 = pstart[e + 1];
        for (int i = r0 + tid; i < r1; i += NTHREADS) c.slot_tok[i] = ox_T;
    }
    for (int gi = blockIdx.x; gi < ox_T / 64; gi += c.grid) {
        if (tid < 32) { int s = pstart[tid]; for (int g2 = 0; g2 < gi; ++g2) s += tbl[g2 * 32 + tid]; base[tid] = s; }
        if (tid < 256) eids[tid] = c.topidx[gi * 256 + tid];
        __syncthreads();
        if (tid < 256) { const int e = eids[tid]; int r = 0; for (int a = 0; a < tid; ++a) r += (eids[a] == e) ? 1 : 0;
            const int slot = base[e] + r; c.tok_slot[gi * 256 + tid] = slot; c.slot_gate[slot] = c.gate[gi * 256 + tid]; c.slot_tok[slot] = gi * 64 + (tid >> 2); }
        __syncthreads();
    }
}
__device__ __forceinline__ int xcd_chunk(long L, int n) { const int q = n / 8, r = n % 8, xcd = (int)(L % 8), off = (int)(L / 8); return (xcd < r ? xcd * (q + 1) : r * (q + 1) + (xcd - r) * q) + off; }
__device__ __forceinline__ void moe_early(int nb, int G, int& M, int& first_idle) {
    const int rem = (nb * 8) % G; first_idle = rem; const int idle = rem ? G - rem : 0, left = (nb * 4) % G;
    int m = (left + 31) / 32; if (m > 7 || 32 * m > idle) m = 0;
    M = m;
}
struct MoeOrder {
    const LAS int* blkexp; int nunits, G, c, lgN, mode, nb, M, first_idle;
    __device__ __forceinline__ int base(int x) const { return (x * nb + 7) / 8 + 20; }
    __device__ __forceinline__ bool next(int i, gx::Unit& u) const {
        if (mode == 1) { const int j = c - first_idle; if (i > 0 || j < 0 || j >= 32 * M) return false; const int t = j >> 3; u.pm = base(j & 7) + (t >> 2); u.pn = t & 3; u.e = blkexp[u.pm]; u.f = 0; return true; }
        const long L = (long)i * G + c; if (L >= nunits) return false;
        int id = xcd_chunk(L, nunits); if (mode == 2) id = nunits - 1 - id;
        int pm = id >> lgN, f = 0; u.pn = id & ((1 << lgN) - 1);
        if (mode == 2) { for (int x = 0; x < 8; ++x) pm += (pm >= base(x)) ? M : 0; }
        else { for (int x = 0; x < 8; ++x) f |= ((unsigned)(pm - base(x)) < (unsigned)M) ? 1 : 0; }
        u.pm = pm; u.e = blkexp[pm]; u.f = f; return true;
    }
};
__device__ __forceinline__ void moe_wait_rows(const int* done, int rb, int need = 64) {
    int tid = threadIdx.x; asm volatile("" : "+v"(tid));
    if (tid == 0) { unsigned sp = 0; while (__hip_atomic_load(done + rb, __ATOMIC_RELAXED, __HIP_MEMORY_SCOPE_AGENT) < need && ++sp < (1u << 22)) __builtin_amdgcn_s_sleep(2); }
    __syncthreads();
    __builtin_amdgcn_fence(__ATOMIC_ACQUIRE, "agent");
}
__device__ __forceinline__ int moe_blocks(const Ctx& c, LAS unsigned char* lds) {
    int tid = threadIdx.x; asm volatile("" : "+v"(tid));
    LAS int* blkexp = (LAS int*)(lds + LDS_TAB); LAS int* ps = blkexp + 288;
    if (tid < 33) ps[tid] = c.moe_pstart[tid];
    __syncthreads();
    const int nb = ps[32] / 256;
    if (tid < nb) { int e = 0; for (int k = 1; k < 32; ++k) e += (ps[k] <= tid * 256) ? 1 : 0; blkexp[tid] = e; }
    __syncthreads();
    return nb;
}
struct EpiSwiglu {
    static constexpr bool PERM = true;
    unsigned char* O; const float* bgu; int* done;
    __device__ __forceinline__ void operator()(const f32x4 (&acc)[2][2][4][2], const gx::Unit& u, int wr, int wc, int fr, int fq) const {
        const int row0 = u.pm * 256 + wr * 64 + fr, col = u.pn * 128 + wc * 32 + 8 * fq;
        const float* bp = bgu + (size_t)u.e * 2048 + col;
        const f32x4 bg0 = *(const f32x4*)bp, bg1 = *(const f32x4*)(bp + 4), bl0 = *(const f32x4*)(bp + 1024), bl1 = *(const f32x4*)(bp + 1028);
#pragma unroll
        for (int ai = 0; ai < 2; ++ai)
#pragma unroll
            for (int m = 0; m < 4; ++m) {
                f32x4 o[2];
#pragma unroll
                for (int n = 0; n < 2; ++n) {
                    const f32x4 xg = acc[ai][0][m][n] * (1.0f / 64.0f) + (n ? bg1 : bg0), xl = acc[ai][1][m][n] * (1.0f / 64.0f) + (n ? bl1 : bl0);
#pragma unroll
                    for (int j = 0; j < 4; ++j) { const float a = fminf(xg[j], 7.0f), b = fminf(fmaxf(xl[j], -7.0f), 7.0f); o[n][j] = a * fast_sigmoid(1.702f * a) * (b + 1.0f); }
                }
                u32x2 w; w.x = pk4_fp8(o[0][0], o[0][1], o[0][2], o[0][3]); w.y = pk4_fp8(o[1][0], o[1][1], o[1][2], o[1][3]); unsigned char* dst = O + (size_t)(row0 + ai * 128 + m * 16) * 1024 + col;
                if (u.f) __hip_atomic_store((unsigned long long*)dst, (unsigned long long)w.x | ((unsigned long long)w.y << 32), __ATOMIC_RELAXED, __HIP_MEMORY_SCOPE_AGENT);
                else *(u32x2*)dst = w;
            }
        if (u.f) { asm volatile("s_waitcnt vmcnt(0)" ::: "memory"); if ((fr | fq) == 0) (void)__hip_atomic_fetch_add(done + u.pm, 1, __ATOMIC_RELAXED, __HIP_MEMORY_SCOPE_AGENT); }
    }
};
struct EpiDown {
    static constexpr bool PERM = true;
    bf16_t* O; const float* bdn; const float* sg;
    __device__ __forceinline__ void operator()(const f32x4 (&acc)[2][2][4][2], const gx::Unit& u, int wr, int wc, int fr, int fq) const {
        const int row0 = u.pm * 256 + wr * 64 + fr, cl = u.pn * 256 + wc * 32 + 8 * fq;
        f32x4 b[2][2];
#pragma unroll
        for (int bj = 0; bj < 2; ++bj) { b[bj][0] = *(const f32x4*)(bdn + (size_t)u.e * 1024 + cl + bj * 128); b[bj][1] = *(const f32x4*)(bdn + (size_t)u.e * 1024 + cl + bj * 128 + 4); }
#pragma unroll
        for (int ai = 0; ai < 2; ++ai)
#pragma unroll
            for (int m = 0; m < 4; ++m) { const size_t row = (size_t)(row0 + ai * 128 + m * 16); const float gt = sg[row];
#pragma unroll
                for (int bj = 0; bj < 2; ++bj) *(u32x4*)(O + row * 1024 + cl + bj * 128) = pack8((acc[ai][bj][m][0] * (1.0f / 64.0f) + b[bj][0]) * gt, (acc[ai][bj][m][1] * (1.0f / 64.0f) + b[bj][1]) * gt); }
    }
};
__device__ __forceinline__ void moe_combine_ln(const Ctx& c, const float* g, const float* b, float* out  ) {
    int tid = threadIdx.x; asm volatile("" : "+v"(tid)); const int wave = __builtin_amdgcn_readfirstlane(tid >> 6), lane = tid & 63;
    const int stride = c.grid * 8; int t = blockIdx.x * 8 + wave;
    if (t >= ox_T) return;
    u32x2 xa[4]; u32x2 ya[4][4]; int sn[4];
#define CMB_SLOTS(dst, tt) do { _Pragma("unroll") for (int k = 0; k < 4; ++k) dst[k] = c.tok_slot[(tt) * 4 + k]; } while (0)
#define CMB_ROWS(xd, yd, tt, sl) do { _Pragma("unroll") for (int j = 0; j < 4; ++j) { const int col = lane * 4 + 256 * j; xd[j] = *(const u32x2*)(c.x1b + (size_t)(tt) * 1024 + col); \
        _Pragma("unroll") for (int k = 0; k < 4; ++k) yd[k][j] = *(const u32x2*)(c.ys2 + (size_t)sl[k] * 1024 + col); } } while (0)
    CMB_SLOTS(sn, t); CMB_ROWS(xa, ya, t, sn);
    { const int t1 = t + stride < ox_T ? t + stride : t; CMB_SLOTS(sn, t1); }
#pragma unroll 1
    for (; t < ox_T; t += stride) {
        f32x4 v[4]; float s = 0.f;
#pragma unroll
        for (int j = 0; j < 4; ++j) { f32x4 a = (f32x4){bflo(xa[j].x), bfhi(xa[j].x), bflo(xa[j].y), bfhi(xa[j].y)} * md::ALPHA;
            a[0] += (bflo(ya[0][j].x) + bflo(ya[1][j].x)) + (bflo(ya[2][j].x) + bflo(ya[3][j].x)); a[1] += (bfhi(ya[0][j].x) + bfhi(ya[1][j].x)) + (bfhi(ya[2][j].x) + bfhi(ya[3][j].x));
            a[2] += (bflo(ya[0][j].y) + bflo(ya[1][j].y)) + (bflo(ya[2][j].y) + bflo(ya[3][j].y)); a[3] += (bfhi(ya[0][j].y) + bfhi(ya[1][j].y)) + (bfhi(ya[2][j].y) + bfhi(ya[3][j].y));
            v[j] = a; s += (a[0] + a[1]) + (a[2] + a[3]); }
        { const int t1 = t + stride < ox_T ? t + stride : t, t2 = t + 2 * stride < ox_T ? t + 2 * stride : t; CMB_ROWS(xa, ya, t1, sn); CMB_SLOTS(sn, t2); }
        const float mean = wave_sum(s) * (1.0f / 1024.0f); float q = 0.f;
#pragma unroll
        for (int j = 0; j < 4; ++j) { v[j] = v[j] - mean; q += (v[j][0] * v[j][0] + v[j][1] * v[j][1]) + (v[j][2] * v[j][2] + v[j][3] * v[j][3]); }
        const float rstd = __builtin_amdgcn_rsqf(wave_sum(q) * (1.0f / 1024.0f) + md::EPS);
#pragma unroll
        for (int j = 0; j < 4; ++j) { const int col = lane * 4 + 256 * j; const f32x4 gg = *(const f32x4*)(g + col), bb = *(const f32x4*)(b + col);
            const f32x4 y = v[j] * rstd * gg + bb; if (out) *(f32x4*)(out + (size_t)t * 1024 + col) = y;
            u32x2 w; w.x = cvt_pk_bf16(y[0], y[1]); w.y = cvt_pk_bf16(y[2], y[3]); *(u32x2*)(c.xbf + (size_t)t * 1024 + col) = w; }
    }
#undef CMB_SLOTS
#undef CMB_ROWS
}
namespace ssd {
constexpr int PITCH = 272;
constexpr int XST_OFF = 0;
constexpr int R1_OFF = 69632;
constexpr int R2_OFF = 104448;
constexpr int S1_VEC = 104448;
constexpr int S3_VEC = 139264;
constexpr int NC = 64;
__device__ __forceinline__ size_t st_index(int dir, int b, int cidx, int h) { return ((((size_t)dir * 2 + b) * NC + cidx) * 32 + h) * 8192; }

__device__ __forceinline__ float softplus_fast(float x) { const float e = __expf(-fabsf(x)); return fmaxf(x, 0.0f) + (e < 1e-3f ? e * (1.0f - 0.5f * e) : __logf(1.0f + e)); }

__device__ __forceinline__ float cumsum8(LAS float* a, int wave, int lane) {
    LAS float* p = a + wave * 128 + 2 * lane;
    const float a0 = p[0], a1 = p[1];
    float v = a0 + a1;
#pragma unroll
    for (int off = 1; off < 64; off <<= 1) { const float t = __int_as_float(__builtin_amdgcn_ds_bpermute((lane - off) << 2, __float_as_int(v))); if (lane >= off) v += t; }
    const float total = __int_as_float(__builtin_amdgcn_readlane(__float_as_int(v), 63));
    if (wave < 4) { p[0] = v - a1; p[1] = v; } else { p[0] = total - (v - a1 - a0); p[1] = total - (v - a1); }
    return total;
}
template <int MODE>
__device__ __forceinline__ void load_conv(const Ctx& c, int l, int b, int cidx, int g, LAS unsigned char* lds, int tid) {
    const int cg = tid & 63, lg = tid >> 6;
    if (MODE == 1 && cg >= 48) return;
    const int col = cg < 32 ? 256 * g + 8 * cg : (cg < 48 ? 2048 + 128 * g + 8 * (cg - 32) : 3072 + 128 * g + 8 * (cg - 48));
    const float* cw = c.in[I_CONVW] + (size_t)l * 5 * 4096 + col; const float* cb = c.in[I_CONVB] + (size_t)l * 4096 + col;
    float w[5][8], bias[8];
#pragma unroll
    for (int k = 0; k < 5; ++k) { const f32x4 a = *(const f32x4*)(cw + k * 4096), bq = *(const f32x4*)(cw + k * 4096 + 4);
        w[k][0] = a[0]; w[k][1] = a[1]; w[k][2] = a[2]; w[k][3] = a[3]; w[k][4] = bq[0]; w[k][5] = bq[1]; w[k][6] = bq[2]; w[k][7] = bq[3]; }
    { const f32x4 a = *(const f32x4*)cb, bq = *(const f32x4*)(cb + 4); bias[0] = a[0]; bias[1] = a[1]; bias[2] = a[2]; bias[3] = a[3]; bias[4] = bq[0]; bias[5] = bq[1]; bias[6] = bq[2]; bias[7] = bq[3]; }
    const int tl0 = cidx * 128 + lg * 16 - 2;
    const bf16_t* src = c.XBCb + ((size_t)b * 8192) * 4096 + col;
    u32x4 rows[20];
#pragma unroll
    for (int i = 0; i < 20; ++i) { const int tl = tl0 + i; rows[i] = (tl >= 0 && tl < 8192) ? *(const u32x4*)(src + (size_t)tl * 4096) : uzero4(); }
    unsigned outp[8][8];
#pragma unroll
    for (int lo = 0; lo < 16; lo += 2) {
        float v[2][8];
#pragma unroll
        for (int d = 0; d < 2; ++d) {
#pragma unroll
            for (int j = 0; j < 8; ++j) v[d][j] = bias[j];
#pragma unroll
            for (int k = 0; k < 5; ++k) { const u32x4 r = rows[lo + d + k];
                v[d][0] += w[k][0] * bflo(r.x); v[d][1] += w[k][1] * bfhi(r.x); v[d][2] += w[k][2] * bflo(r.y); v[d][3] += w[k][3] * bfhi(r.y);
                v[d][4] += w[k][4] * bflo(r.z); v[d][5] += w[k][5] * bfhi(r.z); v[d][6] += w[k][6] * bflo(r.w); v[d][7] += w[k][7] * bfhi(r.w); }
#pragma unroll
            for (int j = 0; j < 8; ++j) v[d][j] = v[d][j] * fast_sigmoid(v[d][j]);
        }
        if (MODE == 3 && cg >= 32) {
            LAS unsigned char* base = lds + (cg < 48 ? R2_OFF : R1_OFF) + (8 * (cg < 48 ? cg - 32 : cg - 48)) * 2;
#pragma unroll
            for (int d = 0; d < 2; ++d) { f32x4 v0 = (f32x4){v[d][0], v[d][1], v[d][2], v[d][3]}, v1 = (f32x4){v[d][4], v[d][5], v[d][6], v[d][7]};
                *(LAS u32x4*)(base + (lg * 16 + lo + d) * PITCH) = pack8(v0, v1); }
        } else {
#pragma unroll
            for (int j = 0; j < 8; ++j) outp[j][lo >> 1] = cvt_pk_bf16(v[0][j], v[1][j]);
        }
    }
    if (!(MODE == 3 && cg >= 32)) {
        LAS unsigned char* base = lds + (cg < 32 ? XST_OFF + (8 * cg) * PITCH : R1_OFF + (8 * (cg - 32)) * PITCH) + (lg * 16) * 2;
#pragma unroll
        for (int j = 0; j < 8; ++j) { *(LAS u32x4*)(base + j * PITCH) = (u32x4){outp[j][0], outp[j][1], outp[j][2], outp[j][3]}; *(LAS u32x4*)(base + j * PITCH + 16) = (u32x4){outp[j][4], outp[j][5], outp[j][6], outp[j][7]}; }
    }
}

__device__ __forceinline__ void phase_s1(const Ctx& c, int l, LAS unsigned char* lds) {
    int tid = threadIdx.x;
    LAS float* dl = (LAS float*)(lds + S1_VEC); LAS float* ac = dl + 1024; LAS float* wv = ac + 1024;
    for (int item_ = blockIdx.x; item_ < 1024; item_ += c.grid) { const int item = 1023 - item_;
        asm volatile("" : "+v"(tid));
        const int wave = __builtin_amdgcn_readfirstlane(tid >> 6), lane = tid & 63, fr = lane & 15, q = lane >> 4;
        const int g = item & 7, cidx = (item >> 3) & 63, b = item >> 9; const size_t t0 = (size_t)b * 8192 + cidx * 128;
        load_conv<1>(c, l, b, cidx, g, lds, tid);
#pragma unroll
        for (int k = 0; k < 2; ++k) { const int e = tid + 512 * k, dir = e >> 9, r = (e >> 7) & 3, ll = e & 127, h = 4 * g + r;
            const float delta = softplus_fast(c.dtf[(t0 + ll) * 64 + dir * 32 + h] + c.in[I_DTB][l * 64 + dir * 32 + h]);
            dl[e] = delta; ac[e] = -__expf(c.in[I_ALOG][l * 64 + dir * 32 + h]) * delta; }
        __syncthreads();
        { const float tot = cumsum8(ac, wave, lane); if (lane == 0) c.ssd_tot[(((wave >> 2) * 2 + b) * NC + cidx) * 32 + 4 * g + (wave & 3)] = tot; }
        __syncthreads();
#pragma unroll
        for (int k = 0; k < 2; ++k) { const int e = tid + 512 * k, dir = e >> 9; const float tot = ac[(e & ~127) + (dir ? 0 : 127)]; wv[e] = dl[e] * __expf(tot - ac[e]); }
        __syncthreads();
        {
            const int r = wave & 3, dir = wave >> 2;
            f32x4 acc[8][4];
#pragma unroll
            for (int nt = 0; nt < 8; ++nt)
#pragma unroll
                for (int pt = 0; pt < 4; ++pt) acc[nt][pt] = zero4();
#pragma unroll
            for (int k = 0; k < 4; ++k) {
                const LAS float* wp = wv + (dir * 4 + r) * 128 + 32 * k + 8 * q;
                const f32x4 w0 = *(const LAS f32x4*)wp, w1 = *(const LAS f32x4*)(wp + 4);
                bf16x8 bfrag[4];
#pragma unroll
                for (int pt = 0; pt < 4; ++pt) { const u32x4 x = *(const LAS u32x4*)(lds + XST_OFF + (r * 64 + 16 * pt + fr) * PITCH + (32 * k + 8 * q) * 2);
                    u32x4 y; y.x = cvt_pk_bf16(bflo(x.x) * w0[0], bfhi(x.x) * w0[1]); y.y = cvt_pk_bf16(bflo(x.y) * w0[2], bfhi(x.y) * w0[3]);
                    y.z = cvt_pk_bf16(bflo(x.z) * w1[0], bfhi(x.z) * w1[1]); y.w = cvt_pk_bf16(bflo(x.w) * w1[2], bfhi(x.w) * w1[3]);
                    bfrag[pt] = __builtin_bit_cast(bf16x8, y); }
#pragma unroll
                for (int nt = 0; nt < 8; ++nt) { const bf16x8 af = *(const LAS bf16x8*)(lds + R1_OFF + (16 * nt + fr) * PITCH + (32 * k + 8 * q) * 2);
#pragma unroll
                    for (int pt = 0; pt < 4; ++pt) acc[nt][pt] = __builtin_amdgcn_mfma_f32_16x16x32_bf16(af, bfrag[pt], acc[nt][pt], 0, 0, 0); }
            }
            bf16_t* So = c.ssd_S + st_index(dir, b, cidx, 4 * g + r);
#pragma unroll
            for (int nt = 0; nt < 8; ++nt)
#pragma unroll
                for (int pt = 0; pt < 4; ++pt) { u32x2 o; o.x = cvt_pk_bf16(acc[nt][pt][0], acc[nt][pt][1]); o.y = cvt_pk_bf16(acc[nt][pt][2], acc[nt][pt][3]);
                    *(u32x2*)(So + (size_t)(16 * pt + fr) * 128 + 16 * nt + 4 * q) = o; }
        }
        __syncthreads();
    }
}
__device__ __forceinline__ void phase_s2(const Ctx& c) {
    int tid = threadIdx.x; asm volatile("" : "+v"(tid));
    for (int i = blockIdx.x * NTHREADS + tid; i < 2 * 2 * 32 * 64 * 16; i += c.grid * NTHREADS) {
        const int n8 = i & 15, p = (i >> 4) & 63, h = (i >> 10) & 31, b = (i >> 15) & 1, dir = i >> 16;
        float st[8];
#pragma unroll
        for (int j = 0; j < 8; ++j) st[j] = 0.f;
#pragma unroll 1
        for (int s0 = 0; s0 < NC; s0 += 8) {
            u32x4 x[8]; float dec[8];
#pragma unroll
            for (int u = 0; u < 8; ++u) { const int cidx = dir ? NC - 1 - (s0 + u) : s0 + u;
                x[u] = *(const u32x4*)(c.ssd_S + st_index(dir, b, cidx, h) + p * 128 + n8 * 8); dec[u] = c.ssd_tot[((dir * 2 + b) * NC + cidx) * 32 + h]; }
#pragma unroll
            for (int u = 0; u < 8; ++u) { const int cidx = dir ? NC - 1 - (s0 + u) : s0 + u; const float dq = __expf(dec[u]);
                *(u32x4*)(c.ssd_S + st_index(dir, b, cidx, h) + p * 128 + n8 * 8) = pack8((f32x4){st[0], st[1], st[2], st[3]}, (f32x4){st[4], st[5], st[6], st[7]});
                st[0] = st[0] * dq + bflo(x[u].x); st[1] = st[1] * dq + bfhi(x[u].x); st[2] = st[2] * dq + bflo(x[u].y); st[3] = st[3] * dq + bfhi(x[u].y);
                st[4] = st[4] * dq + bflo(x[u].z); st[5] = st[5] * dq + bfhi(x[u].z); st[6] = st[6] * dq + bflo(x[u].w); st[7] = st[7] * dq + bfhi(x[u].w); }
        }
    }
}
template <bool ZRAW>
__device__ __forceinline__ void phase_s3(const Ctx& c, int l, LAS unsigned char* lds) {
    int tid = threadIdx.x;
    LAS float* acf = (LAS float*)(lds + S3_VEC); LAS float* rcb = acf + 512; LAS float* gf = rcb + 512; LAS float* gb = gf + 512; LAS float* dl = gb + 512; LAS float* ssq = dl + 1024;
    for (int item = blockIdx.x; item < 1024; item += c.grid) {
        asm volatile("" : "+v"(tid));
        const int wave = __builtin_amdgcn_readfirstlane(tid >> 6), lane = tid & 63, fr = lane & 15, q = lane >> 4;
        const int g = item & 7, cidx = (item >> 3) & 63, b = item >> 9; const size_t t0 = (size_t)b * 8192 + cidx * 128;
        const int hrow = tid >> 2, hpart = tid & 3;
        u32x4 hreg[4];
        { const bf16_t* src = c.ssd_S + st_index(hrow >> 6, b, cidx, 4 * g) + (size_t)(hrow & 63) * 128 + hpart * 32;
            hreg[0] = *(const u32x4*)src; hreg[1] = *(const u32x4*)(src + 8); hreg[2] = *(const u32x4*)(src + 16); hreg[3] = *(const u32x4*)(src + 24); }
        load_conv<3>(c, l, b, cidx, g, lds, tid);
#pragma unroll
        for (int k = 0; k < 2; ++k) { const int e = tid + 512 * k, dir = e >> 9, r = (e >> 7) & 3, ll = e & 127, h = 4 * g + r;
            const float delta = softplus_fast(c.dtf[(t0 + ll) * 64 + dir * 32 + h] + c.in[I_DTB][l * 64 + dir * 32 + h]);
            dl[e] = delta; acf[e] = -__expf(c.in[I_ALOG][l * 64 + dir * 32 + h]) * delta; }
        __syncthreads();
        (void)cumsum8(acf, wave, lane);
        __syncthreads();
#pragma unroll
        for (int k = 0; k < 2; ++k) { const int e = tid + 512 * k; gf[e] = __logf(dl[e]) - acf[e]; }
        __syncthreads();
        const int lrow = 16 * wave + fr;
        bf16x8 cfrag[4];
#pragma unroll
        for (int k = 0; k < 4; ++k) cfrag[k] = *(const LAS bf16x8*)(lds + R1_OFF + lrow * PITCH + (32 * k + 8 * q) * 2);
        f32x4 cbt[8];
#pragma unroll
        for (int a = 0; a < 8; ++a) { cbt[a] = zero4();
#pragma unroll
            for (int k = 0; k < 4; ++k) { const bf16x8 bf = *(const LAS bf16x8*)(lds + R2_OFF + (16 * a + fr) * PITCH + (32 * k + 8 * q) * 2);
                cbt[a] = __builtin_amdgcn_mfma_f32_16x16x32_bf16(bf, cfrag[k], cbt[a], 0, 0, 0); } }
        __syncthreads();
        float ssq_l = 0.f;
#pragma unroll 1
        for (int r = 0; r < 4; ++r) {
            const int h = 4 * g + r;
            LAS unsigned char* hb = lds + ((r & 1) ? R1_OFF : R2_OFF);
            { LAS u32x4* dst = (LAS u32x4*)(hb + hrow * PITCH + hpart * 64); dst[0] = hreg[0]; dst[1] = hreg[1]; dst[2] = hreg[2]; dst[3] = hreg[3]; }
            if (r < 3) { const bf16_t* src = c.ssd_S + st_index(hrow >> 6, b, cidx, h + 1) + (size_t)(hrow & 63) * 128 + hpart * 32;
                hreg[0] = *(const u32x4*)src; hreg[1] = *(const u32x4*)(src + 8); hreg[2] = *(const u32x4*)(src + 16); hreg[3] = *(const u32x4*)(src + 24); }
            const size_t trow = t0 + lrow;
            u32x2 zpre[4];
#pragma unroll
            for (int pt = 0; pt < 4; ++pt) zpre[pt] = *(const u32x2*)(c.Zb + trow * 2048 + h * 64 + 16 * pt + 4 * q);
            const float af_l = acf[r * 128 + lrow], rb_l = rcb[r * 128 + lrow], dsk = c.in[I_SSDD][l * 32 + h];
            bf16x8 mfrag[4];
#pragma unroll
            for (int kk = 0; kk < 4; ++kk) {
                float m[8];
#pragma unroll
                for (int half = 0; half < 2; ++half) { const int a = 2 * kk + half, s0 = 16 * a + 4 * q;
                    if (a < wave) {
                        const f32x4 gfv = *(const LAS f32x4*)(gf + r * 128 + s0);
#pragma unroll
                        for (int j = 0; j < 4; ++j) m[half * 4 + j] = cbt[a][j] * __expf(af_l + gfv[j]);
                    } else if (a > wave) {
                        const f32x4 gbv = *(const LAS f32x4*)(gb + r * 128 + s0);
#pragma unroll
                        for (int j = 0; j < 4; ++j) m[half * 4 + j] = cbt[a][j] * __expf(rb_l + gbv[j]);
                    } else {
                        const f32x4 gfv = *(const LAS f32x4*)(gf + r * 128 + s0), gbv = *(const LAS f32x4*)(gb + r * 128 + s0);
#pragma unroll
                        for (int j = 0; j < 4; ++j) { const int s = s0 + j;
                            const float tf = (s <= lrow) ? __expf(af_l + gfv[j]) : 0.f, tb = (s >= lrow) ? __expf(rb_l + gbv[j]) : 0.f;
                            m[half * 4 + j] = cbt[a][j] * (tf + tb) + ((s == lrow) ? dsk : 0.f); } } }
                u32x4 y; y.x = cvt_pk_bf16(m[0], m[1]); y.y = cvt_pk_bf16(m[2], m[3]); y.z = cvt_pk_bf16(m[4], m[5]); y.w = cvt_pk_bf16(m[6], m[7]);
                mfrag[kk] = __builtin_bit_cast(bf16x8, y);
            }
            __syncthreads();
            const float ef = __expf(af_l), eb = __expf(rb_l);
#pragma unroll 1
            for (int ph = 0; ph < 2; ++ph) {
                f32x4 accd[2], accf[2], accb[2];
#pragma unroll
                for (int p2 = 0; p2 < 2; ++p2) { accd[p2] = zero4(); accf[p2] = accd[p2]; accb[p2] = accd[p2]; }
#pragma unroll
                for (int kk = 0; kk < 4; ++kk)
#pragma unroll
                    for (int p2 = 0; p2 < 2; ++p2) { const int pt = 2 * ph + p2;
                        const LAS unsigned char* xr = lds + XST_OFF + (r * 64 + 16 * pt + fr) * PITCH + (32 * kk + 4 * q) * 2;
                        const u32x2 x0 = *(const LAS u32x2*)xr, x1 = *(const LAS u32x2*)(xr + 32);
                        const u32x4 xa = (u32x4){x0.x, x0.y, x1.x, x1.y};
                        accd[p2] = __builtin_amdgcn_mfma_f32_16x16x32_bf16(__builtin_bit_cast(bf16x8, xa), mfrag[kk], accd[p2], 0, 0, 0);
                        const bf16x8 hf = *(const LAS bf16x8*)(hb + (16 * pt + fr) * PITCH + (32 * kk + 8 * q) * 2);
                        const bf16x8 hbk = *(const LAS bf16x8*)(hb + (64 + 16 * pt + fr) * PITCH + (32 * kk + 8 * q) * 2);
                        accf[p2] = __builtin_amdgcn_mfma_f32_16x16x32_bf16(hf, cfrag[kk], accf[p2], 0, 0, 0);
                        accb[p2] = __builtin_amdgcn_mfma_f32_16x16x32_bf16(hbk, cfrag[kk], accb[p2], 0, 0, 0);
                    }
#pragma unroll
                for (int p2 = 0; p2 < 2; ++p2) { const int pt = 2 * ph + p2;
                    const int col = h * 64 + 16 * pt + 4 * q;
                    const u32x2 zw = p2 ? (ph ? zpre[3] : zpre[1]) : (ph ? zpre[2] : zpre[0]);
                    float zz[4] = {bflo(zw.x), bfhi(zw.x), bflo(zw.y), bfhi(zw.y)}, yv[4];
#pragma unroll
                    for (int j = 0; j < 4; ++j) { const float zg = ZRAW ? zz[j] * fast_sigmoid(zz[j]) : zz[j]; yv[j] = (accd[p2][j] + ef * accf[p2][j] + eb * accb[p2][j]) * zg; ssq_l += yv[j] * yv[j]; }
                    u32x2 o; o.x = cvt_pk_bf16(yv[0], yv[1]); o.y = cvt_pk_bf16(yv[2], yv[3]);
                    *(u32x2*)(c.yssdb + trow * 2048 + col) = o;
                }
            }
        }
        ssq[lrow * 4 + q] = ssq_l;
        __syncthreads();
        if (tid < 128) c.ssd_ssq[(t0 + tid) * 8 + g] = (ssq[tid * 4] + ssq[tid * 4 + 1]) + (ssq[tid * 4 + 2] + ssq[tid * 4 + 3]);
        __syncthreads();
    }
}
}
namespace s5 {
constexpr int NROWS = 72 * 1024;
__device__ __forceinline__ void prologue(const Ctx& c, int l, int par, LAS unsigned char* lds, int first_wg, int n_wg) {
    int tid = threadIdx.x; asm volatile("" : "+v"(tid));
    LAS float* pw = (LAS float*)lds;
    LAS float* bb = pw + 2 * 17 * 64 * 2;
    LAS float* cc = bb + 2 * 64 * 16 * 2;
    LAS float* Kt = cc + 2 * 16 * 64 * 2;
    __syncthreads();
    for (int g = (int)blockIdx.x >= first_wg ? (int)blockIdx.x - first_wg : 72; g < 72; g += n_wg) {
        if (tid < 128) { const int d = tid >> 6, n = tid & 63;
            const float ar = c.in[I_S5ARE][((size_t)(l * 2 + d) * 72 + g) * 64 + n], ai = c.in[I_S5AIM][((size_t)(l * 2 + d) * 72 + g) * 64 + n];
            const float step = __expf(c.in[I_S5LS][(l * 2 + d) * 72 + g]);
            const float mag = __expf(step * ar); const float abr = mag * __cosf(step * ai), abi = mag * __sinf(step * ai);
            const float rden = __builtin_amdgcn_rcpf(ar * ar + ai * ai); const float fr = ((abr - 1.0f) * ar + abi * ai) * rden, fi = (abi * ar - (abr - 1.0f) * ai) * rden;
#pragma clang loop unroll(disable)
            for (int ch = 0; ch < 16; ++ch) { const float br = c.in[I_S5BRE][(((size_t)l * 72 + g) * 64 + n) * 16 + ch], bi = c.in[I_S5BIM][(((size_t)l * 72 + g) * 64 + n) * 16 + ch];
                bb[((d * 64 + n) * 16 + ch) * 2] = fr * br - fi * bi; bb[((d * 64 + n) * 16 + ch) * 2 + 1] = fr * bi + fi * br; }
            float pr = 1.0f, pi = 0.0f;
#pragma clang loop unroll(disable)
            for (int j = 0; j <= 16; ++j) { pw[((d * 17 + j) * 64 + n) * 2] = pr; pw[((d * 17 + j) * 64 + n) * 2 + 1] = pi; const float nr = pr * abr - pi * abi, ni = pr * abi + pi * abr; pr = nr; pi = ni; }
            float* a16 = c.s5_a16 + par * wsz::A16; a16[((g * 2 + d) * 64 + n) * 2] = pw[((d * 17 + 16) * 64 + n) * 2]; a16[((g * 2 + d) * 64 + n) * 2 + 1] = pw[((d * 17 + 16) * 64 + n) * 2 + 1]; }
        for (int i = tid; i < 2 * 16 * 64; i += NTHREADS) { const int d = i >> 10, ch = (i >> 6) & 15, n = i & 63;
            cc[i * 2] = c.in[I_S5CRE][(((size_t)(l * 2 + d) * 72 + g) * 16 + ch) * 64 + n]; cc[i * 2 + 1] = c.in[I_S5CIM][(((size_t)(l * 2 + d) * 72 + g) * 16 + ch) * 64 + n]; }
        __syncthreads();
        for (int i = tid; i < 2 * 16 * 256; i += NTHREADS) { const int d = i >> 12, j = (i >> 8) & 15, ch = (i >> 4) & 15, c2 = i & 15; float s = 0.f;
            for (int n = 0; n < 64; ++n) { const float cr = cc[((d * 16 + ch) * 64 + n) * 2], ci = cc[((d * 16 + ch) * 64 + n) * 2 + 1], pr = pw[((d * 17 + j) * 64 + n) * 2], pi = pw[((d * 17 + j) * 64 + n) * 2 + 1];
                const float wr = cr * pr - ci * pi, wi = cr * pi + ci * pr; s += wr * bb[((d * 64 + n) * 16 + c2) * 2] - wi * bb[((d * 64 + n) * 16 + c2) * 2 + 1]; }
            Kt[i] = s; }
        __syncthreads();
        bf16_t* W1 = c.s5_W1 + par * wsz::S5W1 + (size_t)g * 512 * 256; bf16_t* Qm = c.s5_Q + par * wsz::S5Q + (size_t)g * 256 * 256;
        for (int i = tid; i < 256 * 256 / 2; i += NTHREADS) { const int row = i >> 7, col = (i & 127) * 2; const int l1 = row >> 4, c1 = row & 15, l2 = col >> 4, c2 = col & 15; float v[2];
#pragma unroll
            for (int e = 0; e < 2; ++e) { float s = 0.f; if (l2 <= l1) s += Kt[((0 * 16 + (l1 - l2)) * 16 + c1) * 16 + c2 + e]; if (l2 >= l1) s += Kt[((1 * 16 + (l2 - l1)) * 16 + c1) * 16 + c2 + e]; v[e] = s; }
            *(unsigned*)(W1 + (size_t)row * 256 + col) = cvt_pk_bf16(v[0], v[1]); }
        for (int i = tid; i < 256 * 256 / 2; i += NTHREADS) { const int row = i >> 7, col = (i & 127) * 2; const int d = row >> 7, part = (row >> 6) & 1, n = row & 63, l2 = col >> 4, c2 = col & 15;
            const int j = d ? l2 : 15 - l2; const float pr = pw[((d * 17 + j) * 64 + n) * 2], pi = pw[((d * 17 + j) * 64 + n) * 2 + 1]; float v[2];
#pragma unroll
            for (int e = 0; e < 2; ++e) { const float br = bb[((d * 64 + n) * 16 + c2 + e) * 2], bi = bb[((d * 64 + n) * 16 + c2 + e) * 2 + 1]; v[e] = part ? (pr * bi + pi * br) : (pr * br - pi * bi); }
            *(unsigned*)(W1 + (size_t)(256 + row) * 256 + col) = cvt_pk_bf16(v[0], v[1]); }
        for (int i = tid; i < 256 * 256 / 2; i += NTHREADS) { const int row = i >> 7, col = (i & 127) * 2; const int l1 = row >> 4, c1 = row & 15, d = col >> 7, part = (col >> 6) & 1, n = col & 63;
            const int j = d ? 16 - l1 : l1 + 1; float v[2];
#pragma unroll
            for (int e = 0; e < 2; ++e) { const float cr = cc[((d * 16 + c1) * 64 + n + e) * 2], ci = cc[((d * 16 + c1) * 64 + n + e) * 2 + 1], pr = pw[((d * 17 + j) * 64 + n + e) * 2], pi = pw[((d * 17 + j) * 64 + n + e) * 2 + 1];
                v[e] = part ? -(cr * pi + ci * pr) : (cr * pr - ci * pi); }
            *(unsigned*)(Qm + (size_t)row * 256 + col) = cvt_pk_bf16(v[0], v[1]); }
        __syncthreads();
    }
}
struct Order { int nunits, G, c, lgN, rev, mode;
    __device__ __forceinline__ int late_cnt() const { return (nunits > G && nunits <= 2 * G) ? nunits - G : 0; }
    __device__ __forceinline__ bool next(int i, gx::Unit& u) const {
        long L = (long)i * G + c; const int lc = late_cnt();
        if (mode == 2) { const int g3 = 576 % G, off = (g3 + lc <= G) ? g3 : 0, j = c - off; if (i > 0 || j < 0 || j >= lc) return false; L = G + j; }
        else if (L >= nunits || (mode == 1 && lc > 0 && i > 0)) return false;
        int id = xcd_chunk(L, nunits); if (rev) id = nunits - 1 - id; u.pm = (int)(id >> lgN); u.pn = (int)(id & ((1 << lgN) - 1)); u.e = u.pm >> 2; u.f = (mode == 2) ? 1 : 0; return true; } };
struct Epi1 {
    static constexpr bool PERM = true;
    bf16_t* Y; bf16_t* S;
    __device__ __forceinline__ void operator()(const f32x4 (&acc)[2][2][4][2], const gx::Unit& u, int wr, int wc, int fr, int fq) const {
        const int row0 = u.pm * 256 + wr * 64 + fr, cl = wc * 32 + 8 * fq;
#pragma unroll
        for (int ai = 0; ai < 2; ++ai)
#pragma unroll
            for (int m = 0; m < 4; ++m)
#pragma unroll
                for (int bj = 0; bj < 2; ++bj) { const size_t off = (size_t)(row0 + ai * 128 + m * 16) * 256 + bj * 128 + cl;
                    *(u32x4*)((u.pn == 0 ? Y : S) + off) = pack8(acc[ai][bj][m][0], acc[ai][bj][m][1]); }
    }
};
__device__ __forceinline__ void scan(const Ctx& c, int par, LAS unsigned char* lds) {
    int tid = threadIdx.x; asm volatile("" : "+v"(tid)); const int nl = tid & 31, seg = tid >> 5;
    LAS float* seg_r = (LAS float*)lds; LAS float* seg_i = seg_r + 512;
    __syncthreads();
    for (int item = blockIdx.x; item < 576; item += c.grid) {
        const int nh = item & 1, d = (item >> 1) & 1, b = (item >> 2) & 1, g = item >> 3, n = nh * 32 + nl;
        const float ar = c.s5_a16[par * wsz::A16 + ((g * 2 + d) * 64 + n) * 2], ai = c.s5_a16[par * wsz::A16 + ((g * 2 + d) * 64 + n) * 2 + 1];
        const size_t base = ((size_t)g * 1024 + b * 512) * 256 + d * 128 + n;
        float lr[32], li[32];
#pragma unroll
        for (int j = 0; j < 32; ++j) { const int p = 32 * seg + j; const size_t o = base + (size_t)(d ? 511 - p : p) * 256; lr[j] = bf2f(c.s5_Sloc[o]); li[j] = bf2f(c.s5_Sloc[o + 64]); }
        float sr = 0.f, si = 0.f;
#pragma unroll
        for (int j = 0; j < 32; ++j) { const float nr = ar * sr - ai * si + lr[j], ni = ar * si + ai * sr + li[j]; sr = nr; si = ni; }
        seg_r[seg * 32 + nl] = sr; seg_i[seg * 32 + nl] = si;
        float pr = ar, pi = ai;
#pragma unroll
        for (int q = 0; q < 5; ++q) { const float nr = pr * pr - pi * pi, ni = 2.0f * pr * pi; pr = nr; pi = ni; }
        __syncthreads();
        float cr = 0.f, ci = 0.f;
        for (int s2 = 0; s2 < seg; ++s2) { const float er = seg_r[s2 * 32 + nl], ei = seg_i[s2 * 32 + nl]; const float nr = pr * cr - pi * ci + er, ni = pr * ci + pi * cr + ei; cr = nr; ci = ni; }
        sr = cr; si = ci;
#pragma unroll
        for (int j = 0; j < 32; ++j) { const int p = 32 * seg + j; const size_t o = base + (size_t)(d ? 511 - p : p) * 256;
            c.s5_Sin[o] = (bf16_t)f2bf(sr); c.s5_Sin[o + 64] = (bf16_t)f2bf(si);
            const float nr = ar * sr - ai * si + lr[j], ni = ar * si + ai * sr + li[j]; sr = nr; si = ni; }
        __syncthreads();
    }
}
struct Epi2 {
    static constexpr bool PERM = true;
    const bf16_t* Y; const bf16_t* U; const float* dsk; bf16_t* O; int* done;
    __device__ __forceinline__ void operator()(const f32x4 (&acc)[2][2][4][2], const gx::Unit& u, int wr, int wc, int fr, int fq) const {
        const int row0 = u.pm * 256 + wr * 64 + fr, cl = wc * 32 + 8 * fq, g = u.e, c0 = cl & 15;
        const f32x4 d0 = *(const f32x4*)(dsk + g * 16 + c0), d1 = *(const f32x4*)(dsk + g * 16 + c0 + 4);
#pragma unroll
        for (int ai = 0; ai < 2; ++ai) {
            u32x4 yw[4][2], uw[4][2];
#pragma unroll
            for (int m = 0; m < 4; ++m)
#pragma unroll
                for (int bj = 0; bj < 2; ++bj) { const size_t off = (size_t)(row0 + ai * 128 + m * 16) * 256 + bj * 128 + cl; yw[m][bj] = *(const u32x4*)(Y + off); uw[m][bj] = *(const u32x4*)(U + off); }
#pragma unroll
            for (int m = 0; m < 4; ++m)
#pragma unroll
                for (int bj = 0; bj < 2; ++bj) { const int R = row0 + ai * 128 + m * 16, col = bj * 128 + cl; const int tok = (R & 1023) * 16 + (col >> 4);
                    const u32x4 y4 = yw[m][bj], u4 = uw[m][bj];
                    f32x4 v0 = acc[ai][bj][m][0] + (f32x4){bflo(y4.x), bfhi(y4.x), bflo(y4.y), bfhi(y4.y)} + d0 * (f32x4){bflo(u4.x), bfhi(u4.x), bflo(u4.y), bfhi(u4.y)};
                    f32x4 v1 = acc[ai][bj][m][1] + (f32x4){bflo(y4.z), bfhi(y4.z), bflo(y4.w), bfhi(y4.w)} + d1 * (f32x4){bflo(u4.z), bfhi(u4.z), bflo(u4.w), bfhi(u4.w)};
#pragma unroll
                    for (int j = 0; j < 4; ++j) { const float a = v0[j], bq = v1[j];
                        v0[j] = a * fast_sigmoid(1.5957691216f * (a + 0.044715f * a * a * a)); v1[j] = bq * fast_sigmoid(1.5957691216f * (bq + 0.044715f * bq * bq * bq)); }
                    const u32x4 w = pack8(v0, v1); bf16_t* dst = O + (size_t)tok * 1152 + g * 16 + c0;
                    if (u.f) {
                        __hip_atomic_store((unsigned long long*)dst, (unsigned long long)w.x | ((unsigned long long)w.y << 32), __ATOMIC_RELAXED, __HIP_MEMORY_SCOPE_AGENT);
                        __hip_atomic_store((unsigned long long*)dst + 1, (unsigned long long)w.z | ((unsigned long long)w.w << 32), __ATOMIC_RELAXED, __HIP_MEMORY_SCOPE_AGENT);
                    } else *(u32x4*)dst = w; }
        }
        if (u.f) { asm volatile("s_waitcnt vmcnt(0)" ::: "memory"); if ((fr | fq) == 0) (void)__hip_atomic_fetch_add(done, 1, __ATOMIC_RELAXED, __HIP_MEMORY_SCOPE_AGENT); }
    }
};
}
namespace att {
constexpr int KP = 144, VP = 776;
constexpr int K_OFF = 0, VT_OFF = 384 * KP;
typedef float f32x16 __attribute__((ext_vector_type(16)));
__device__ __forceinline__ f32x16 zero16() { float z = 0.f; asm volatile("" : "+v"(z)); return (f32x16){z, z, z, z, z, z, z, z, z, z, z, z, z, z, z, z}; }
__device__ __forceinline__ void phase(const Ctx& c, LAS unsigned char* lds) {
    int tid = threadIdx.x;
    for (int item = ((int)blockIdx.x + c.grid / 2) % c.grid; item < 1152; item += c.grid) {
        asm volatile("" : "+v"(tid));
        const int wave = __builtin_amdgcn_readfirstlane(tid >> 6), lane = tid & 63, lr = lane & 31, hh = lane >> 5;
        const int itm = 1151 - item;
        const int blk = itm & 31, rest = itm >> 5, h = rest % 6, g = (rest / 6) % 3, b = rest / 18;
        const int dil = g == 0 ? 1 : (g == 1 ? 4 : 16), ls = 8192 / dil, ipc = 32 / dil, r = blk / ipc, i0 = (blk % ipc) * 256;
        const float slope = __builtin_amdgcn_exp2f((float)(h * 3 + g + 1) * (-8.0f / 18.0f)) * (float)dil;
        const bf16_t* qkv = c.QKVU + (size_t)b * 8192 * 4608 + g * 384 + h * 64;
        for (int u = tid; u < 384 * 8; u += NTHREADS) { const int kl = u >> 3, part = u & 7, ik = i0 - 64 + kl;
            u32x4 v = uzero4();
            if (ik >= 0 && ik < ls) v = *(const u32x4*)(qkv + (size_t)(ik * dil + r) * 4608 + 1152 + part * 8);
            *(LAS u32x4*)(lds + K_OFF + kl * KP + part * 16) = v; }
        for (int u = tid; u < 192 * 8; u += NTHREADS) { const int part = u / 192, kp = u % 192, ik = i0 - 64 + 2 * kp;
            u32x4 v0 = uzero4(), v1 = v0;
            if (ik >= 0 && ik < ls) v0 = *(const u32x4*)(qkv + (size_t)(ik * dil + r) * 4608 + 2304 + part * 8);
            if (ik + 1 >= 0 && ik + 1 < ls) v1 = *(const u32x4*)(qkv + (size_t)((ik + 1) * dil + r) * 4608 + 2304 + part * 8);
            LAS unsigned char* dst = lds + VT_OFF + (part * 8) * VP + kp * 4;
            *(LAS unsigned*)(dst + 0 * VP) = (v0.x & 0xffffu) | (v1.x << 16); *(LAS unsigned*)(dst + 1 * VP) = (v0.x >> 16) | (v1.x & 0xffff0000u);
            *(LAS unsigned*)(dst + 2 * VP) = (v0.y & 0xffffu) | (v1.y << 16); *(LAS unsigned*)(dst + 3 * VP) = (v0.y >> 16) | (v1.y & 0xffff0000u);
            *(LAS unsigned*)(dst + 4 * VP) = (v0.z & 0xffffu) | (v1.z << 16); *(LAS unsigned*)(dst + 5 * VP) = (v0.z >> 16) | (v1.z & 0xffff0000u);
            *(LAS unsigned*)(dst + 6 * VP) = (v0.w & 0xffffu) | (v1.w << 16); *(LAS unsigned*)(dst + 7 * VP) = (v0.w >> 16) | (v1.w & 0xffff0000u); }
        const int q0 = 32 * wave, iq = i0 + q0 + lr;
        const size_t tq = (size_t)(iq * dil + r);
        bf16x8 qf[4];
#pragma unroll
        for (int ks = 0; ks < 4; ++ks) qf[ks] = *(const bf16x8*)(qkv + tq * 4608 + 16 * ks + 8 * hh);
        __syncthreads();
        f32x16 st[5];
#pragma unroll
        for (int kt = 0; kt < 5; ++kt) { st[kt] = zero16();
#pragma unroll
            for (int ks = 0; ks < 4; ++ks) { const bf16x8 kf = *(const LAS bf16x8*)(lds + K_OFF + (q0 + 32 * kt + lr) * KP + (16 * ks + 8 * hh) * 2);
                st[kt] = __builtin_amdgcn_mfma_f32_32x32x16_bf16(kf, qf[ks], st[kt], 0, 0, 0); } }
        float mx = -1e30f;
        int dlt = 4 * hh - lr; asm volatile("" : "+v"(dlt));
        const int ikb = i0 - 64 + q0 + 4 * hh;
#pragma unroll
        for (int kt = 0; kt < 5; ++kt)
#pragma unroll
            for (int reg = 0; reg < 16; ++reg) { const int kc = 32 * kt + (reg & 3) + 8 * (reg >> 2);
                const int d = kc - 64 + dlt, dist = d < 0 ? -d : d, ik = ikb + kc;
                const bool ok = dist <= 64 && ik >= 0 && ik < ls;
                const float s = ok ? st[kt][reg] * 0.125f - slope * (float)dist : -1e30f;
                st[kt][reg] = s; mx = fmaxf(mx, s); }
        mx = fmaxf(mx, __int_as_float(__builtin_amdgcn_ds_bpermute((lane ^ 32) << 2, __float_as_int(mx))));
        float sum = 0.f;
#pragma unroll
        for (int kt = 0; kt < 5; ++kt)
#pragma unroll
            for (int reg = 0; reg < 16; ++reg) { const float p = st[kt][reg] > -1e29f ? __expf(st[kt][reg] - mx) : 0.f; st[kt][reg] = p; sum += p; }
        sum += __int_as_float(__builtin_amdgcn_ds_bpermute((lane ^ 32) << 2, __float_as_int(sum)));
        f32x16 o[2];
#pragma unroll
        for (int dt = 0; dt < 2; ++dt) o[dt] = zero16();
#pragma unroll
        for (int kt = 0; kt < 5; ++kt)
#pragma unroll
            for (int s2 = 0; s2 < 2; ++s2) {
                u32x4 pw; pw.x = cvt_pk_bf16(st[kt][8 * s2 + 0], st[kt][8 * s2 + 1]); pw.y = cvt_pk_bf16(st[kt][8 * s2 + 2], st[kt][8 * s2 + 3]);
                pw.z = cvt_pk_bf16(st[kt][8 * s2 + 4], st[kt][8 * s2 + 5]); pw.w = cvt_pk_bf16(st[kt][8 * s2 + 6], st[kt][8 * s2 + 7]);
                const bf16x8 pf = __builtin_bit_cast(bf16x8, pw);
#pragma unroll
                for (int dt = 0; dt < 2; ++dt) { const LAS unsigned char* vp = lds + VT_OFF + (32 * dt + lr) * VP + (q0 + 32 * kt + 16 * s2 + 4 * hh) * 2;
                    const u32x2 a0 = *(const LAS u32x2*)vp, a1 = *(const LAS u32x2*)(vp + 16);
                    const u32x4 av = (u32x4){a0.x, a0.y, a1.x, a1.y};
                    o[dt] = __builtin_amdgcn_mfma_f32_32x32x16_bf16(__builtin_bit_cast(bf16x8, av), pf, o[dt], 0, 0, 0); }
            }
        const float inv = __builtin_amdgcn_rcpf(sum); const size_t tglob = (size_t)b * 8192 + tq;
        bf16_t* op = c.attob + ((size_t)g * 16384 + tglob) * 384 + h * 64;
#pragma unroll
        for (int dt = 0; dt < 2; ++dt)
#pragma unroll
            for (int rg = 0; rg < 4; ++rg) { u32x2 w; w.x = cvt_pk_bf16(o[dt][4 * rg + 0] * inv, o[dt][4 * rg + 1] * inv); w.y = cvt_pk_bf16(o[dt][4 * rg + 2] * inv, o[dt][4 * rg + 3] * inv);
                *(u32x2*)(op + 32 * dt + 8 * rg + 4 * hh) = w; }
        if (hh == 0) c.attlse[((size_t)g * 16384 + tglob) * 6 + h] = mx + __logf(sum);
        __syncthreads();
    }
}
__device__ __forceinline__ void combine(const Ctx& c, long i) {
    const int c8 = (int)(i % 48); const long t = i / 48; const int h = c8 >> 3;
    const float l0 = c.attlse[((size_t)0 * 16384 + t) * 6 + h], l1 = c.attlse[((size_t)1 * 16384 + t) * 6 + h], l2 = c.attlse[((size_t)2 * 16384 + t) * 6 + h];
    const float m = fmaxf(l0, fmaxf(l1, l2)); float w0 = __expf(l0 - m), w1 = __expf(l1 - m), w2 = __expf(l2 - m); const float inv = __builtin_amdgcn_rcpf(w0 + w1 + w2); w0 *= inv; w1 *= inv; w2 *= inv;
    const u32x4 a = *(const u32x4*)(c.attob + ((size_t)0 * 16384 + t) * 384 + c8 * 8), bq = *(const u32x4*)(c.attob + ((size_t)1 * 16384 + t) * 384 + c8 * 8), cq = *(const u32x4*)(c.attob + ((size_t)2 * 16384 + t) * 384 + c8 * 8);
    f32x4 v0, v1;
    v0[0] = w0 * bflo(a.x) + w1 * bflo(bq.x) + w2 * bflo(cq.x); v0[1] = w0 * bfhi(a.x) + w1 * bfhi(bq.x) + w2 * bfhi(cq.x);
    v0[2] = w0 * bflo(a.y) + w1 * bflo(bq.y) + w2 * bflo(cq.y); v0[3] = w0 * bfhi(a.y) + w1 * bfhi(bq.y) + w2 * bfhi(cq.y);
    v1[0] = w0 * bflo(a.z) + w1 * bflo(bq.z) + w2 * bflo(cq.z); v1[1] = w0 * bfhi(a.z) + w1 * bfhi(bq.z) + w2 * bfhi(cq.z);
    v1[2] = w0 * bflo(a.w) + w1 * bflo(bq.w) + w2 * bflo(cq.w); v1[3] = w0 * bfhi(a.w) + w1 * bfhi(bq.w) + w2 * bfhi(cq.w);
    *(u32x4*)(c.yattb + t * 384 + c8 * 8) = pack8(v0, v1);
}
}
namespace lnr {
constexpr int XP = 1028;
constexpr int PART_OFF = 16 * XP * 4, CNT_OFF = PART_OFF + 8 * 16 * 32 * 4, GB_OFF = CNT_OFF + 128;
__device__ __forceinline__ void phase(const Ctx& c, int l, LAS unsigned char* lds) {
    int tid = threadIdx.x; asm volatile("" : "+v"(tid)); const int wave = __builtin_amdgcn_readfirstlane(tid >> 6), lane = tid & 63;
    const bf16_t* xin = c.xbf;
    LAS float* xf = (LAS float*)lds; LAS float* part = (LAS float*)(lds + PART_OFF); LAS int* cnt_l = (LAS int*)(lds + CNT_OFF);
    float wreg[2][32];
    { const float* rw = c.in[I_RW] + (size_t)l * 1024 * 32 + (size_t)(128 * wave + 4 * (lane >> 4)) * 32 + (lane & 15);
#pragma unroll
      for (int s4 = 0; s4 < 8; ++s4)
#pragma unroll
        for (int i = 0; i < 4; ++i) { wreg[0][4 * s4 + i] = rw[(16 * s4 + i) * 32]; wreg[1][4 * s4 + i] = rw[(16 * s4 + i) * 32 + 16]; } }
    LAS float* gb = (LAS float*)(lds + GB_OFF);
    __syncthreads();
    for (int i = tid; i < 1024; i += NTHREADS) { gb[i] = c.in[I_LN1G][l * 1024 + i]; gb[1024 + i] = c.in[I_LN1B][l * 1024 + i]; }
    const float rbias = c.in[I_RB][l * 32 + (lane & 31)];
    __syncthreads();
    float xn[16], mn[16];
#define LNR_LOAD(tok) do { const size_t b0_ = (size_t)(tok) * 1024 + 4 * lane; _Pragma("unroll") for (int jq = 0; jq < 4; ++jq) { const u32x2 xv = *(const u32x2*)(xin + b0_ + 256 * jq), mv = *(const u32x2*)(c.mixb + b0_ + 256 * jq); \
        xn[4 * jq] = bflo(xv.x); xn[4 * jq + 1] = bfhi(xv.x); xn[4 * jq + 2] = bflo(xv.y); xn[4 * jq + 3] = bfhi(xv.y); mn[4 * jq] = bflo(mv.x); mn[4 * jq + 1] = bfhi(mv.x); mn[4 * jq + 2] = bflo(mv.y); mn[4 * jq + 3] = bfhi(mv.y); } } while (0)
    if ((int)blockIdx.x < ox_T / 64) LNR_LOAD(blockIdx.x * 64 + wave * 2);
#pragma unroll 1
    for (int gi = blockIdx.x; gi < ox_T / 64; gi += c.grid) {
      if (tid < 32) cnt_l[tid] = 0;
#pragma unroll 1
      for (int q = 0; q < 4; ++q) {
        int tid2 = tid; asm volatile("" : "+v"(tid2)); const int lane = tid2 & 63;
#pragma unroll 1
        for (int tt = 0; tt < 2; ++tt) {
          const int t = gi * 64 + 16 * q + 2 * wave + tt;
          float x[16];
          const size_t base = (size_t)t * 1024 + 4 * lane; float s = 0.f;
#pragma unroll
          for (int j = 0; j < 16; ++j) { x[j] = md::ALPHA * xn[j] + mn[j]; s += x[j]; }
          { const int tn = tt == 0 ? t + 1 : (q < 3 ? t + 15 : (gi + c.grid < ox_T / 64 ? (gi + c.grid) * 64 + 2 * wave : t)); LNR_LOAD(tn); }
          const float mean = wave_sum(s) * (1.0f / 1024.0f); float qq = 0.f;
#pragma unroll
          for (int j = 0; j < 16; ++j) { x[j] -= mean; qq += x[j] * x[j]; }
          float eps_ = md::EPS; asm volatile("" : "+v"(eps_));
          const float rstd = __builtin_amdgcn_rsqf(wave_sum(qq) * (1.0f / 1024.0f) + eps_);
          LAS float* xrow = xf + (2 * wave + tt) * XP + 4 * lane;
#pragma unroll
          for (int jq = 0; jq < 4; ++jq) { const f32x4 g4 = *(const LAS f32x4*)(gb + 4 * lane + 256 * jq), b4 = *(const LAS f32x4*)(gb + 1024 + 4 * lane + 256 * jq);
              f32x4 y; y[0] = x[4 * jq] * rstd * g4[0] + b4[0]; y[1] = x[4 * jq + 1] * rstd * g4[1] + b4[1]; y[2] = x[4 * jq + 2] * rstd * g4[2] + b4[2]; y[3] = x[4 * jq + 3] * rstd * g4[3] + b4[3];
              u32x2 w; w.x = cvt_pk_bf16(y[0], y[1]); w.y = cvt_pk_bf16(y[2], y[3]);
              *(u32x2*)(c.x1b + base + 256 * jq) = w; *(unsigned*)(c.x1q + base + 256 * jq) = pk4_fp8(y[0], y[1], y[2], y[3]);
              *(LAS f32x4*)(xrow + 256 * jq) = y; }
        }
        __syncthreads();
        {
            f32x4 acc0 = zero4(), acc1 = zero4();
            const LAS float* ap = xf + (lane & 15) * XP + 128 * wave + 4 * (lane >> 4);
#pragma unroll
            for (int s4 = 0; s4 < 8; ++s4) { const f32x4 av = *(const LAS f32x4*)(ap + 16 * s4);
#pragma unroll
                for (int i = 0; i < 4; ++i) { acc0 = __builtin_amdgcn_mfma_f32_16x16x4f32(av[i], wreg[0][4 * s4 + i], acc0, 0, 0, 0); acc1 = __builtin_amdgcn_mfma_f32_16x16x4f32(av[i], wreg[1][4 * s4 + i], acc1, 0, 0, 0); } }
            LAS float* pp = part + (wave * 16 + 4 * (lane >> 4)) * 32 + (lane & 15);
#pragma unroll
            for (int r = 0; r < 4; ++r) { pp[r * 32] = acc0[r]; pp[r * 32 + 16] = acc1[r]; }
        }
        __syncthreads();
        {
            const int tl = 2 * wave + (lane >> 5), t = gi * 64 + 16 * q + tl;
            float v1 = rbias;
#pragma unroll
            for (int w2 = 0; w2 < 8; ++w2) v1 += part[(w2 * 16 + tl) * 32 + (lane & 31)];
            float tv[4]; int ti[4]; float neg_ = -3.0e38f; asm volatile("" : "+v"(neg_));
#pragma unroll
            for (int k = 0; k < 4; ++k) {
                float m = v1;
                m = fmaxf(m, SWZ_XOR(m, 1)); m = fmaxf(m, SWZ_XOR(m, 2)); m = fmaxf(m, SWZ_XOR(m, 4)); m = fmaxf(m, SWZ_XOR(m, 8)); m = fmaxf(m, SWZ_XOR(m, 16));
                const unsigned long long mask = __ballot(v1 == m);
                const unsigned mh = (unsigned)(mask >> (lane & 32));
                const int first = __builtin_ctz(mh);
                tv[k] = m; ti[k] = first;
                if ((lane & 31) == first) v1 = neg_;
            }
            const float e1 = __expf(tv[1] - tv[0]), e2 = __expf(tv[2] - tv[0]), e3 = __expf(tv[3] - tv[0]); const float inv = __builtin_amdgcn_rcpf(1.0f + e1 + e2 + e3);
            const int kk = lane & 31;
            if (kk < 4) { const int te = kk == 0 ? ti[0] : (kk == 1 ? ti[1] : (kk == 2 ? ti[2] : ti[3]));
                c.gate[t * 4 + kk] = (kk == 0 ? 1.0f : (kk == 1 ? e1 : (kk == 2 ? e2 : e3))) * inv; c.topidx[t * 4 + kk] = te; atomicAdd((int*)(cnt_l + te), 1); }
        }
      }
      __syncthreads();
      if (tid < 32) c.moe_cnt[gi * 32 + tid] = cnt_l[tid];
      __syncthreads();
    }
}
#undef LNR_LOAD
}
#endif
typedef const __attribute__((address_space(4))) Ctx* CtxK;
#if defined(__HIP_DEVICE_COMPILE__)
__device__ __forceinline__ const Ctx* ctx_ptr() { CtxK p = (CtxK)__builtin_amdgcn_kernarg_segment_ptr(); asm volatile("" : "+s"(p)); return (const Ctx*)p; }
#endif
#define PH(...) do { const Ctx& c = *ctx_ptr(); __VA_ARGS__ } while (0)

#define RUN(bit, ...) do { PH(__VA_ARGS__); if (REPMASK & (1u << (bit))) PH(__VA_ARGS__); } while (0)
#define LDSP ((LAS unsigned char*)lds)
#ifndef NCV
#define NCV 0
#endif

__global__ void __launch_bounds__(NTHREADS, 2) mk_forward(Ctx cparam) {
#if defined(__HIP_DEVICE_COMPILE__)
    extern __shared__ __attribute__((aligned(16))) unsigned char lds[];
    volatile LAS unsigned* bst = (volatile LAS unsigned*)((LAS unsigned char*)lds + LDS_BYTES - 16);
    if (threadIdx.x == 0) { bst[0] = 0u; bst[1] = 0u; bst[2] = 0u; bst[3] = 0u; }
    __syncthreads();
    XcdBarrier bar = xcd_barrier_post(ctx_ptr()->bar, bst);
    const long T = ox_T; const int depth = ctx_ptr()->depth;
    for (int l = -1; l < depth; ++l) {
        const int par = l & 1;
        if (l >= 0) RUN(0, prologue_weights<false, true>(c, l, par, LDSP, 0, c.grid); );
        else PH( LOOP(T * 128, cvt_x8(c.in[I_X], c.xbf, i)); const u32x4 z4 = uzero4(); LOOP(128, *(u32x4*)(c.x1b + (size_t)ox_T * 1024 + i * 8) = z4); LOOP(1, c.moe_done[320] = 0); LOOP(64, *(u32x4*)(c.x1q + (size_t)ox_T * 1024 + i * 16) = z4); );
        if (l + 1 < depth) { RUN(0, prologue_weights<true, false>(c, l + 1, par ^ 1, LDSP, 0, c.grid); ); RUN(0, s5::prologue(c, l + 1, par ^ 1, LDSP, c.grid >= 72 ? c.grid - 72 : 0, c.grid >= 72 ? 72 : c.grid); ); }
        if (l >= 0) {
            PH( __syncthreads(); );
            RUN(1, gx::Gemm g{c.xbf, c.Win_t + par * wsz::WIN, 1024, 0}; gx::StaticOrder S; S.init(ox_T, 14080, c.grid, (int)blockIdx.x);
                   EpiInproj<false, true> E{c.Gb, c.Zb, c.XBCb, c.QKVU, c.dtf, c.in[I_BGATE] + (size_t)l * 3072, c.Ug};
                   gx::gemm_phase(LDSP, g, S, E); );
        }
        SYNC();
        if (l < 0) continue;
        RUN(3, att::phase(c, LDSP); );
        RUN(4, gx::Gemm g{c.Ug, c.s5_W1 + par * wsz::S5W1, 256, (size_t)512 * 256 * 2}; s5::Order S{576, c.grid, (int)blockIdx.x, 1, 1}; s5::Epi1 E{c.s5_Yl, c.s5_Sloc}; gx::gemm_phase(LDSP, g, S, E); );
        RUN(2, ssd::phase_s1(c, l, LDSP); );
        SYNC();
        RUN(5, s5::scan(c, par, LDSP); );
        RUN(5, LOOP(T * 48, att::combine(c, i)); );
        PH( ssd::phase_s2(c); );
        SYNC();
        RUN(6, ssd::phase_s3<true>(c, l, LDSP); );
#pragma clang loop unroll(disable)
        for (int ps = 1; ps <= 2; ++ps) {
            if (ps == 2) SYNC();
            PH( gx::Gemm g{c.s5_Sin, c.s5_Q + par * wsz::S5Q, 256, (size_t)256 * 256 * 2}; s5::Order S{288, c.grid, (int)blockIdx.x, 0, 0, ps}; s5::Epi2 E{c.s5_Yl, c.Ug, c.in[I_S5D] + (size_t)l * 1152, c.s5hb, c.moe_done + 320}; gx::gemm_phase(LDSP, g, S, E); );
        }
        RUN(9, gx::Gemm g{c.yssdb, c.Wbs_t + par * wsz::WBS, 2048, 0}; gx::StaticOrder S; S.init(ox_T, 1024, c.grid, (int)blockIdx.x); EpiBranch<0> E{c.Gb, c.mergedb, c.ssd_ssq}; gx::gemm_phase(LDSP, g, S, E); );
        PH( gx::Gemm g{c.yattb, c.Wba_t + par * wsz::WBA, 384, 0}; gx::StaticOrder S; S.init(ox_T, 1024, c.grid, (int)blockIdx.x); EpiBranch<1> E{c.Gb, c.mergedb, nullptr}; gx::gemm_phase(LDSP, g, S, E); );
        PH( const s5::Order S2{288, c.grid, (int)blockIdx.x, 0, 0, 2}; moe_wait_rows(c.moe_done, 320, (l + 1) * S2.late_cnt() * 8); );
        RUN(8, gx::Gemm g{c.s5hb, c.Wglu_t + par * wsz::WGLU, 1152, 0}; gx::StaticOrder S; S.init(ox_T, 2304, c.grid, (int)blockIdx.x); EpiGlu E{c.ys5b}; gx::gemm_phase(LDSP, g, S, E); );
        SYNC();
        RUN(10, gx::Gemm g{c.ys5b, c.Wb5_t + par * wsz::WB5, 1152, 0}; gx::StaticOrder S; S.init(ox_T, 1024, c.grid, (int)blockIdx.x); EpiBranch<2> E{c.Gb, c.mergedb, nullptr}; gx::gemm_phase(LDSP, g, S, E); );
        SYNC();
        RUN(11, gx::Gemm g{c.mergedb, c.Wout_t + par * wsz::WOUT, 1024, 0}; gx::StaticOrder S; S.init(ox_T, 1024, c.grid, (int)blockIdx.x); EpiBf16 E{c.mixb}; gx::gemm_phase(LDSP, g, S, E); );
        SYNC();
        RUN(12, lnr::phase(c, l, LDSP); );
        SYNC();
        RUN(13, moe_assign(c, LDSP); );
        SYNC();
        RUN(14, const int nb = moe_blocks(c, LDSP); int M, fi; moe_early(nb, c.grid, M, fi); gx::Gemm g{(const bf16_t*)c.x1q, c.Wgu_t, 512, (size_t)2048 * 1024};
                MoeOrder S{(const LAS int*)(LDSP + LDS_TAB), nb * 8, c.grid, (int)blockIdx.x, 3, 0, nb, M, fi};
                EpiSwiglu E{(unsigned char*)c.actb, c.in[I_BGU] + (size_t)l * 32 * 2048, c.moe_done}; gx::gemm_phase<EpiSwiglu, MoeOrder, true, true>(LDSP, g, S, E, c.slot_tok); );
#pragma clang loop unroll(disable)
        for (int ps = 1; ps <= 2; ++ps) {
            if (ps == 2) SYNC();
            RUN(15, const int nb = moe_blocks(c, LDSP); int M, fi; moe_early(nb, c.grid, M, fi); gx::Gemm g{c.actb, c.Wdn_t, 512, (size_t)1024 * 1024};
                    MoeOrder S{(const LAS int*)(LDSP + LDS_TAB), (nb - 8 * M) * 4, c.grid, (int)blockIdx.x, 2, ps, nb, M, fi};
                    gx::Unit u0; if (ps == 1 && S.next(0, u0)) moe_wait_rows(c.moe_done, u0.pm);
                    EpiDown E{c.ys2, c.in[I_BDN] + (size_t)l * 32 * 1024, c.slot_gate}; gx::gemm_phase<EpiDown, MoeOrder, false, true>(LDSP, g, S, E); );
        }
        SYNC();
        RUN(16, moe_combine_ln(c, c.in[I_LN2G] + l * 1024, c.in[I_LN2B] + l * 1024, (l == depth - 1) ? c.out : nullptr); );
        SYNC();
    }
#endif
}

extern "C" void kernel_launch(void* const* d_in, const int* in_sizes, int n_in, void* d_out, int out_size, void* d_ws, size_t ws_size, hipStream_t stream) {
    static int grid = 0;
    Ctx c;
    const size_t need = build_ctx(c, d_in, d_out, d_ws, 4);
    if (grid == 0) {
        if (n_in != N_INPUTS || out_size != 2 * 8192 * 1024 || ws_size < need) { fprintf(stderr, "kernel_launch: unexpected shapes (n_in %d out %d ws %zu need %zu)\n", n_in, out_size, ws_size, need); grid = -1; return; }
        int dev = 0, cus = 0, per_cu = 0;
        (void)hipGetDevice(&dev); (void)hipDeviceGetAttribute(&cus, hipDeviceAttributeMultiprocessorCount, dev);
        if (hipFuncSetAttribute((const void*)mk_forward, hipFuncAttributeMaxDynamicSharedMemorySize, LDS_BYTES) != hipSuccess) { fprintf(stderr, "kernel_launch: hipFuncSetAttribute failed\n"); grid = -1; return; }
        if (hipOccupancyMaxActiveBlocksPerMultiprocessor(&per_cu, (const void*)mk_forward, NTHREADS, LDS_BYTES) != hipSuccess || per_cu < 1) { fprintf(stderr, "kernel_launch: occupancy query says %d\n", per_cu); grid = -1; return; }
        (void)hipGetLastError();
        grid = cus;
    }
    if (grid < 0) return;
    c.grid = grid;
    (void)hipMemsetAsync(c.bar, 0, 16384, stream);
    hipLaunchKernelGGL(mk_forward, dim3(grid), dim3(NTHREADS), LDS_BYTES, stream, c);
}
```

```cpp
#include <hip/hip_runtime.h>
#include <cstdio>
#include <cstdint>
#include <cstring>
#include <cmath>

#ifndef REPMASK
#define REPMASK 0u
#endif

namespace md {
constexpr int D = 1024, NIN = 13888;
constexpr int C_GATE = 0, C_Z = 3072, C_XBC = 5120, C_DT = 9216, C_QKV = 9280, C_U = 12736;
constexpr int SSD_IN = 2048, SSD_CC = 4096, NH = 32, HP = 64, NG = 8, NS = 128;
constexpr int ATT_W = 1152, ATT_O = 384;
constexpr int S5W = 1152, S5G = 72, S5C = 16, S5N = 64;
constexpr int NE = 32, TOPK = 4, FF = 1024;
constexpr float ALPHA = 1.681792830507429f;
constexpr float EPS = 1e-5f;
}

enum { I_X = 0, I_WIN, I_BGATE, I_CONVW, I_CONVB, I_ALOG, I_DTB, I_SSDD, I_NORMW, I_S5ARE, I_S5AIM, I_S5LS, I_S5BRE, I_S5BIM,
       I_S5CRE, I_S5CIM, I_S5D, I_GLU1, I_GLU2, I_WBSSD, I_WBATT, I_WBS5, I_WOUT, I_LN1G, I_LN1B, I_RW, I_RB, I_WGU, I_BGU,
       I_WDN, I_BDN, I_LN2G, I_LN2B, N_INPUTS };

struct Ctx {
    const float* in[N_INPUTS];
    float* out;
    float *attlse, *gate; unsigned short* mixb;
    int *topidx, *tok_slot;
    unsigned* bar;
    unsigned short *Win_t, *Wglu_t, *Wbs_t, *Wba_t, *Wb5_t, *Wout_t, *Wgu_t, *Wdn_t;
    unsigned short *xbf, *Gb, *Zb, *XBCb, *QKVU; float* dtf;
    unsigned short *yssdb, *yattb, *s5hb, *ys5b, *mergedb;
    unsigned short *x1b, *actb, *ys2; float* slot_gate; int *moe_cnt, *moe_pstart, *slot_tok, *moe_done; unsigned char* x1q;
    unsigned short* ssd_S; float *ssd_tot, *ssd_ssq;
    unsigned short* attob;
    unsigned short *Ug, *s5_W1, *s5_Q, *s5_Yl, *s5_Sin, *s5_Sloc; float* s5_a16;
    int depth, grid;
};

namespace wsz { constexpr size_t WIN = (size_t)14080 * 1024, WGLU = (size_t)2304 * 1152, WBS = (size_t)1024 * 2048, WBA = (size_t)1024 * 384, WB5 = (size_t)1024 * 1152, WOUT = (size_t)1024 * 1024,
    S5W1 = (size_t)72 * 512 * 256, S5Q = (size_t)72 * 256 * 256, A16 = 72 * 2 * 64 * 2; }
static inline size_t align_up(size_t x) { return (x + 255) & ~(size_t)255; }
static size_t build_ctx(Ctx& c, void* const* d_in, void* d_out, void* d_ws, int depth) {
    memset(&c, 0, sizeof(c));
    for (int i = 0; i < N_INPUTS; ++i) c.in[i] = (const float*)d_in[i];
    c.out = (float*)d_out; c.depth = depth;
    char* w = (char*)d_ws; size_t off = 0; const size_t T = 16384;
    auto take = [&](size_t bytes) { char* p = w + off; off = align_up(off + bytes); return p; };
    c.bar = (unsigned*)take(16384);
    c.attlse = (float*)take(3 * T * 6 * 4); c.mixb = (unsigned short*)take(T * 1024 * 2);
    c.gate = (float*)take(T * 4 * 4); c.topidx = (int*)take(T * 4 * 4); c.tok_slot = (int*)take(T * 4 * 4);
    c.Win_t = (unsigned short*)take(2 * wsz::WIN * 2); c.Wglu_t = (unsigned short*)take(2 * wsz::WGLU * 2); c.Wbs_t = (unsigned short*)take(2 * wsz::WBS * 2);
    c.Wba_t = (unsigned short*)take(2 * wsz::WBA * 2); c.Wb5_t = (unsigned short*)take(2 * wsz::WB5 * 2); c.Wout_t = (unsigned short*)take(2 * wsz::WOUT * 2);
    c.Wgu_t = (unsigned short*)take((size_t)32 * 2048 * 1024 * 2); c.Wdn_t = (unsigned short*)take((size_t)32 * 1024 * 1024 * 2);
    c.xbf = (unsigned short*)take(T * 1024 * 2); c.Gb = (unsigned short*)take(T * 3072 * 2); c.Zb = (unsigned short*)take(T * 2048 * 2); c.XBCb = (unsigned short*)take(T * 4096 * 2);
    c.QKVU = (unsigned short*)take(T * 4608 * 2); c.dtf = (float*)take(T * 64 * 4);
    c.x1b = (unsigned short*)take((size_t)(T + 1) * 1024 * 2); c.slot_tok = (int*)take(73728 * 4); c.actb = (unsigned short*)take((size_t)73728 * 1024 * 2); c.ys2 = (unsigned short*)take((size_t)73728 * 1024 * 2);
    c.slot_gate = (float*)take(73728 * 4); c.moe_cnt = (int*)take(8192 * 4); c.moe_pstart = (int*)take(256); c.moe_done = (int*)take(2048); c.x1q = (unsigned char*)take((size_t)(T + 1) * 1024);
    c.ssd_S = (unsigned short*)take((size_t)2 * 2 * 64 * 32 * 8192 * 2); c.ssd_tot = (float*)take(2 * 2 * 64 * 32 * 4); c.ssd_ssq = (float*)take(T * 8 * 4);
    c.attob = (unsigned short*)take(3 * T * 384 * 2);
    c.Ug = (unsigned short*)take(T * 1152 * 2); c.s5_W1 = (unsigned short*)take(2 * wsz::S5W1 * 2); c.s5_Q = (unsigned short*)take(2 * wsz::S5Q * 2);
    c.s5_Yl = (unsigned short*)take((size_t)73728 * 256 * 2); c.s5_Sin = (unsigned short*)take((size_t)73728 * 256 * 2); c.s5_Sloc = (unsigned short*)take((size_t)73728 * 256 * 2); c.s5_a16 = (float*)take(2 * wsz::A16 * 4);
    c.yssdb = (unsigned short*)take(T * 2048 * 2); c.yattb = (unsigned short*)take(T * 384 * 2); c.s5hb = (unsigned short*)take(T * 1152 * 2); c.ys5b = (unsigned short*)take(T * 1152 * 2); c.mergedb = (unsigned short*)take(T * 1024 * 2);
    return off;
}

#define XB_TMO      128
#define XB_XCNT(j)  (256  + 64 * (j))
#define XB_XSUB(j)  (1280 + 64 * (j))
#define XB_XGEN(j)  (2304 + 64 * (j))
#define XB_TOP      3328
#define XB_TOPGEN   3392
#define XCD_BAR_WORDS 3456
#define XB_SPIN_CAP (1u << 18)
#define LAS __attribute__((address_space(3)))

__device__ __forceinline__ unsigned xb_ld(unsigned* p)              { return __hip_atomic_load(p, __ATOMIC_RELAXED, __HIP_MEMORY_SCOPE_AGENT); }
__device__ __forceinline__ unsigned xb_add(unsigned* p, unsigned v) { return __hip_atomic_fetch_add(p, v, __ATOMIC_RELAXED, __HIP_MEMORY_SCOPE_AGENT); }
__device__ __forceinline__ unsigned xb_xcc_id() { return (unsigned)__builtin_amdgcn_s_getreg((3 << 11) | 20) & 0xFu; }
#define XB_SPIN(cond, bar) do { unsigned _sp = 0; while (cond) { __builtin_amdgcn_s_sleep(1); \
    if ((++_sp & 255u) == 0u) { if (xb_ld(&(bar)[XB_TMO])) break; if (_sp > XB_SPIN_CAP) { atomicAdd(&(bar)[XB_TMO], 1u); break; } } } } while (0)

struct XcdBarrier { unsigned* bar; unsigned x; volatile LAS unsigned* st; };

__device__ __forceinline__ XcdBarrier xcd_barrier_post(unsigned* bar, volatile LAS unsigned* st) {
    XcdBarrier b; b.bar = bar; b.x = xb_xcc_id(); b.st = st;
    if (threadIdx.x == 0) (void)xb_add(&bar[XB_XCNT(b.x)], 1u);
    return b;
}
__device__ __forceinline__ void xcd_barrier_complete(unsigned* bar, unsigned x, unsigned& nloc, unsigned& nx) {
    const unsigned G = gridDim.x * gridDim.y * gridDim.z;
    unsigned sum, cnt, mine, sp = 0u;
    for (;;) {
        sum = 0u; cnt = 0u; mine = 0u;
#pragma unroll
        for (unsigned j = 0; j < 16; ++j) { const unsigned c = xb_ld(&bar[XB_XCNT(j)]); sum += c; cnt += (c > 0u) ? 1u : 0u; mine = (j == x) ? c : mine; }
        if (sum == G) break;
        __builtin_amdgcn_s_sleep(1);
        if ((++sp & 255u) == 0u) { if (xb_ld(&bar[XB_TMO])) break; if (sp > XB_SPIN_CAP) { atomicAdd(&bar[XB_TMO], 1u); break; } }
    }
    nloc = mine > 0u ? mine : 1u; nx = cnt > 0u ? cnt : 1u;
}
__device__ __forceinline__ void xcd_barrier(const XcdBarrier& b) {
    asm volatile("s_waitcnt vmcnt(0)" ::: "memory");
    __syncthreads();
    if (threadIdx.x == 0) {
        unsigned* bar = b.bar;
        __builtin_amdgcn_s_waitcnt(0);
        unsigned nloc = b.st[0], nx = b.st[1];
        if (nloc == 0u) { xcd_barrier_complete(bar, b.x, nloc, nx); b.st[0] = nloc; b.st[1] = nx; }
        const unsigned old = xb_add(&bar[XB_XSUB(b.x)], 1u);
        const unsigned gen = old / nloc;
        if (old + 1u == (gen + 1u) * nloc) {
            __builtin_amdgcn_fence(__ATOMIC_RELEASE, "agent");
            asm volatile("s_waitcnt vmcnt(0)" ::: "memory");
            const unsigned og = xb_add(&bar[XB_TOP], 1u);
            const unsigned tg = og / nx;
            if (og + 1u == (tg + 1u) * nx) xb_add(&bar[XB_TOPGEN], 1u);
            else XB_SPIN(xb_ld(&bar[XB_TOPGEN]) == tg, bar);
            __builtin_amdgcn_fence(__ATOMIC_ACQUIRE, "agent");
            xb_add(&bar[XB_XGEN(b.x)], 1u);
            asm volatile("s_waitcnt vmcnt(0)" ::: "memory");
        } else {
            XB_SPIN(xb_ld(&bar[XB_XGEN(b.x)]) == gen, bar);
            __builtin_amdgcn_fence(__ATOMIC_ACQUIRE, "agent");
            asm volatile("s_waitcnt vmcnt(0)" ::: "memory");
        }
    }
    __syncthreads();
}

constexpr int NTHREADS = 512;
constexpr int LDS_BYTES = 163840;

#if defined(__HIP_DEVICE_COMPILE__)
typedef unsigned short bf16_t;
typedef short bf16x8 __attribute__((ext_vector_type(8)));
typedef float f32x4 __attribute__((ext_vector_type(4)));
typedef float f32x2 __attribute__((ext_vector_type(2)));
typedef unsigned u32x4 __attribute__((ext_vector_type(4)));
typedef unsigned u32x2 __attribute__((ext_vector_type(2)));
#define LDS_WAIT() asm volatile("s_waitcnt lgkmcnt(0)" ::: "memory")
#define VM_WAIT() asm volatile("s_waitcnt vmcnt(0)" ::: "memory")

__device__ __forceinline__ f32x4 zero4() { float z = 0.f; asm volatile("" : "+v"(z)); return (f32x4){z, z, z, z}; }
__device__ __forceinline__ u32x4 uzero4() { unsigned z = 0u; asm volatile("" : "+v"(z)); return (u32x4){z, z, z, z}; }
__device__ __forceinline__ unsigned f2bf(float f) { unsigned u = __float_as_uint(f); return (u + 0x7fffu + ((u >> 16) & 1u)) >> 16; }
__device__ __forceinline__ unsigned pk2(float lo, float hi) { return f2bf(lo) | (f2bf(hi) << 16); }
__device__ __forceinline__ float bf2f(unsigned b) { return __uint_as_float(b << 16); }
__device__ __forceinline__ float bflo(unsigned w) { return __uint_as_float(w << 16); }
__device__ __forceinline__ float bfhi(unsigned w) { return __uint_as_float(w & 0xffff0000u); }
typedef __bf16 bf16x2_t __attribute__((ext_vector_type(2)));
__device__ __forceinline__ unsigned cvt_pk_bf16(float lo, float hi) { const f32x2 v = {lo, hi}; return __builtin_bit_cast(unsigned, __builtin_convertvector(v, bf16x2_t)); }
__device__ __forceinline__ float fast_sigmoid(float x) { return __builtin_amdgcn_rcpf(1.0f + __expf(-x)); }
__device__ __forceinline__ f32x4 sig4(f32x4 v) { return (f32x4){fast_sigmoid(v[0]), fast_sigmoid(v[1]), fast_sigmoid(v[2]), fast_sigmoid(v[3])}; }
__device__ __forceinline__ unsigned pk4_fp8(float a, float b, float c2, float d) { int w = 0; w = __builtin_amdgcn_cvt_pk_fp8_f32(a, b, w, false); w = __builtin_amdgcn_cvt_pk_fp8_f32(c2, d, w, true); return (unsigned)w; }
__device__ __forceinline__ u32x4 pack8(f32x4 v0, f32x4 v1) { u32x4 w; w.x = cvt_pk_bf16(v0[0], v0[1]); w.y = cvt_pk_bf16(v0[2], v0[3]); w.z = cvt_pk_bf16(v1[0], v1[1]); w.w = cvt_pk_bf16(v1[2], v1[3]); return w; }

namespace gx {
constexpr int BM = 256, BK = 64, HALF = 128, HTB = HALF * BK * 2, STAGE_BYTES = 8 * HTB, NXCD = 8, WGM = 2;
__device__ __forceinline__ int lds_byte(int r, int c) { const int st = (r >> 4) * 2 + (c >> 5), rr = r & 15, cc = c & 31, ob = rr * 64 + cc * 2; return st * 1024 + (ob ^ (((ob >> 9) & 1) << 5)); }
__device__ __forceinline__ void stage_rc(int b, int& R, int& C) { const int st = b / 1024, sb = b % 1024, swz = sb ^ (((sb >> 9) & 1) << 5); R = (st >> 1) * 16 + swz / 64; C = (st & 1) * 32 + (swz % 64) / 2; }
__device__ __forceinline__ int perm32(int rho) { const int n = rho >> 4, i = rho & 15; return 8 * (i >> 2) + 4 * n + (i & 3); }
struct Unit { int pm, pn, e, f; };
struct Gemm { const bf16_t* A; const bf16_t* Bt; int K; size_t bexp; };
struct StaticOrder {
    int nM, nN, nwg, G, c;
    __device__ void init(int M, int N, int G_, int c_) { nM = M / BM; nN = N / BM; nwg = nM * nN; G = G_; c = c_; }
    __device__ bool next(int i, Unit& u) const {
        const long Lx = (long)i * G + c; if (Lx >= nwg) return false;
        int wgid = (int)Lx; { const int q = nwg / NXCD, r = nwg % NXCD, xcd = wgid % NXCD, off = wgid / NXCD; wgid = (xcd < r ? xcd * (q + 1) : r * (q + 1) + (xcd - r) * q) + off; }
        const int nig = WGM * nN, gid = wgid / nig, fm = gid * WGM, gsz = (nM - fm) < WGM ? (nM - fm) : WGM;
        u.pm = fm + ((wgid % nig) % gsz); u.pn = (wgid % nig) / gsz; u.e = 0; u.f = 0; return true;
    }
};
typedef int v8i32 __attribute__((ext_vector_type(8)));
template <class Epi, class Sched, bool GATHER = false, bool FP8 = false>
__device__ __forceinline__ void gemm_phase(LAS unsigned char* lds, const Gemm g, const Sched& S, const Epi& E, const int* rowidx = nullptr) {
    int tid = threadIdx.x; asm volatile("" : "+v"(tid)); const int wid = __builtin_amdgcn_readfirstlane(tid >> 6), lane = tid & 63, wr = wid >> 2, wc = wid & 3, fr = lane & 15, fq = lane >> 4;
    int K = g.K; asm volatile("" : "+s"(K)); const int nt = K / BK;
    unsigned voffA[2], voffB[2];
#pragma unroll
    for (int i = 0; i < 2; ++i) { int R, C; stage_rc(tid * 16 + i * 8192, R, C); const int Rb = Epi::PERM ? ((R & ~31) + perm32(R & 31)) : R;
        voffA[i] = (unsigned)(R * K + C) * 2u; voffB[i] = (unsigned)(Rb * K + C) * 2u; }
    const size_t kstep = (size_t)(BK * 2);
    const size_t hstep = (size_t)HALF * K * 2;
    const size_t tstep = 2 * hstep;
    const size_t hstepA = GATHER ? 0 : hstep;
    const unsigned ldsw = (unsigned)wid * 1024u;
    const int aoff = lds_byte(wr * 64 + fr, fq * 8), boff = lds_byte(wc * 32 + fr, fq * 8);
#define GX_SA(b, h) (((b) * 2 + (h)) * HTB)
#define GX_SB(b, h) ((4 + (b) * 2 + (h)) * HTB)
#define GX_STAGE(bufoff, gbase, voff) do { _Pragma("unroll") for (int _i = 0; _i < 2; ++_i) \
        __builtin_amdgcn_global_load_lds((const unsigned*)((const char*)(gbase) + (voff)[_i]), (LAS unsigned*)(lds + (bufoff) + ldsw + _i * 8192), 16, 0, 0); } while (0)
#define GX_STAGE_A(bufoff, ptr, half, usenext) do { if (GATHER) { unsigned _v[2]; _Pragma("unroll") for (int _i = 0; _i < 2; ++_i) _v[_i] = (usenext) ? nv[half][_i] : cv[half][_i]; GX_STAGE(bufoff, ptr, _v); } \
        else GX_STAGE(bufoff, (ptr) + (half) * hstepA, voffA); } while (0)
#define GX_IDX(dst, u) do { _Pragma("unroll") for (int _i = 0; _i < 2; ++_i) { int _R, _C; stage_rc(tid * 16 + _i * 8192, _R, _C); _Pragma("unroll") for (int _h = 0; _h < 2; ++_h) \
        dst[_h][_i] = (unsigned)rowidx[(u).pm * 256 + _h * 128 + _R] * (unsigned)(K * 2) + (unsigned)(_C * 2); } } while (0)
#define GX_LDA(dst, b, h) do { _Pragma("unroll") for (int m = 0; m < 4; ++m) _Pragma("unroll") for (int k = 0; k < 2; ++k) dst[m][k] = *(const LAS bf16x8*)(lds + GX_SA(b, h) + aoff + m * 2048 + k * 1024); } while (0)
#define GX_LDB(dst, b, h) do { _Pragma("unroll") for (int n = 0; n < 2; ++n) _Pragma("unroll") for (int k = 0; k < 2; ++k) dst[n][k] = *(const LAS bf16x8*)(lds + GX_SB(b, h) + boff + n * 2048 + k * 1024); } while (0)
#define GX_CAT8(lo, hi) __builtin_bit_cast(v8i32, __builtin_shufflevector(__builtin_bit_cast(u32x4, lo), __builtin_bit_cast(u32x4, hi), 0, 1, 2, 3, 4, 5, 6, 7))
#define GX_MMA(ai, bj, At, Bt) do { __builtin_amdgcn_s_setprio(1); if (FP8) { _Pragma("unroll") for (int m = 0; m < 4; ++m) _Pragma("unroll") for (int n = 0; n < 2; ++n) \
            asm volatile("v_mfma_scale_f32_16x16x128_f8f6f4 %0, %1, %2, %0, %3, %3 op_sel_hi:[0,0,0]" : "+v"(acc[ai][bj][m][n]) : "v"(GX_CAT8(Bt[n][0], Bt[n][1])), "v"(GX_CAT8(At[m][0], At[m][1])), "v"(one_scale)); } \
        else { _Pragma("unroll") for (int m = 0; m < 4; ++m) _Pragma("unroll") for (int n = 0; n < 2; ++n) _Pragma("unroll") for (int k = 0; k < 2; ++k) \
        acc[ai][bj][m][n] = __builtin_amdgcn_mfma_f32_16x16x32_bf16(Bt[n][k], At[m][k], acc[ai][bj][m][n], 0, 0, 0); } __builtin_amdgcn_s_setprio(0); } while (0)
#define GX_WAIT_V(n) asm volatile("s_waitcnt vmcnt(" #n ")" ::: "memory")
#define GX_WAIT_L(n) asm volatile("s_waitcnt lgkmcnt(" #n ")" ::: "memory")
#define GX_BAR __builtin_amdgcn_s_barrier()
#define GX_SCHED __builtin_amdgcn_sched_barrier(0)
    Unit cur, nxt, nn; int ui = 0;
    if (!S.next(0, cur)) return;
    bool has_next = S.next(1, nxt);
    unsigned cv[2][2], nv[2][2], nnv[2][2];
    if (GATHER) { GX_IDX(cv, cur); if (has_next) GX_IDX(nv, nxt); else { _Pragma("unroll") for (int h = 0; h < 2; ++h) _Pragma("unroll") for (int i = 0; i < 2; ++i) nv[h][i] = cv[h][i]; } }
    f32x4 acc[2][2][4][2];
    { float z = 0.f; asm volatile("" : "+v"(z));
#pragma unroll
    for (int a = 0; a < 2; ++a)
#pragma unroll
        for (int b = 0; b < 2; ++b)
#pragma unroll
            for (int m = 0; m < 4; ++m)
#pragma unroll
                for (int n = 0; n < 2; ++n) acc[a][b][m][n] = (f32x4){z, z, z, z}; }
    bf16x8 At[4][2], B0[2][2], B1[2][2]; int one_scale = 0x7f7f7f7f; asm volatile("" : "+v"(one_scale));
    const char* cA = (const char*)g.A + (GATHER ? 0 : (size_t)cur.pm * tstep); const char* cB = (const char*)g.Bt + (size_t)cur.e * g.bexp + (size_t)cur.pn * tstep;
    GX_STAGE(GX_SB(0, 0), cB, voffB); GX_STAGE_A(GX_SA(0, 0), cA, 0, false); GX_STAGE(GX_SB(0, 1), cB + hstep, voffB); GX_STAGE_A(GX_SA(0, 1), cA, 1, false);
    if (wr == 1) GX_BAR;
    GX_WAIT_V(4); GX_BAR;
    GX_STAGE(GX_SB(1, 0), cB + kstep, voffB); GX_STAGE_A(GX_SA(1, 0), cA + kstep, 0, false); GX_STAGE(GX_SB(1, 1), cB + hstep + kstep, voffB);
    GX_WAIT_V(6); GX_BAR;
    for (;;) {
        const char* nA = (has_next && !GATHER) ? (const char*)g.A + (size_t)nxt.pm * tstep : cA; const char* nB = has_next ? (const char*)g.Bt + (size_t)nxt.e * g.bexp + (size_t)nxt.pn * tstep : cB;
#pragma clang loop unroll(disable)
        for (int t = 0; t < nt; t += 2) {
            const bool last = (t == nt - 2);
            const char* a1 = cA + (size_t)(t + 1) * kstep;
            const char* a2 = last ? nA : cA + (size_t)(t + 2) * kstep; const char* b2 = last ? nB : cB + (size_t)(t + 2) * kstep;
            const char* a3 = a2 + kstep; const char* b3 = b2 + kstep;
            GX_LDB(B0, 0, 0); GX_SCHED; GX_LDA(At, 0, 0); GX_STAGE_A(GX_SA(1, 1), a1, 1, false);
            GX_WAIT_L(8); GX_BAR; GX_WAIT_L(0); GX_MMA(0, 0, At, B0); GX_BAR; GX_SCHED;
            GX_LDB(B1, 0, 1); GX_STAGE(GX_SB(0, 0), b2, voffB);
            GX_BAR; GX_WAIT_L(0); GX_MMA(0, 1, At, B1); GX_BAR;
            GX_LDA(At, 0, 1); GX_STAGE_A(GX_SA(0, 0), a2, 0, last);
            GX_BAR; GX_WAIT_L(0); GX_MMA(1, 0, At, B0); GX_BAR; GX_SCHED;
            GX_STAGE(GX_SB(0, 1), b2 + hstep, voffB);
            GX_WAIT_V(6); GX_BAR; GX_MMA(1, 1, At, B1); GX_BAR;
            GX_LDB(B0, 1, 0); GX_SCHED; GX_LDA(At, 1, 0); GX_STAGE_A(GX_SA(0, 1), a2, 1, last);
            GX_WAIT_L(8); GX_BAR; GX_WAIT_L(0); GX_MMA(0, 0, At, B0); GX_BAR; GX_SCHED;
            GX_LDB(B1, 1, 1); GX_STAGE(GX_SB(1, 0), b3, voffB);
            GX_BAR; GX_WAIT_L(0); GX_MMA(0, 1, At, B1); GX_BAR;
            GX_LDA(At, 1, 1); GX_STAGE_A(GX_SA(1, 0), a3, 0, last);
            GX_BAR; GX_WAIT_L(0); GX_MMA(1, 0, At, B0); GX_BAR; GX_SCHED;
            GX_STAGE(GX_SB(1, 1), b3 + hstep, voffB);
            GX_WAIT_V(6); GX_BAR; GX_MMA(1, 1, At, B1); GX_BAR;
        }
        const bool has_nn = has_next && S.next(ui + 2, nn);
        if (GATHER && has_nn) GX_IDX(nnv, nn);
        if (FP8) asm volatile("s_nop 15\n\ts_nop 15" ::: "memory");
        E(acc, cur, wr, wc, fr, fq);
        if (!has_next) break;
        { float z = 0.f; asm volatile("" : "+v"(z));
#pragma unroll
        for (int a = 0; a < 2; ++a)
#pragma unroll
            for (int b = 0; b < 2; ++b)
#pragma unroll
                for (int m = 0; m < 4; ++m)
#pragma unroll
                    for (int n = 0; n < 2; ++n) acc[a][b][m][n] = (f32x4){z, z, z, z}; }
        cur = nxt; cA = nA; cB = nB; ++ui;
        if (GATHER) { _Pragma("unroll") for (int h = 0; h < 2; ++h) _Pragma("unroll") for (int i = 0; i < 2; ++i) { cv[h][i] = nv[h][i]; if (has_nn) nv[h][i] = nnv[h][i]; } }
        nxt = nn; has_next = has_nn;
    }
    GX_WAIT_V(0);
    if (wr == 0) GX_BAR;
    GX_BAR;
#undef GX_SA
#undef GX_SB
#undef GX_STAGE
#undef GX_STAGE_A
#undef GX_IDX
#undef GX_LDA
#undef GX_LDB
#undef GX_MMA
#undef GX_CAT8
#undef GX_WAIT_V
#undef GX_WAIT_L
#undef GX_BAR
#undef GX_SCHED
}
}

template <bool RAWG, bool RAWZ> struct EpiInproj {
    static constexpr bool PERM = true;
    bf16_t *Gb, *Zb, *XBCb, *QKVU; float* dtf; const float* bgate; bf16_t* Ug;
    __device__ __forceinline__ void operator()(const f32x4 (&acc)[2][2][4][2], const gx::Unit& u, int wr, int wc, int fr, int fq) const {
        const int row0 = u.pm * 256 + wr * 64 + fr, cl = wc * 32 + 8 * fq;
        if (u.pn == 54) {
            if (wc < 2) {
#pragma unroll
                for (int ai = 0; ai < 2; ++ai)
#pragma unroll
                    for (int m = 0; m < 4; ++m) { float* rowp = dtf + (size_t)(row0 + ai * 128 + m * 16) * 64 + cl; *(f32x4*)rowp = acc[ai][0][m][0]; *(f32x4*)(rowp + 4) = acc[ai][0][m][1]; }
            }
            return;
        }
        bf16_t* base; int ldc, colt, mode;
        if (u.pn < 12) { base = Gb; ldc = 3072; colt = u.pn * 256; mode = RAWG ? 0 : 1; }
        else if (u.pn < 20) { base = Zb; ldc = 2048; colt = (u.pn - 12) * 256; mode = RAWZ ? 0 : 2; }
        else if (u.pn < 36) { base = XBCb; ldc = 4096; colt = (u.pn - 20) * 256; mode = 0; }
        else { base = QKVU; ldc = 4608; colt = (u.pn - 36) * 256; mode = 0; }
        const bool isu = u.pn >= 50;
#pragma unroll
        for (int bj = 0; bj < 2; ++bj) {
            const int col = colt + bj * 128 + cl;
            f32x4 b0 = zero4(), b1 = b0;
            if (mode == 1) { b0 = *(const f32x4*)(bgate + col); b1 = *(const f32x4*)(bgate + col + 4); }
#pragma unroll
            for (int ai = 0; ai < 2; ++ai)
#pragma unroll
                for (int m = 0; m < 4; ++m) {
                    f32x4 v0 = acc[ai][bj][m][0], v1 = acc[ai][bj][m][1];
                    if (mode == 1) { v0 = sig4(v0 + b0); v1 = sig4(v1 + b1); }
                    else if (mode == 2) { v0 = v0 * sig4(v0); v1 = v1 * sig4(v1); }
                    const u32x4 pk = pack8(v0, v1);
                    if (isu || (u.pn == 49 && bj == 1)) { const int uc = col - 3456; *(u32x4*)(Ug + ((size_t)(uc >> 4) * 16384 + (row0 + ai * 128 + m * 16)) * 16 + (uc & 15)) = pk; }
                    else *(u32x4*)(base + (size_t)(row0 + ai * 128 + m * 16) * ldc + col) = pk;
                }
        }
    }
};

struct EpiGlu {
    static constexpr bool PERM = true;
    bf16_t* O;
    __device__ __forceinline__ void operator()(const f32x4 (&acc)[2][2][4][2], const gx::Unit& u, int wr, int wc, int fr, int fq) const {
        const int row0 = u.pm * 256 + wr * 64 + fr, col = u.pn * 128 + wc * 32 + 8 * fq;
#pragma unroll
        for (int ai = 0; ai < 2; ++ai)
#pragma unroll
            for (int m = 0; m < 4; ++m) {
                const f32x4 v0 = acc[ai][0][m][0] * sig4(acc[ai][1][m][0]), v1 = acc[ai][0][m][1] * sig4(acc[ai][1][m][1]);
                *(u32x4*)(O + (size_t)(row0 + ai * 128 + m * 16) * 1152 + col) = pack8(v0, v1);
            }
    }
};
template <int STEP> struct EpiBranch {
    static constexpr bool PERM = true;
    const bf16_t* G; bf16_t* mb; const float* ssq;
    __device__ __forceinline__ void operator()(const f32x4 (&acc)[2][2][4][2], const gx::Unit& u, int wr, int wc, int fr, int fq) const {
        const int row0 = u.pm * 256 + wr * 64 + fr, cl = u.pn * 256 + wc * 32 + 8 * fq;
#pragma unroll
        for (int ai = 0; ai < 2; ++ai) {
            u32x4 gw[4][2], pw[4][2]; float rs[4];
#pragma unroll
            for (int m = 0; m < 4; ++m) { const size_t row = (size_t)(row0 + ai * 128 + m * 16);
#pragma unroll
                for (int bj = 0; bj < 2; ++bj) { const int col = cl + bj * 128; gw[m][bj] = *(const u32x4*)(G + row * 3072 + STEP * 1024 + col); if (STEP > 0) pw[m][bj] = *(const u32x4*)(mb + row * 1024 + col); }
                if (STEP == 0) { const f32x4 qa = *(const f32x4*)(ssq + row * 8), qb = *(const f32x4*)(ssq + row * 8 + 4);
                    rs[m] = __builtin_amdgcn_rsqf((((qa[0] + qa[1]) + (qa[2] + qa[3])) + ((qb[0] + qb[1]) + (qb[2] + qb[3]))) * (1.0f / 2048.0f) + md::EPS); } }
#pragma unroll
            for (int m = 0; m < 4; ++m)
#pragma unroll
                for (int bj = 0; bj < 2; ++bj) { const size_t row = (size_t)(row0 + ai * 128 + m * 16); const int col = cl + bj * 128; const u32x4 g4 = gw[m][bj];
                    const f32x4 g0 = (f32x4){bflo(g4.x), bfhi(g4.x), bflo(g4.y), bfhi(g4.y)}, g1 = (f32x4){bflo(g4.z), bfhi(g4.z), bflo(g4.w), bfhi(g4.w)};
                    f32x4 v0 = acc[ai][bj][m][0] * g0, v1 = acc[ai][bj][m][1] * g1;
                    if (STEP == 0) { v0 *= rs[m]; v1 *= rs[m]; }
                    if (STEP > 0) { const u32x4 p4 = pw[m][bj]; v0 += (f32x4){bflo(p4.x), bfhi(p4.x), bflo(p4.y), bfhi(p4.y)}; v1 += (f32x4){bflo(p4.z), bfhi(p4.z), bflo(p4.w), bfhi(p4.w)}; }
                    *(u32x4*)(mb + row * 1024 + col) = pack8(v0, v1); }
        }
    }
};
struct EpiBf16 {
    static constexpr bool PERM = true;
    bf16_t* C;
    __device__ __forceinline__ void operator()(const f32x4 (&acc)[2][2][4][2], const gx::Unit& u, int wr, int wc, int fr, int fq) const {
        const int row0 = u.pm * 256 + wr * 64 + fr, cl = u.pn * 256 + wc * 32 + 8 * fq;
#pragma unroll
        for (int ai = 0; ai < 2; ++ai)
#pragma unroll
            for (int m = 0; m < 4; ++m)
#pragma unroll
                for (int bj = 0; bj < 2; ++bj) *(u32x4*)(C + (size_t)(row0 + ai * 128 + m * 16) * 1024 + cl + bj * 128) = pack8(acc[ai][bj][m][0], acc[ai][bj][m][1]);
    }
};

__device__ __forceinline__ void cvt_item(const float* Wsrc  , int ldn, bf16_t* dst  , int K, int k0, LAS float* scr, int lane, const float* kscale) {
#pragma unroll
    for (int hb = 0; hb < 2; ++hb) {
        float v[32];
#pragma unroll
        for (int i = 0; i < 32; ++i) v[i] = __builtin_nontemporal_load(Wsrc + (size_t)(k0 + 32 * hb + i) * ldn + lane);
        if (kscale) {
#pragma unroll
            for (int i = 0; i < 32; ++i) v[i] *= kscale[k0 + 32 * hb + i];
        }
#pragma unroll
        for (int i = 0; i < 32; ++i) scr[(32 * hb + i) * 65 + lane] = v[i];
    }
    LDS_WAIT(); asm volatile("" ::: "memory");
    const int cch = lane & 7;
#pragma unroll
    for (int j = 0; j < 8; ++j) { const int n = (lane >> 3) + 8 * j; const LAS float* sp = scr + (8 * cch) * 65 + n;
        u32x4 o; o.x = cvt_pk_bf16(sp[0 * 65], sp[1 * 65]); o.y = cvt_pk_bf16(sp[2 * 65], sp[3 * 65]); o.z = cvt_pk_bf16(sp[4 * 65], sp[5 * 65]); o.w = cvt_pk_bf16(sp[6 * 65], sp[7 * 65]);
        *(u32x4*)(dst + (size_t)n * K + k0 + 8 * cch) = o; }
    LDS_WAIT(); asm volatile("" ::: "memory");
}
__device__ __forceinline__ void cvt8_load(float (&v)[64], const float* Wsrc, int ldn, int k0, int lane) {
#pragma unroll
    for (int i = 0; i < 64; ++i) v[i] = __builtin_nontemporal_load(Wsrc + (size_t)(k0 + i) * ldn + lane);
}
__device__ __forceinline__ void cvt8_put(const float (&v)[64], LAS float* scr, int lane, float wmul) {
#pragma unroll
    for (int i = 0; i < 64; ++i) scr[i * 65 + lane] = v[i] * wmul;
}
__device__ __forceinline__ void cvt8_out(unsigned char* dst  , int Kb  , int k0, LAS float* scr, int lane) {
    LDS_WAIT(); asm volatile("" ::: "memory");
    const LAS float* sp = scr + lane;
#pragma unroll
    for (int j = 0; j < 4; ++j) { u32x4 o;
        o.x = pk4_fp8(sp[(16 * j + 0) * 65], sp[(16 * j + 1) * 65], sp[(16 * j + 2) * 65], sp[(16 * j + 3) * 65]); o.y = pk4_fp8(sp[(16 * j + 4) * 65], sp[(16 * j + 5) * 65], sp[(16 * j + 6) * 65], sp[(16 * j + 7) * 65]);
        o.z = pk4_fp8(sp[(16 * j + 8) * 65], sp[(16 * j + 9) * 65], sp[(16 * j + 10) * 65], sp[(16 * j + 11) * 65]); o.w = pk4_fp8(sp[(16 * j + 12) * 65], sp[(16 * j + 13) * 65], sp[(16 * j + 14) * 65], sp[(16 * j + 15) * 65]);
        *(u32x4*)(dst + (size_t)lane * Kb + k0 + 16 * j) = o; }
    LDS_WAIT(); asm volatile("" ::: "memory");
}
template <bool SMALL, bool MOE>
__device__ __forceinline__ void prologue_weights(const Ctx& c, int l, int par, LAS unsigned char* lds, int first_wg, int n_wg) {
    int tid_ = threadIdx.x; asm volatile("" : "+v"(tid_)); const int wave = __builtin_amdgcn_readfirstlane(tid_ >> 6), lane = tid_ & 63;
    LAS float* scr = (LAS float*)(lds + wave * 16640);
    const int gw = ((int)blockIdx.x - first_wg) * 8 + wave, NGW = n_wg * 8;
    constexpr int N_WIN = 16 * 217, N_GLU = 18 * 18, N_BS = 32 * 16, N_BA = 6 * 16, N_B5 = 18 * 16, N_WO = 16 * 16, N_GU = 32 * 16 * 32, N_DN = 32 * 16 * 16;
    constexpr int N_SMALL = N_WIN + 2 * N_GLU + N_BS + N_BA + N_B5 + N_WO;
    if (SMALL) {
        bf16_t* Win_t = c.Win_t + par * wsz::WIN; bf16_t* Wglu_t = c.Wglu_t + par * wsz::WGLU; bf16_t* Wbs_t = c.Wbs_t + par * wsz::WBS; bf16_t* Wba_t = c.Wba_t + par * wsz::WBA; bf16_t* Wb5_t = c.Wb5_t + par * wsz::WB5; bf16_t* Wout_t = c.Wout_t + par * wsz::WOUT;
#pragma unroll 1
        for (int it = gw; it < N_SMALL; it += NGW) {
            int r = it; const float* src; bf16_t* dst; int ldn, K, kb; const float* ksc = nullptr;
            if (r < N_WIN) { kb = r / 217; const int n0 = (r % 217) * 64; const int drow = n0 < 9216 ? n0 : (n0 < 9280 ? 13824 + (n0 - 9216) : n0 - 64);
                src = c.in[I_WIN] + (size_t)l * 1024 * md::NIN + n0; ldn = md::NIN; dst = Win_t + (size_t)drow * 1024; K = 1024; }
            else if ((r -= N_WIN) < 2 * N_GLU) { const int w = r / N_GLU; r -= w * N_GLU; kb = r / 18; const int sb = r % 18; const int drow = 256 * (sb / 2) + 64 * (sb % 2) + 128 * w;
                src = c.in[w ? I_GLU2 : I_GLU1] + (size_t)l * 1152 * 1152 + sb * 64; ldn = 1152; dst = Wglu_t + (size_t)drow * 1152; K = 1152; }
            else if ((r -= 2 * N_GLU) < N_BS) { kb = r / 16; const int sb = r % 16; src = c.in[I_WBSSD] + (size_t)l * 2048 * 1024 + sb * 64; ldn = 1024; dst = Wbs_t + (size_t)(sb * 64) * 2048; K = 2048; ksc = c.in[I_NORMW] + (size_t)l * 2048; }
            else if ((r -= N_BS) < N_BA) { kb = r / 16; const int sb = r % 16; src = c.in[I_WBATT] + (size_t)l * 384 * 1024 + sb * 64; ldn = 1024; dst = Wba_t + (size_t)(sb * 64) * 384; K = 384; }
            else if ((r -= N_BA) < N_B5) { kb = r / 16; const int sb = r % 16; src = c.in[I_WBS5] + (size_t)l * 1152 * 1024 + sb * 64; ldn = 1024; dst = Wb5_t + (size_t)(sb * 64) * 1152; K = 1152; }
            else { r -= N_B5; kb = r / 16; const int sb = r % 16; src = c.in[I_WOUT] + (size_t)l * 1024 * 1024 + sb * 64; ldn = 1024; dst = Wout_t + (size_t)(sb * 64) * 1024; K = 1024; }
            cvt_item(src, ldn, dst, K, kb * 64, scr, lane, ksc);
        }
        for (long i = (long)((int)blockIdx.x - first_wg) * NTHREADS + tid_; i < 192 * 1024 / 8; i += (long)n_wg * NTHREADS) *(u32x4*)(Win_t + (size_t)13888 * 1024 + i * 8) = uzero4();
    }
    if (MOE) {
#define MOE_ITEM(r_, src, ldn, dst, kb) do { int r = (r_); \
            if (r < N_GU) { const int e = r / (16 * 32); r -= e * 16 * 32; kb = r / 32; const int sb = r % 32; const int s2 = sb & 15; const int drow = e * 2048 + 256 * (s2 / 2) + 64 * (s2 % 2) + (sb >= 16 ? 128 : 0); \
                src = c.in[I_WGU] + ((size_t)l * 32 + e) * 1024 * 2048 + sb * 64; ldn = 2048; dst = (unsigned char*)c.Wgu_t + (size_t)drow * 1024; } \
            else { r -= N_GU; const int e = r / (16 * 16); r -= e * 16 * 16; kb = r / 16; const int sb = r % 16; \
                src = c.in[I_WDN] + ((size_t)l * 32 + e) * 1024 * 1024 + sb * 64; ldn = 1024; dst = (unsigned char*)c.Wdn_t + (size_t)(e * 1024 + sb * 64) * 1024; } } while (0)
        float v[64]; const float* src; unsigned char* dst; int ldn, kb; int it = gw;
        if (it < N_GU + N_DN) { MOE_ITEM(it, src, ldn, dst, kb); cvt8_load(v, src, ldn, kb * 64, lane); }
#pragma unroll 1
        for (; it < N_GU + N_DN; it += NGW) {
            cvt8_put(v, scr, lane, 64.0f);
            unsigned char* dcur = dst; const int kcur = kb;
            if (it + NGW < N_GU + N_DN) { MOE_ITEM(it + NGW, src, ldn, dst, kb); cvt8_load(v, src, ldn, kb * 64, lane); }
            cvt8_out(dcur, 1024, kcur * 64, scr, lane);
        }
#undef MOE_ITEM
    }
}
__device__ __forceinline__ void cvt_x8(const float* x, bf16_t* o, long i) {
    const f32x4 a = *(const f32x4*)(x + i * 8), b = *(const f32x4*)(x + i * 8 + 4);
    *(u32x4*)(o + i * 8) = pack8(a, b);
}
#endif

#define LOOP(count, stmt) do { unsigned t_ = threadIdx.x; asm volatile("" : "+v"(t_)); const long gth_ = (long)c.grid * NTHREADS; for (long i = (long)blockIdx.x * NTHREADS + t_; i < (long)(count); i += gth_) { stmt; } } while (0)
#define SYNC() xcd_barrier(bar)
constexpr int ox_T = 16384;

#if defined(__HIP_DEVICE_COMPILE__)
constexpr int LDS_TAB = 131072;
constexpr int NSLOT_MAX = 65536 + 32 * 256;
#define SWZ_XOR(v, k) __int_as_float(__builtin_amdgcn_ds_swizzle(__float_as_int(v), ((k) << 10) | 0x1f))
__device__ __forceinline__ float wave_sum(float v) {
    v += SWZ_XOR(v, 1); v += SWZ_XOR(v, 2); v += SWZ_XOR(v, 4); v += SWZ_XOR(v, 8); v += SWZ_XOR(v, 16);
    return __int_as_float(__builtin_amdgcn_readlane(__float_as_int(v), 0)) + __int_as_float(__builtin_amdgcn_readlane(__float_as_int(v), 32));
}
__device__ __forceinline__ void moe_count(const Ctx& c, LAS unsigned char* lds) {
    int tid = threadIdx.x; asm volatile("" : "+v"(tid));
    LAS int* cl = (LAS int*)lds;
    for (int gi = blockIdx.x; gi < ox_T / 64; gi += c.grid) {
        if (tid < 32) cl[tid] = 0;
        __syncthreads();
        if (tid < 256) atomicAdd((int*)(cl + c.topidx[gi * 256 + tid]), 1);
        __syncthreads();
        if (tid < 32) c.moe_cnt[gi * 32 + tid] = cl[tid];
        __syncthreads();
    }
}
__device__ __forceinline__ void moe_assign(const Ctx& c, LAS unsigned char* lds) {
    int tid = threadIdx.x; asm volatile("" : "+v"(tid));
    LAS int* tbl = (LAS int*)lds;
    LAS int* total = tbl + 8192;
    LAS int* pstart = total + 32;
    LAS int* base = pstart + 40;
    LAS int* eids = base + 32;
    __syncthreads();
    for (int i = tid; i < 8192; i += NTHREADS) tbl[i] = c.moe_cnt[i];
    __syncthreads();
    if (tid < 32) { int s = 0; for (int gi = 0; gi < 256; ++gi) s += tbl[gi * 32 + tid]; total[tid] = s; }
    __syncthreads();
    if (tid == 0) { int p = 0; for (int e = 0; e < 32; ++e) { pstart[e] = p; p += (total[e] + 255) / 256 * 256; } pstart[32] = p; }
    __syncthreads();
    if (blockIdx.x == 0 && tid < 33) c.moe_pstart[tid] = pstart[tid];
    if (blockIdx.x == 0 && tid < 288) c.moe_done[tid] = 0;
    for (int e = blockIdx.x; e < 32; e += c.grid) {
        const int r0 = pstart[e] + total[e], r1 = pstart[e + 1];
        for (int i = r0 + tid; i < r1; i += NTHREADS) c.slot_tok[i] = ox_T;
    }
    for (int gi = blockIdx.x; gi < ox_T / 64; gi += c.grid) {
        if (tid < 32) { int s = pstart[tid]; for (int g2 = 0; g2 < gi; ++g2) s += tbl[g2 * 32 + tid]; base[tid] = s; }
        if (tid < 256) eids[tid] = c.topidx[gi * 256 + tid];
        __syncthreads();
        if (tid < 256) { const int e = eids[tid]; int r = 0; for (int a = 0; a < tid; ++a) r += (eids[a] == e) ? 1 : 0;
            const int slot = base[e] + r; c.tok_slot[gi * 256 + tid] = slot; c.slot_gate[slot] = c.gate[gi * 256 + tid]; c.slot_tok[slot] = gi * 64 + (tid >> 2); }
        __syncthreads();
    }
}
__device__ __forceinline__ int xcd_chunk(long L, int n) { const int q = n / 8, r = n % 8, xcd = (int)(L % 8), off = (int)(L / 8); return (xcd < r ? xcd * (q + 1) : r * (q + 1) + (xcd - r) * q) + off; }
__device__ __forceinline__ void moe_early(int nb, int G, int& M, int& first_idle) {
    const int rem = (nb * 8) % G; first_idle = rem; const int idle = rem ? G - rem : 0, left = (nb * 4) % G;
    int m = (left + 31) / 32; if (m > 7 || 32 * m > idle) m = 0;
    M = m;
}
struct MoeOrder {
    const LAS int* blkexp; int nunits, G, c, lgN, mode, nb, M, first_idle;
    __device__ __forceinline__ int base(int x) const { return (x * nb + 7) / 8 + 20; }
    __device__ __forceinline__ bool next(int i, gx::Unit& u) const {
        if (mode == 1) { const int j = c - first_idle; if (i > 0 || j < 0 || j >= 32 * M) return false; const int t = j >> 3; u.pm = base(j & 7) + (t >> 2); u.pn = t & 3; u.e = blkexp[u.pm]; u.f = 0; return true; }
        const long L = (long)i * G + c; if (L >= nunits) return false;
        int id = xcd_chunk(L, nunits); if (mode == 2) id = nunits - 1 - id;
        int pm = id >> lgN, f = 0; u.pn = id & ((1 << lgN) - 1);
        if (mode == 2) { for (int x = 0; x < 8; ++x) pm += (pm >= base(x)) ? M : 0; }
        else { for (int x = 0; x < 8; ++x) f |= ((unsigned)(pm - base(x)) < (unsigned)M) ? 1 : 0; }
        u.pm = pm; u.e = blkexp[pm]; u.f = f; return true;
    }
};
__device__ __forceinline__ void moe_wait_rows(const int* done, int rb, int need = 64) {
    int tid = threadIdx.x; asm volatile("" : "+v"(tid));
    if (tid == 0) { unsigned sp = 0; while (__hip_atomic_load(done + rb, __ATOMIC_RELAXED, __HIP_MEMORY_SCOPE_AGENT) < need && ++sp < (1u << 22)) __builtin_amdgcn_s_sleep(2); }
    __syncthreads();
    __builtin_amdgcn_fence(__ATOMIC_ACQUIRE, "agent");
}
__device__ __forceinline__ int moe_blocks(const Ctx& c, LAS unsigned char* lds) {
    int tid = threadIdx.x; asm volatile("" : "+v"(tid));
    LAS int* blkexp = (LAS int*)(lds + LDS_TAB); LAS int* ps = blkexp + 288;
    if (tid < 33) ps[tid] = c.moe_pstart[tid];
    __syncthreads();
    const int nb = ps[32] / 256;
    if (tid < nb) { int e = 0; for (int k = 1; k < 32; ++k) e += (ps[k] <= tid * 256) ? 1 : 0; blkexp[tid] = e; }
    __syncthreads();
    return nb;
}
struct EpiSwiglu {
    static constexpr bool PERM = true;
    unsigned char* O; const float* bgu; int* done;
    __device__ __forceinline__ void operator()(const f32x4 (&acc)[2][2][4][2], const gx::Unit& u, int wr, int wc, int fr, int fq) const {
        const int row0 = u.pm * 256 + wr * 64 + fr, col = u.pn * 128 + wc * 32 + 8 * fq;
        const float* bp = bgu + (size_t)u.e * 2048 + col;
        const f32x4 bg0 = *(const f32x4*)bp, bg1 = *(const f32x4*)(bp + 4), bl0 = *(const f32x4*)(bp + 1024), bl1 = *(const f32x4*)(bp + 1028);
#pragma unroll
        for (int ai = 0; ai < 2; ++ai)
#pragma unroll
            for (int m = 0; m < 4; ++m) {
                f32x4 o[2];
#pragma unroll
                for (int n = 0; n < 2; ++n) {
                    const f32x4 xg = acc[ai][0][m][n] * (1.0f / 64.0f) + (n ? bg1 : bg0), xl = acc[ai][1][m][n] * (1.0f / 64.0f) + (n ? bl1 : bl0);
#pragma unroll
                    for (int j = 0; j < 4; ++j) { const float a = fminf(xg[j], 7.0f), b = fminf(fmaxf(xl[j], -7.0f), 7.0f); o[n][j] = a * fast_sigmoid(1.702f * a) * (b + 1.0f); }
                }
                u32x2 w; w.x = pk4_fp8(o[0][0], o[0][1], o[0][2], o[0][3]); w.y = pk4_fp8(o[1][0], o[1][1], o[1][2], o[1][3]); unsigned char* dst = O + (size_t)(row0 + ai * 128 + m * 16) * 1024 + col;
                if (u.f) __hip_atomic_store((unsigned long long*)dst, (unsigned long long)w.x | ((unsigned long long)w.y << 32), __ATOMIC_RELAXED, __HIP_MEMORY_SCOPE_AGENT);
                else *(u32x2*)dst = w;
            }
        if (u.f) { asm volatile("s_waitcnt vmcnt(0)" ::: "memory"); if ((fr | fq) == 0) (void)__hip_atomic_fetch_add(done + u.pm, 1, __ATOMIC_RELAXED, __HIP_MEMORY_SCOPE_AGENT); }
    }
};
struct EpiDown {
    static constexpr bool PERM = true;
    bf16_t* O; const float* bdn; const float* sg;
    __device__ __forceinline__ void operator()(const f32x4 (&acc)[2][2][4][2], const gx::Unit& u, int wr, int wc, int fr, int fq) const {
        const int row0 = u.pm * 256 + wr * 64 + fr, cl = u.pn * 256 + wc * 32 + 8 * fq;
        f32x4 b[2][2];
#pragma unroll
        for (int bj = 0; bj < 2; ++bj) { b[bj][0] = *(const f32x4*)(bdn + (size_t)u.e * 1024 + cl + bj * 128); b[bj][1] = *(const f32x4*)(bdn + (size_t)u.e * 1024 + cl + bj * 128 + 4); }
#pragma unroll
        for (int ai = 0; ai < 2; ++ai)
#pragma unroll
            for (int m = 0; m < 4; ++m) { const size_t row = (size_t)(row0 + ai * 128 + m * 16); const float gt = sg[row];
#pragma unroll
                for (int bj = 0; bj < 2; ++bj) *(u32x4*)(O + row * 1024 + cl + bj * 128) = pack8((acc[ai][bj][m][0] * (1.0f / 64.0f) + b[bj][0]) * gt, (acc[ai][bj][m][1] * (1.0f / 64.0f) + b[bj][1]) * gt); }
    }
};
__device__ __forceinline__ void moe_combine_ln(const Ctx& c, const float* g, const float* b, float* out  ) {
    int tid = threadIdx.x; asm volatile("" : "+v"(tid)); const int wave = __builtin_amdgcn_readfirstlane(tid >> 6), lane = tid & 63;
    const int stride = c.grid * 8; int t = blockIdx.x * 8 + wave;
    if (t >= ox_T) return;
    u32x2 xa[4]; u32x2 ya[4][4]; int sn[4];
#define CMB_SLOTS(dst, tt) do { _Pragma("unroll") for (int k = 0; k < 4; ++k) dst[k] = c.tok_slot[(tt) * 4 + k]; } while (0)
#define CMB_ROWS(xd, yd, tt, sl) do { _Pragma("unroll") for (int j = 0; j < 4; ++j) { const int col = lane * 4 + 256 * j; xd[j] = *(const u32x2*)(c.x1b + (size_t)(tt) * 1024 + col); \
        _Pragma("unroll") for (int k = 0; k < 4; ++k) yd[k][j] = *(const u32x2*)(c.ys2 + (size_t)sl[k] * 1024 + col); } } while (0)
    CMB_SLOTS(sn, t); CMB_ROWS(xa, ya, t, sn);
    { const int t1 = t + stride < ox_T ? t + stride : t; CMB_SLOTS(sn, t1); }
#pragma unroll 1
    for (; t < ox_T; t += stride) {
        f32x4 v[4]; float s = 0.f;
#pragma unroll
        for (int j = 0; j < 4; ++j) { f32x4 a = (f32x4){bflo(xa[j].x), bfhi(xa[j].x), bflo(xa[j].y), bfhi(xa[j].y)} * md::ALPHA;
            a[0] += (bflo(ya[0][j].x) + bflo(ya[1][j].x)) + (bflo(ya[2][j].x) + bflo(ya[3][j].x)); a[1] += (bfhi(ya[0][j].x) + bfhi(ya[1][j].x)) + (bfhi(ya[2][j].x) + bfhi(ya[3][j].x));
            a[2] += (bflo(ya[0][j].y) + bflo(ya[1][j].y)) + (bflo(ya[2][j].y) + bflo(ya[3][j].y)); a[3] += (bfhi(ya[0][j].y) + bfhi(ya[1][j].y)) + (bfhi(ya[2][j].y) + bfhi(ya[3][j].y));
            v[j] = a; s += (a[0] + a[1]) + (a[2] + a[3]); }
        { const int t1 = t + stride < ox_T ? t + stride : t, t2 = t + 2 * stride < ox_T ? t + 2 * stride : t; CMB_ROWS(xa, ya, t1, sn); CMB_SLOTS(sn, t2); }
        const float mean = wave_sum(s) * (1.0f / 1024.0f); float q = 0.f;
#pragma unroll
        for (int j = 0; j < 4; ++j) { v[j] = v[j] - mean; q += (v[j][0] * v[j][0] + v[j][1] * v[j][1]) + (v[j][2] * v[j][2] + v[j][3] * v[j][3]); }
        const float rstd = __builtin_amdgcn_rsqf(wave_sum(q) * (1.0f / 1024.0f) + md::EPS);
#pragma unroll
        for (int j = 0; j < 4; ++j) { const int col = lane * 4 + 256 * j; const f32x4 gg = *(const f32x4*)(g + col), bb = *(const f32x4*)(b + col);
            const f32x4 y = v[j] * rstd * gg + bb; if (out) *(f32x4*)(out + (size_t)t * 1024 + col) = y;
            u32x2 w; w.x = cvt_pk_bf16(y[0], y[1]); w.y = cvt_pk_bf16(y[2], y[3]); *(u32x2*)(c.xbf + (size_t)t * 1024 + col) = w; }
    }
#undef CMB_SLOTS
#undef CMB_ROWS
}
namespace ssd {
constexpr int PITCH = 272;
constexpr int XST_OFF = 0;
constexpr int R1_OFF = 69632;
constexpr int R2_OFF = 104448;
constexpr int S1_VEC = 104448;
constexpr int S3_VEC = 139264;
constexpr int NC = 64;
__device__ __forceinline__ size_t st_index(int dir, int b, int cidx, int h) { return ((((size_t)dir * 2 + b) * NC + cidx) * 32 + h) * 8192; }

__device__ __forceinline__ float softplus_fast(float x) { const float e = __expf(-fabsf(x)); return fmaxf(x, 0.0f) + (e < 1e-3f ? e * (1.0f - 0.5f * e) : __logf(1.0f + e)); }

__device__ __forceinline__ float cumsum8(LAS float* a, int wave, int lane) {
    LAS float* p = a + wave * 128 + 2 * lane;
    const float a0 = p[0], a1 = p[1];
    float v = a0 + a1;
#pragma unroll
    for (int off = 1; off < 64; off <<= 1) { const float t = __int_as_float(__builtin_amdgcn_ds_bpermute((lane - off) << 2, __float_as_int(v))); if (lane >= off) v += t; }
    const float total = __int_as_float(__builtin_amdgcn_readlane(__float_as_int(v), 63));
    if (wave < 4) { p[0] = v - a1; p[1] = v; } else { p[0] = total - (v - a1 - a0); p[1] = total - (v - a1); }
    return total;
}
template <int MODE>
__device__ __forceinline__ void load_conv(const Ctx& c, int l, int b, int cidx, int g, LAS unsigned char* lds, int tid) {
    const int cg = tid & 63, lg = tid >> 6;
    if (MODE == 1 && cg >= 48) return;
    const int col = cg < 32 ? 256 * g + 8 * cg : (cg < 48 ? 2048 + 128 * g + 8 * (cg - 32) : 3072 + 128 * g + 8 * (cg - 48));
    const float* cw = c.in[I_CONVW] + (size_t)l * 5 * 4096 + col; const float* cb = c.in[I_CONVB] + (size_t)l * 4096 + col;
    float w[5][8], bias[8];
#pragma unroll
    for (int k = 0; k < 5; ++k) { const f32x4 a = *(const f32x4*)(cw + k * 4096), bq = *(const f32x4*)(cw + k * 4096 + 4);
        w[k][0] = a[0]; w[k][1] = a[1]; w[k][2] = a[2]; w[k][3] = a[3]; w[k][4] = bq[0]; w[k][5] = bq[1]; w[k][6] = bq[2]; w[k][7] = bq[3]; }
    { const f32x4 a = *(const f32x4*)cb, bq = *(const f32x4*)(cb + 4); bias[0] = a[0]; bias[1] = a[1]; bias[2] = a[2]; bias[3] = a[3]; bias[4] = bq[0]; bias[5] = bq[1]; bias[6] = bq[2]; bias[7] = bq[3]; }
    const int tl0 = cidx * 128 + lg * 16 - 2;
    const bf16_t* src = c.XBCb + ((size_t)b * 8192) * 4096 + col;
    u32x4 rows[20];
#pragma unroll
    for (int i = 0; i < 20; ++i) { const int tl = tl0 + i; rows[i] = (tl >= 0 && tl < 8192) ? *(const u32x4*)(src + (size_t)tl * 4096) : uzero4(); }
    unsigned outp[8][8];
#pragma unroll
    for (int lo = 0; lo < 16; lo += 2) {
        float v[2][8];
#pragma unroll
        for (int d = 0; d < 2; ++d) {
#pragma unroll
            for (int j = 0; j < 8; ++j) v[d][j] = bias[j];
#pragma unroll
            for (int k = 0; k < 5; ++k) { const u32x4 r = rows[lo + d + k];
                v[d][0] += w[k][0] * bflo(r.x); v[d][1] += w[k][1] * bfhi(r.x); v[d][2] += w[k][2] * bflo(r.y); v[d][3] += w[k][3] * bfhi(r.y);
                v[d][4] += w[k][4] * bflo(r.z); v[d][5] += w[k][5] * bfhi(r.z); v[d][6] += w[k][6] * bflo(r.w); v[d][7] += w[k][7] * bfhi(r.w); }
#pragma unroll
            for (int j = 0; j < 8; ++j) v[d][j] = v[d][j] * fast_sigmoid(v[d][j]);
        }
        if (MODE == 3 && cg >= 32) {
            LAS unsigned char* base = lds + (cg < 48 ? R2_OFF : R1_OFF) + (8 * (cg < 48 ? cg - 32 : cg - 48)) * 2;
#pragma unroll
            for (int d = 0; d < 2; ++d) { f32x4 v0 = (f32x4){v[d][0], v[d][1], v[d][2], v[d][3]}, v1 = (f32x4){v[d][4], v[d][5], v[d][6], v[d][7]};
                *(LAS u32x4*)(base + (lg * 16 + lo + d) * PITCH) = pack8(v0, v1); }
        } else {
#pragma unroll
            for (int j = 0; j < 8; ++j) outp[j][lo >> 1] = cvt_pk_bf16(v[0][j], v[1][j]);
        }
    }
    if (!(MODE == 3 && cg >= 32)) {
        LAS unsigned char* base = lds + (cg < 32 ? XST_OFF + (8 * cg) * PITCH : R1_OFF + (8 * (cg - 32)) * PITCH) + (lg * 16) * 2;
#pragma unroll
        for (int j = 0; j < 8; ++j) { *(LAS u32x4*)(base + j * PITCH) = (u32x4){outp[j][0], outp[j][1], outp[j][2], outp[j][3]}; *(LAS u32x4*)(base + j * PITCH + 16) = (u32x4){outp[j][4], outp[j][5], outp[j][6], outp[j][7]}; }
    }
}

__device__ __forceinline__ void phase_s1(const Ctx& c, int l, LAS unsigned char* lds) {
    int tid = threadIdx.x;
    LAS float* dl = (LAS float*)(lds + S1_VEC); LAS float* ac = dl + 1024; LAS float* wv = ac + 1024;
    for (int item_ = blockIdx.x; item_ < 1024; item_ += c.grid) { const int item = 1023 - item_;
        asm volatile("" : "+v"(tid));
        const int wave = __builtin_amdgcn_readfirstlane(tid >> 6), lane = tid & 63, fr = lane & 15, q = lane >> 4;
        const int g = item & 7, cidx = (item >> 3) & 63, b = item >> 9; const size_t t0 = (size_t)b * 8192 + cidx * 128;
        load_conv<1>(c, l, b, cidx, g, lds, tid);
#pragma unroll
        for (int k = 0; k < 2; ++k) { const int e = tid + 512 * k, dir = e >> 9, r = (e >> 7) & 3, ll = e & 127, h = 4 * g + r;
            const float delta = softplus_fast(c.dtf[(t0 + ll) * 64 + dir * 32 + h] + c.in[I_DTB][l * 64 + dir * 32 + h]);
            dl[e] = delta; ac[e] = -__expf(c.in[I_ALOG][l * 64 + dir * 32 + h]) * delta; }
        __syncthreads();
        { const float tot = cumsum8(ac, wave, lane); if (lane == 0) c.ssd_tot[(((wave >> 2) * 2 + b) * NC + cidx) * 32 + 4 * g + (wave & 3)] = tot; }
        __syncthreads();
#pragma unroll
        for (int k = 0; k < 2; ++k) { const int e = tid + 512 * k, dir = e >> 9; const float tot = ac[(e & ~127) + (dir ? 0 : 127)]; wv[e] = dl[e] * __expf(tot - ac[e]); }
        __syncthreads();
        {
            const int r = wave & 3, dir = wave >> 2;
            f32x4 acc[8][4];
#pragma unroll
            for (int nt = 0; nt < 8; ++nt)
#pragma unroll
                for (int pt = 0; pt < 4; ++pt) acc[nt][pt] = zero4();
#pragma unroll
            for (int k = 0; k < 4; ++k) {
                const LAS float* wp = wv + (dir * 4 + r) * 128 + 32 * k + 8 * q;
                const f32x4 w0 = *(const LAS f32x4*)wp, w1 = *(const LAS f32x4*)(wp + 4);
                bf16x8 bfrag[4];
#pragma unroll
                for (int pt = 0; pt < 4; ++pt) { const u32x4 x = *(const LAS u32x4*)(lds + XST_OFF + (r * 64 + 16 * pt + fr) * PITCH + (32 * k + 8 * q) * 2);
                    u32x4 y; y.x = cvt_pk_bf16(bflo(x.x) * w0[0], bfhi(x.x) * w0[1]); y.y = cvt_pk_bf16(bflo(x.y) * w0[2], bfhi(x.y) * w0[3]);
                    y.z = cvt_pk_bf16(bflo(x.z) * w1[0], bfhi(x.z) * w1[1]); y.w = cvt_pk_bf16(bflo(x.w) * w1[2], bfhi(x.w) * w1[3]);
                    bfrag[pt] = __builtin_bit_cast(bf16x8, y); }
#pragma unroll
                for (int nt = 0; nt < 8; ++nt) { const bf16x8 af = *(const LAS bf16x8*)(lds + R1_OFF + (16 * nt + fr) * PITCH + (32 * k + 8 * q) * 2);
#pragma unroll
                    for (int pt = 0; pt < 4; ++pt) acc[nt][pt] = __builtin_amdgcn_mfma_f32_16x16x32_bf16(af, bfrag[pt], acc[nt][pt], 0, 0, 0); }
            }
            bf16_t* So = c.ssd_S + st_index(dir, b, cidx, 4 * g + r);
#pragma unroll
            for (int nt = 0; nt < 8; ++nt)
#pragma unroll
                for (int pt = 0; pt < 4; ++pt) { u32x2 o; o.x = cvt_pk_bf16(acc[nt][pt][0], acc[nt][pt][1]); o.y = cvt_pk_bf16(acc[nt][pt][2], acc[nt][pt][3]);
                    *(u32x2*)(So + (size_t)(16 * pt + fr) * 128 + 16 * nt + 4 * q) = o; }
        }
        __syncthreads();
    }
}
__device__ __forceinline__ void phase_s2(const Ctx& c) {
    int tid = threadIdx.x; asm volatile("" : "+v"(tid));
    for (int i = blockIdx.x * NTHREADS + tid; i < 2 * 2 * 32 * 64 * 16; i += c.grid * NTHREADS) {
        const int n8 = i & 15, p = (i >> 4) & 63, h = (i >> 10) & 31, b = (i >> 15) & 1, dir = i >> 16;
        float st[8];
#pragma unroll
        for (int j = 0; j < 8; ++j) st[j] = 0.f;
#pragma unroll 1
        for (int s0 = 0; s0 < NC; s0 += 8) {
            u32x4 x[8]; float dec[8];
#pragma unroll
            for (int u = 0; u < 8; ++u) { const int cidx = dir ? NC - 1 - (s0 + u) : s0 + u;
                x[u] = *(const u32x4*)(c.ssd_S + st_index(dir, b, cidx, h) + p * 128 + n8 * 8); dec[u] = c.ssd_tot[((dir * 2 + b) * NC + cidx) * 32 + h]; }
#pragma unroll
            for (int u = 0; u < 8; ++u) { const int cidx = dir ? NC - 1 - (s0 + u) : s0 + u; const float dq = __expf(dec[u]);
                *(u32x4*)(c.ssd_S + st_index(dir, b, cidx, h) + p * 128 + n8 * 8) = pack8((f32x4){st[0], st[1], st[2], st[3]}, (f32x4){st[4], st[5], st[6], st[7]});
                st[0] = st[0] * dq + bflo(x[u].x); st[1] = st[1] * dq + bfhi(x[u].x); st[2] = st[2] * dq + bflo(x[u].y); st[3] = st[3] * dq + bfhi(x[u].y);
                st[4] = st[4] * dq + bflo(x[u].z); st[5] = st[5] * dq + bfhi(x[u].z); st[6] = st[6] * dq + bflo(x[u].w); st[7] = st[7] * dq + bfhi(x[u].w); }
        }
    }
}
template <bool ZRAW>
__device__ __forceinline__ void phase_s3(const Ctx& c, int l, LAS unsigned char* lds) {
    int tid = threadIdx.x;
    LAS float* acf = (LAS float*)(lds + S3_VEC); LAS float* rcb = acf + 512; LAS float* gf = rcb + 512; LAS float* gb = gf + 512; LAS float* dl = gb + 512; LAS float* ssq = dl + 1024;
    for (int item = blockIdx.x; item < 1024; item += c.grid) {
        asm volatile("" : "+v"(tid));
        const int wave = __builtin_amdgcn_readfirstlane(tid >> 6), lane = tid & 63, fr = lane & 15, q = lane >> 4;
        const int g = item & 7, cidx = (item >> 3) & 63, b = item >> 9; const size_t t0 = (size_t)b * 8192 + cidx * 128;
        const int hrow = tid >> 2, hpart = tid & 3;
        u32x4 hreg[4];
        { const bf16_t* src = c.ssd_S + st_index(hrow >> 6, b, cidx, 4 * g) + (size_t)(hrow & 63) * 128 + hpart * 32;
            hreg[0] = *(const u32x4*)src; hreg[1] = *(const u32x4*)(src + 8); hreg[2] = *(const u32x4*)(src + 16); hreg[3] = *(const u32x4*)(src + 24); }
        load_conv<3>(c, l, b, cidx, g, lds, tid);
#pragma unroll
        for (int k = 0; k < 2; ++k) { const int e = tid + 512 * k, dir = e >> 9, r = (e >> 7) & 3, ll = e & 127, h = 4 * g + r;
            const float delta = softplus_fast(c.dtf[(t0 + ll) * 64 + dir * 32 + h] + c.in[I_DTB][l * 64 + dir * 32 + h]);
            dl[e] = delta; acf[e] = -__expf(c.in[I_ALOG][l * 64 + dir * 32 + h]) * delta; }
        __syncthreads();
        (void)cumsum8(acf, wave, lane);
        __syncthreads();
#pragma unroll
        for (int k = 0; k < 2; ++k) { const int e = tid + 512 * k; gf[e] = __logf(dl[e]) - acf[e]; }
        __syncthreads();
        const int lrow = 16 * wave + fr;
        bf16x8 cfrag[4];
#pragma unroll
        for (int k = 0; k < 4; ++k) cfrag[k] = *(const LAS bf16x8*)(lds + R1_OFF + lrow * PITCH + (32 * k + 8 * q) * 2);
        f32x4 cbt[8];
#pragma unroll
        for (int a = 0; a < 8; ++a) { cbt[a] = zero4();
#pragma unroll
            for (int k = 0; k < 4; ++k) { const bf16x8 bf = *(const LAS bf16x8*)(lds + R2_OFF + (16 * a + fr) * PITCH + (32 * k + 8 * q) * 2);
                cbt[a] = __builtin_amdgcn_mfma_f32_16x16x32_bf16(bf, cfrag[k], cbt[a], 0, 0, 0); } }
        __syncthreads();
        float ssq_l = 0.f;
#pragma unroll 1
        for (int r = 0; r < 4; ++r) {
            const int h = 4 * g + r;
            LAS unsigned char* hb = lds + ((r & 1) ? R1_OFF : R2_OFF);
            { LAS u32x4* dst = (LAS u32x4*)(hb + hrow * PITCH + hpart * 64); dst[0] = hreg[0]; dst[1] = hreg[1]; dst[2] = hreg[2]; dst[3] = hreg[3]; }
            if (r < 3) { const bf16_t* src = c.ssd_S + st_index(hrow >> 6, b, cidx, h + 1) + (size_t)(hrow & 63) * 128 + hpart * 32;
                hreg[0] = *(const u32x4*)src; hreg[1] = *(const u32x4*)(src + 8); hreg[2] = *(const u32x4*)(src + 16); hreg[3] = *(const u32x4*)(src + 24); }
            const size_t trow = t0 + lrow;
            u32x2 zpre[4];
#pragma unroll
            for (int pt = 0; pt < 4; ++pt) zpre[pt] = *(const u32x2*)(c.Zb + trow * 2048 + h * 64 + 16 * pt + 4 * q);
            const float af_l = acf[r * 128 + lrow], rb_l = rcb[r * 128 + lrow], dsk = c.in[I_SSDD][l * 32 + h];
            bf16x8 mfrag[4];
#pragma unroll
            for (int kk = 0; kk < 4; ++kk) {
                float m[8];
#pragma unroll
                for (int half = 0; half < 2; ++half) { const int a = 2 * kk + half, s0 = 16 * a + 4 * q;
                    if (a < wave) {
                        const f32x4 gfv = *(const LAS f32x4*)(gf + r * 128 + s0);
#pragma unroll
                        for (int j = 0; j < 4; ++j) m[half * 4 + j] = cbt[a][j] * __expf(af_l + gfv[j]);
                    } else if (a > wave) {
                        const f32x4 gbv = *(const LAS f32x4*)(gb + r * 128 + s0);
#pragma unroll
                        for (int j = 0; j < 4; ++j) m[half * 4 + j] = cbt[a][j] * __expf(rb_l + gbv[j]);
                    } else {
                        const f32x4 gfv = *(const LAS f32x4*)(gf + r * 128 + s0), gbv = *(const LAS f32x4*)(gb + r * 128 + s0);
#pragma unroll
                        for (int j = 0; j < 4; ++j) { const int s = s0 + j;
                            const float tf = (s <= lrow) ? __expf(af_l + gfv[j]) : 0.f, tb = (s >= lrow) ? __expf(rb_l + gbv[j]) : 0.f;
                            m[half * 4 + j] = cbt[a][j] * (tf + tb) + ((s == lrow) ? dsk : 0.f); } } }
                u32x4 y; y.x = cvt_pk_bf16(m[0], m[1]); y.y = cvt_pk_bf16(m[2], m[3]); y.z = cvt_pk_bf16(m[4], m[5]); y.w = cvt_pk_bf16(m[6], m[7]);
                mfrag[kk] = __builtin_bit_cast(bf16x8, y);
            }
            __syncthreads();
            const float ef = __expf(af_l), eb = __expf(rb_l);
#pragma unroll 1
            for (int ph = 0; ph < 2; ++ph) {
                f32x4 accd[2], accf[2], accb[2];
#pragma unroll
                for (int p2 = 0; p2 < 2; ++p2) { accd[p2] = zero4(); accf[p2] = accd[p2]; accb[p2] = accd[p2]; }
#pragma unroll
                for (int kk = 0; kk < 4; ++kk)
#pragma unroll
                    for (int p2 = 0; p2 < 2; ++p2) { const int pt = 2 * ph + p2;
                        const LAS unsigned char* xr = lds + XST_OFF + (r * 64 + 16 * pt + fr) * PITCH + (32 * kk + 4 * q) * 2;
                        const u32x2 x0 = *(const LAS u32x2*)xr, x1 = *(const LAS u32x2*)(xr + 32);
                        const u32x4 xa = (u32x4){x0.x, x0.y, x1.x, x1.y};
                        accd[p2] = __builtin_amdgcn_mfma_f32_16x16x32_bf16(__builtin_bit_cast(bf16x8, xa), mfrag[kk], accd[p2], 0, 0, 0);
                        const bf16x8 hf = *(const LAS bf16x8*)(hb + (16 * pt + fr) * PITCH + (32 * kk + 8 * q) * 2);
                        const bf16x8 hbk = *(const LAS bf16x8*)(hb + (64 + 16 * pt + fr) * PITCH + (32 * kk + 8 * q) * 2);
                        accf[p2] = __builtin_amdgcn_mfma_f32_16x16x32_bf16(hf, cfrag[kk], accf[p2], 0, 0, 0);
                        accb[p2] = __builtin_amdgcn_mfma_f32_16x16x32_bf16(hbk, cfrag[kk], accb[p2], 0, 0, 0);
                    }
#pragma unroll
                for (int p2 = 0; p2 < 2; ++p2) { const int pt = 2 * ph + p2;
                    const int col = h * 64 + 16 * pt + 4 * q;
                    const u32x2 zw = p2 ? (ph ? zpre[3] : zpre[1]) : (ph ? zpre[2] : zpre[0]);
                    float zz[4] = {bflo(zw.x), bfhi(zw.x), bflo(zw.y), bfhi(zw.y)}, yv[4];
#pragma unroll
                    for (int j = 0; j < 4; ++j) { const float zg = ZRAW ? zz[j] * fast_sigmoid(zz[j]) : zz[j]; yv[j] = (accd[p2][j] + ef * accf[p2][j] + eb * accb[p2][j]) * zg; ssq_l += yv[j] * yv[j]; }
                    u32x2 o; o.x = cvt_pk_bf16(yv[0], yv[1]); o.y = cvt_pk_bf16(yv[2], yv[3]);
                    *(u32x2*)(c.yssdb + trow * 2048 + col) = o;
                }
            }
        }
        ssq[lrow * 4 + q] = ssq_l;
        __syncthreads();
        if (tid < 128) c.ssd_ssq[(t0 + tid) * 8 + g] = (ssq[tid * 4] + ssq[tid * 4 + 1]) + (ssq[tid * 4 + 2] + ssq[tid * 4 + 3]);
        __syncthreads();
    }
}
}
namespace s5 {
constexpr int NROWS = 72 * 1024;
__device__ __forceinline__ void prologue(const Ctx& c, int l, int par, LAS unsigned char* lds, int first_wg, int n_wg) {
    int tid = threadIdx.x; asm volatile("" : "+v"(tid));
    LAS float* pw = (LAS float*)lds;
    LAS float* bb = pw + 2 * 17 * 64 * 2;
    LAS float* cc = bb + 2 * 64 * 16 * 2;
    LAS float* Kt = cc + 2 * 16 * 130;
    __syncthreads();
    for (int g = (int)blockIdx.x >= first_wg ? (int)blockIdx.x - first_wg : 72; g < 72; g += n_wg) {
        if (tid < 128) { const int d = tid >> 6, n = tid & 63;
            const float ar = c.in[I_S5ARE][((size_t)(l * 2 + d) * 72 + g) * 64 + n], ai = c.in[I_S5AIM][((size_t)(l * 2 + d) * 72 + g) * 64 + n];
            const float step = __expf(c.in[I_S5LS][(l * 2 + d) * 72 + g]);
            const float mag = __expf(step * ar); const float abr = mag * __cosf(step * ai), abi = mag * __sinf(step * ai);
            const float rden = __builtin_amdgcn_rcpf(ar * ar + ai * ai); const float fr = ((abr - 1.0f) * ar + abi * ai) * rden, fi = (abi * ar - (abr - 1.0f) * ai) * rden;
            { const float* brp = c.in[I_S5BRE] + (((size_t)l * 72 + g) * 64 + n) * 16; const float* bip = c.in[I_S5BIM] + (((size_t)l * 72 + g) * 64 + n) * 16;
              f32x4 brv[4], biv[4];
#pragma unroll
              for (int q4 = 0; q4 < 4; ++q4) { brv[q4] = *(const f32x4*)(brp + 4 * q4); biv[q4] = *(const f32x4*)(bip + 4 * q4); }
#pragma unroll
              for (int ch = 0; ch < 16; ++ch) { const float br = brv[ch >> 2][ch & 3], bi = biv[ch >> 2][ch & 3];
                  bb[((d * 64 + n) * 16 + ch) * 2] = fr * br - fi * bi; bb[((d * 64 + n) * 16 + ch) * 2 + 1] = fr * bi + fi * br; } }
            float pr = 1.0f, pi = 0.0f;
#pragma clang loop unroll(disable)
            for (int j = 0; j <= 16; ++j) { pw[((d * 17 + j) * 64 + n) * 2] = pr; pw[((d * 17 + j) * 64 + n) * 2 + 1] = pi; const float nr = pr * abr - pi * abi, ni = pr * abi + pi * abr; pr = nr; pi = ni; }
            float* a16 = c.s5_a16 + par * wsz::A16; a16[((g * 2 + d) * 64 + n) * 2] = pw[((d * 17 + 16) * 64 + n) * 2]; a16[((g * 2 + d) * 64 + n) * 2 + 1] = pw[((d * 17 + 16) * 64 + n) * 2 + 1]; }
        for (int i = tid; i < 2 * 16 * 64; i += NTHREADS) { const int d = i >> 10, ch = (i >> 6) & 15, n = i & 63;
            cc[(d * 16 + ch) * 130 + n * 2] = c.in[I_S5CRE][(((size_t)(l * 2 + d) * 72 + g) * 16 + ch) * 64 + n]; cc[(d * 16 + ch) * 130 + n * 2 + 1] = c.in[I_S5CIM][(((size_t)(l * 2 + d) * 72 + g) * 16 + ch) * 64 + n]; }
        __syncthreads();
        { const int lane = tid & 63, wv = __builtin_amdgcn_readfirstlane(tid >> 6), d = wv >> 2, r16 = lane & 15, kq = lane >> 4;
          float bre[16], bim[16];
#pragma unroll
          for (int sidx = 0; sidx < 16; ++sidx) { const LAS float* bp = bb + ((d * 64 + 4 * sidx + kq) * 16 + r16) * 2; bre[sidx] = bp[0]; bim[sidx] = bp[1]; }
#pragma clang loop unroll(disable)
          for (int jj = 0; jj < 4; ++jj) { const int j = 4 * (wv & 3) + jj; f32x4 acc = zero4();
#pragma unroll
              for (int sidx = 0; sidx < 16; ++sidx) { const int n = 4 * sidx + kq;
                  const float cr = cc[(d * 16 + r16) * 130 + n * 2], ci = cc[(d * 16 + r16) * 130 + n * 2 + 1], pr = pw[((d * 17 + j) * 64 + n) * 2], pi = pw[((d * 17 + j) * 64 + n) * 2 + 1];
                  const float wr = cr * pr - ci * pi, wi = cr * pi + ci * pr;
                  acc = __builtin_amdgcn_mfma_f32_16x16x4f32(wr, bre[sidx], acc, 0, 0, 0); acc = __builtin_amdgcn_mfma_f32_16x16x4f32(-wi, bim[sidx], acc, 0, 0, 0); }
#pragma unroll
              for (int r = 0; r < 4; ++r) Kt[((d * 16 + j) * 16 + 4 * kq + r) * 16 + r16] = acc[r]; } }
        __syncthreads();
        bf16_t* W1 = c.s5_W1 + par * wsz::S5W1 + (size_t)g * 512 * 256; bf16_t* Qm = c.s5_Q + par * wsz::S5Q + (size_t)g * 256 * 256;
        for (int i = tid; i < 256 * 256 / 2; i += NTHREADS) { const int row = i >> 7, col = (i & 127) * 2; const int l1 = row >> 4, c1 = row & 15, l2 = col >> 4, c2 = col & 15; float v[2];
#pragma unroll
            for (int e = 0; e < 2; ++e) { float s = 0.f; if (l2 <= l1) s += Kt[((0 * 16 + (l1 - l2)) * 16 + c1) * 16 + c2 + e]; if (l2 >= l1) s += Kt[((1 * 16 + (l2 - l1)) * 16 + c1) * 16 + c2 + e]; v[e] = s; }
            *(unsigned*)(W1 + (size_t)row * 256 + col) = cvt_pk_bf16(v[0], v[1]); }
        for (int i = tid; i < 256 * 256 / 2; i += NTHREADS) { const int row = i >> 7, col = (i & 127) * 2; const int d = row >> 7, part = (row >> 6) & 1, n = row & 63, l2 = col >> 4, c2 = col & 15;
            const int j = d ? l2 : 15 - l2; const float pr = pw[((d * 17 + j) * 64 + n) * 2], pi = pw[((d * 17 + j) * 64 + n) * 2 + 1]; float v[2];
#pragma unroll
            for (int e = 0; e < 2; ++e) { const float br = bb[((d * 64 + n) * 16 + c2 + e) * 2], bi = bb[((d * 64 + n) * 16 + c2 + e) * 2 + 1]; v[e] = part ? (pr * bi + pi * br) : (pr * br - pi * bi); }
            *(unsigned*)(W1 + (size_t)(256 + row) * 256 + col) = cvt_pk_bf16(v[0], v[1]); }
        for (int i = tid; i < 256 * 256 / 2; i += NTHREADS) { const int row = i >> 7, col = (i & 127) * 2; const int l1 = row >> 4, c1 = row & 15, d = col >> 7, part = (col >> 6) & 1, n = col & 63;
            const int j = d ? 16 - l1 : l1 + 1; float v[2];
#pragma unroll
            for (int e = 0; e < 2; ++e) { const float cr = cc[(d * 16 + c1) * 130 + (n + e) * 2], ci = cc[(d * 16 + c1) * 130 + (n + e) * 2 + 1], pr = pw[((d * 17 + j) * 64 + n + e) * 2], pi = pw[((d * 17 + j) * 64 + n + e) * 2 + 1];
                v[e] = part ? -(cr * pi + ci * pr) : (cr * pr - ci * pi); }
            *(unsigned*)(Qm + (size_t)row * 256 + col) = cvt_pk_bf16(v[0], v[1]); }
        __syncthreads();
    }
}
struct Order { int nunits, G, c, lgN, rev, mode;
    __device__ __forceinline__ int late_cnt() const { return (nunits > G && nunits <= 2 * G) ? nunits - G : 0; }
    __device__ __forceinline__ bool next(int i, gx::Unit& u) const {
        long L = (long)i * G + c; const int lc = late_cnt();
        if (mode == 2) { const int g3 = 576 % G, off = (g3 + lc <= G) ? g3 : 0, j = c - off; if (i > 0 || j < 0 || j >= lc) return false; L = G + j; }
        else if (L >= nunits || (mode == 1 && lc > 0 && i > 0)) return false;
        int id = xcd_chunk(L, nunits); if (rev) id = nunits - 1 - id; u.pm = (int)(id >> lgN); u.pn = (int)(id & ((1 << lgN) - 1)); u.e = u.pm >> 2; u.f = (mode == 2) ? 1 : 0; return true; } };
struct Epi1 {
    static constexpr bool PERM = true;
    bf16_t* Y; bf16_t* S;
    __device__ __forceinline__ void operator()(const f32x4 (&acc)[2][2][4][2], const gx::Unit& u, int wr, int wc, int fr, int fq) const {
        const int row0 = u.pm * 256 + wr * 64 + fr, cl = wc * 32 + 8 * fq;
#pragma unroll
        for (int ai = 0; ai < 2; ++ai)
#pragma unroll
            for (int m = 0; m < 4; ++m)
#pragma unroll
                for (int bj = 0; bj < 2; ++bj) { const size_t off = (size_t)(row0 + ai * 128 + m * 16) * 256 + bj * 128 + cl;
                    *(u32x4*)((u.pn == 0 ? Y : S) + off) = pack8(acc[ai][bj][m][0], acc[ai][bj][m][1]); }
    }
};
__device__ __forceinline__ void scan(const Ctx& c, int par, LAS unsigned char* lds) {
    int tid = threadIdx.x; asm volatile("" : "+v"(tid)); const int nl = tid & 31, seg = tid >> 5;
    LAS float* seg_r = (LAS float*)lds; LAS float* seg_i = seg_r + 512;
    __syncthreads();
    for (int item = blockIdx.x; item < 576; item += c.grid) {
        const int nh = item & 1, d = (item >> 1) & 1, b = (item >> 2) & 1, g = item >> 3, n = nh * 32 + nl;
        const float ar = c.s5_a16[par * wsz::A16 + ((g * 2 + d) * 64 + n) * 2], ai = c.s5_a16[par * wsz::A16 + ((g * 2 + d) * 64 + n) * 2 + 1];
        const size_t base = ((size_t)g * 1024 + b * 512) * 256 + d * 128 + n;
        float lr[32], li[32];
#pragma unroll
        for (int j = 0; j < 32; ++j) { const int p = 32 * seg + j; const size_t o = base + (size_t)(d ? 511 - p : p) * 256; lr[j] = bf2f(c.s5_Sloc[o]); li[j] = bf2f(c.s5_Sloc[o + 64]); }
        float sr = 0.f, si = 0.f;
#pragma unroll
        for (int j = 0; j < 32; ++j) { const float nr = ar * sr - ai * si + lr[j], ni = ar * si + ai * sr + li[j]; sr = nr; si = ni; }
        seg_r[seg * 32 + nl] = sr; seg_i[seg * 32 + nl] = si;
        float pr = ar, pi = ai;
#pragma unroll
        for (int q = 0; q < 5; ++q) { const float nr = pr * pr - pi * pi, ni = 2.0f * pr * pi; pr = nr; pi = ni; }
        __syncthreads();
        float cr = 0.f, ci = 0.f;
        for (int s2 = 0; s2 < seg; ++s2) { const float er = seg_r[s2 * 32 + nl], ei = seg_i[s2 * 32 + nl]; const float nr = pr * cr - pi * ci + er, ni = pr * ci + pi * cr + ei; cr = nr; ci = ni; }
        sr = cr; si = ci;
#pragma unroll
        for (int j = 0; j < 32; ++j) { const int p = 32 * seg + j; const size_t o = base + (size_t)(d ? 511 - p : p) * 256;
            c.s5_Sin[o] = (bf16_t)f2bf(sr); c.s5_Sin[o + 64] = (bf16_t)f2bf(si);
            const float nr = ar * sr - ai * si + lr[j], ni = ar * si + ai * sr + li[j]; sr = nr; si = ni; }
        __syncthreads();
    }
}
struct Epi2 {
    static constexpr bool PERM = true;
    const bf16_t* Y; const bf16_t* U; const float* dsk; bf16_t* O; int* done;
    __device__ __forceinline__ void operator()(const f32x4 (&acc)[2][2][4][2], const gx::Unit& u, int wr, int wc, int fr, int fq) const {
        const int row0 = u.pm * 256 + wr * 64 + fr, cl = wc * 32 + 8 * fq, g = u.e, c0 = cl & 15;
        const f32x4 d0 = *(const f32x4*)(dsk + g * 16 + c0), d1 = *(const f32x4*)(dsk + g * 16 + c0 + 4);
#pragma unroll
        for (int ai = 0; ai < 2; ++ai) {
            u32x4 yw[4][2], uw[4][2];
#pragma unroll
            for (int m = 0; m < 4; ++m)
#pragma unroll
                for (int bj = 0; bj < 2; ++bj) { const size_t off = (size_t)(row0 + ai * 128 + m * 16) * 256 + bj * 128 + cl; yw[m][bj] = *(const u32x4*)(Y + off); uw[m][bj] = *(const u32x4*)(U + off); }
#pragma unroll
            for (int m = 0; m < 4; ++m)
#pragma unroll
                for (int bj = 0; bj < 2; ++bj) { const int R = row0 + ai * 128 + m * 16, col = bj * 128 + cl; const int tok = (R & 1023) * 16 + (col >> 4);
                    const u32x4 y4 = yw[m][bj], u4 = uw[m][bj];
                    f32x4 v0 = acc[ai][bj][m][0] + (f32x4){bflo(y4.x), bfhi(y4.x), bflo(y4.y), bfhi(y4.y)} + d0 * (f32x4){bflo(u4.x), bfhi(u4.x), bflo(u4.y), bfhi(u4.y)};
                    f32x4 v1 = acc[ai][bj][m][1] + (f32x4){bflo(y4.z), bfhi(y4.z), bflo(y4.w), bfhi(y4.w)} + d1 * (f32x4){bflo(u4.z), bfhi(u4.z), bflo(u4.w), bfhi(u4.w)};
#pragma unroll
                    for (int j = 0; j < 4; ++j) { const float a = v0[j], bq = v1[j];
                        v0[j] = a * fast_sigmoid(1.5957691216f * (a + 0.044715f * a * a * a)); v1[j] = bq * fast_sigmoid(1.5957691216f * (bq + 0.044715f * bq * bq * bq)); }
                    const u32x4 w = pack8(v0, v1); bf16_t* dst = O + (size_t)tok * 1152 + g * 16 + c0;
                    if (u.f) {
                        __hip_atomic_store((unsigned long long*)dst, (unsigned long long)w.x | ((unsigned long long)w.y << 32), __ATOMIC_RELAXED, __HIP_MEMORY_SCOPE_AGENT);
                        __hip_atomic_store((unsigned long long*)dst + 1, (unsigned long long)w.z | ((unsigned long long)w.w << 32), __ATOMIC_RELAXED, __HIP_MEMORY_SCOPE_AGENT);
                    } else *(u32x4*)dst = w; }
        }
        if (u.f) { asm volatile("s_waitcnt vmcnt(0)" ::: "memory"); if ((fr | fq) == 0) (void)__hip_atomic_fetch_add(done, 1, __ATOMIC_RELAXED, __HIP_MEMORY_SCOPE_AGENT); }
    }
};
}
namespace att {
constexpr int KP = 144, VP = 776;
constexpr int K_OFF = 0, VT_OFF = 384 * KP;
typedef float f32x16 __attribute__((ext_vector_type(16)));
__device__ __forceinline__ f32x16 zero16() { float z = 0.f; asm volatile("" : "+v"(z)); return (f32x16){z, z, z, z, z, z, z, z, z, z, z, z, z, z, z, z}; }
__device__ __forceinline__ void phase(const Ctx& c, LAS unsigned char* lds) {
    int tid = threadIdx.x;
    for (int item = ((int)blockIdx.x + c.grid / 2) % c.grid; item < 1152; item += c.grid) {
        asm volatile("" : "+v"(tid));
        const int wave = __builtin_amdgcn_readfirstlane(tid >> 6), lane = tid & 63, lr = lane & 31, hh = lane >> 5;
        const int itm = 1151 - item;
        const int blk = itm & 31, rest = itm >> 5, h = rest % 6, g = (rest / 6) % 3, b = rest / 18;
        const int dil = g == 0 ? 1 : (g == 1 ? 4 : 16), ls = 8192 / dil, ipc = 32 / dil, r = blk / ipc, i0 = (blk % ipc) * 256;
        const float slope = __builtin_amdgcn_exp2f((float)(h * 3 + g + 1) * (-8.0f / 18.0f)) * (float)dil;
        const bf16_t* qkv = c.QKVU + (size_t)b * 8192 * 4608 + g * 384 + h * 64;
        for (int u = tid; u < 384 * 8; u += NTHREADS) { const int kl = u >> 3, part = u & 7, ik = i0 - 64 + kl;
            u32x4 v = uzero4();
            if (ik >= 0 && ik < ls) v = *(const u32x4*)(qkv + (size_t)(ik * dil + r) * 4608 + 1152 + part * 8);
            *(LAS u32x4*)(lds + K_OFF + kl * KP + part * 16) = v; }
        for (int u = tid; u < 192 * 8; u += NTHREADS) { const int part = u / 192, kp = u % 192, ik = i0 - 64 + 2 * kp;
            u32x4 v0 = uzero4(), v1 = v0;
            if (ik >= 0 && ik < ls) v0 = *(const u32x4*)(qkv + (size_t)(ik * dil + r) * 4608 + 2304 + part * 8);
            if (ik + 1 >= 0 && ik + 1 < ls) v1 = *(const u32x4*)(qkv + (size_t)((ik + 1) * dil + r) * 4608 + 2304 + part * 8);
            LAS unsigned char* dst = lds + VT_OFF + (part * 8) * VP + kp * 4;
            *(LAS unsigned*)(dst + 0 * VP) = (v0.x & 0xffffu) | (v1.x << 16); *(LAS unsigned*)(dst + 1 * VP) = (v0.x >> 16) | (v1.x & 0xffff0000u);
            *(LAS unsigned*)(dst + 2 * VP) = (v0.y & 0xffffu) | (v1.y << 16); *(LAS unsigned*)(dst + 3 * VP) = (v0.y >> 16) | (v1.y & 0xffff0000u);
            *(LAS unsigned*)(dst + 4 * VP) = (v0.z & 0xffffu) | (v1.z << 16); *(LAS unsigned*)(dst + 5 * VP) = (v0.z >> 16) | (v1.z & 0xffff0000u);
            *(LAS unsigned*)(dst + 6 * VP) = (v0.w & 0xffffu) | (v1.w << 16); *(LAS unsigned*)(dst + 7 * VP) = (v0.w >> 16) | (v1.w & 0xffff0000u); }
        const int q0 = 32 * wave, iq = i0 + q0 + lr;
        const size_t tq = (size_t)(iq * dil + r);
        bf16x8 qf[4];
#pragma unroll
        for (int ks = 0; ks < 4; ++ks) qf[ks] = *(const bf16x8*)(qkv + tq * 4608 + 16 * ks + 8 * hh);
        __syncthreads();
        f32x16 st[5];
#pragma unroll
        for (int kt = 0; kt < 5; ++kt) { st[kt] = zero16();
#pragma unroll
            for (int ks = 0; ks < 4; ++ks) { const bf16x8 kf = *(const LAS bf16x8*)(lds + K_OFF + (q0 + 32 * kt + lr) * KP + (16 * ks + 8 * hh) * 2);
                st[kt] = __builtin_amdgcn_mfma_f32_32x32x16_bf16(kf, qf[ks], st[kt], 0, 0, 0); } }
        float mx = -1e30f;
        int dlt = 4 * hh - lr; asm volatile("" : "+v"(dlt));
        const int ikb = i0 - 64 + q0 + 4 * hh;
#pragma unroll
        for (int kt = 0; kt < 5; ++kt)
#pragma unroll
            for (int reg = 0; reg < 16; ++reg) { const int kc = 32 * kt + (reg & 3) + 8 * (reg >> 2);
                const int d = kc - 64 + dlt, dist = d < 0 ? -d : d, ik = ikb + kc;
                const bool ok = dist <= 64 && ik >= 0 && ik < ls;
                const float s = ok ? st[kt][reg] * 0.125f - slope * (float)dist : -1e30f;
                st[kt][reg] = s; mx = fmaxf(mx, s); }
        mx = fmaxf(mx, __int_as_float(__builtin_amdgcn_ds_bpermute((lane ^ 32) << 2, __float_as_int(mx))));
        float sum = 0.f;
#pragma unroll
        for (int kt = 0; kt < 5; ++kt)
#pragma unroll
            for (int reg = 0; reg < 16; ++reg) { const float p = st[kt][reg] > -1e29f ? __expf(st[kt][reg] - mx) : 0.f; st[kt][reg] = p; sum += p; }
        sum += __int_as_float(__builtin_amdgcn_ds_bpermute((lane ^ 32) << 2, __float_as_int(sum)));
        f32x16 o[2];
#pragma unroll
        for (int dt = 0; dt < 2; ++dt) o[dt] = zero16();
#pragma unroll
        for (int kt = 0; kt < 5; ++kt)
#pragma unroll
            for (int s2 = 0; s2 < 2; ++s2) {
                u32x4 pw; pw.x = cvt_pk_bf16(st[kt][8 * s2 + 0], st[kt][8 * s2 + 1]); pw.y = cvt_pk_bf16(st[kt][8 * s2 + 2], st[kt][8 * s2 + 3]);
                pw.z = cvt_pk_bf16(st[kt][8 * s2 + 4], st[kt][8 * s2 + 5]); pw.w = cvt_pk_bf16(st[kt][8 * s2 + 6], st[kt][8 * s2 + 7]);
                const bf16x8 pf = __builtin_bit_cast(bf16x8, pw);
#pragma unroll
                for (int dt = 0; dt < 2; ++dt) { const LAS unsigned char* vp = lds + VT_OFF + (32 * dt + lr) * VP + (q0 + 32 * kt + 16 * s2 + 4 * hh) * 2;
                    const u32x2 a0 = *(const LAS u32x2*)vp, a1 = *(const LAS u32x2*)(vp + 16);
                    const u32x4 av = (u32x4){a0.x, a0.y, a1.x, a1.y};
                    o[dt] = __builtin_amdgcn_mfma_f32_32x32x16_bf16(__builtin_bit_cast(bf16x8, av), pf, o[dt], 0, 0, 0); }
            }
        const float inv = __builtin_amdgcn_rcpf(sum); const size_t tglob = (size_t)b * 8192 + tq;
        bf16_t* op = c.attob + ((size_t)g * 16384 + tglob) * 384 + h * 64;
#pragma unroll
        for (int dt = 0; dt < 2; ++dt)
#pragma unroll
            for (int rg = 0; rg < 4; ++rg) { u32x2 w; w.x = cvt_pk_bf16(o[dt][4 * rg + 0] * inv, o[dt][4 * rg + 1] * inv); w.y = cvt_pk_bf16(o[dt][4 * rg + 2] * inv, o[dt][4 * rg + 3] * inv);
                *(u32x2*)(op + 32 * dt + 8 * rg + 4 * hh) = w; }
        if (hh == 0) c.attlse[((size_t)g * 16384 + tglob) * 6 + h] = mx + __logf(sum);
        __syncthreads();
    }
}
__device__ __forceinline__ void combine(const Ctx& c, long i) {
    const int c8 = (int)(i % 48); const long t = i / 48; const int h = c8 >> 3;
    const float l0 = c.attlse[((size_t)0 * 16384 + t) * 6 + h], l1 = c.attlse[((size_t)1 * 16384 + t) * 6 + h], l2 = c.attlse[((size_t)2 * 16384 + t) * 6 + h];
    const float m = fmaxf(l0, fmaxf(l1, l2)); float w0 = __expf(l0 - m), w1 = __expf(l1 - m), w2 = __expf(l2 - m); const float inv = __builtin_amdgcn_rcpf(w0 + w1 + w2); w0 *= inv; w1 *= inv; w2 *= inv;
    const u32x4 a = *(const u32x4*)(c.attob + ((size_t)0 * 16384 + t) * 384 + c8 * 8), bq = *(const u32x4*)(c.attob + ((size_t)1 * 16384 + t) * 384 + c8 * 8), cq = *(const u32x4*)(c.attob + ((size_t)2 * 16384 + t) * 384 + c8 * 8);
    f32x4 v0, v1;
    v0[0] = w0 * bflo(a.x) + w1 * bflo(bq.x) + w2 * bflo(cq.x); v0[1] = w0 * bfhi(a.x) + w1 * bfhi(bq.x) + w2 * bfhi(cq.x);
    v0[2] = w0 * bflo(a.y) + w1 * bflo(bq.y) + w2 * bflo(cq.y); v0[3] = w0 * bfhi(a.y) + w1 * bfhi(bq.y) + w2 * bfhi(cq.y);
    v1[0] = w0 * bflo(a.z) + w1 * bflo(bq.z) + w2 * bflo(cq.z); v1[1] = w0 * bfhi(a.z) + w1 * bfhi(bq.z) + w2 * bfhi(cq.z);
    v1[2] = w0 * bflo(a.w) + w1 * bflo(bq.w) + w2 * bflo(cq.w); v1[3] = w0 * bfhi(a.w) + w1 * bfhi(bq.w) + w2 * bfhi(cq.w);
    *(u32x4*)(c.yattb + t * 384 + c8 * 8) = pack8(v0, v1);
}
}
namespace lnr {
constexpr int XP = 1028;
constexpr int PART_OFF = 16 * XP * 4, CNT_OFF = PART_OFF + 8 * 16 * 32 * 4, GB_OFF = CNT_OFF + 128;
__device__ __forceinline__ void phase(const Ctx& c, int l, LAS unsigned char* lds) {
    int tid = threadIdx.x; asm volatile("" : "+v"(tid)); const int wave = __builtin_amdgcn_readfirstlane(tid >> 6), lane = tid & 63;
    const bf16_t* xin = c.xbf;
    LAS float* xf = (LAS float*)lds; LAS float* part = (LAS float*)(lds + PART_OFF); LAS int* cnt_l = (LAS int*)(lds + CNT_OFF);
    float wreg[2][32];
    { const float* rw = c.in[I_RW] + (size_t)l * 1024 * 32 + (size_t)(128 * wave + 4 * (lane >> 4)) * 32 + (lane & 15);
#pragma unroll
      for (int s4 = 0; s4 < 8; ++s4)
#pragma unroll
        for (int i = 0; i < 4; ++i) { wreg[0][4 * s4 + i] = rw[(16 * s4 + i) * 32]; wreg[1][4 * s4 + i] = rw[(16 * s4 + i) * 32 + 16]; } }
    LAS float* gb = (LAS float*)(lds + GB_OFF);
    __syncthreads();
    for (int i = tid; i < 1024; i += NTHREADS) { gb[i] = c.in[I_LN1G][l * 1024 + i]; gb[1024 + i] = c.in[I_LN1B][l * 1024 + i]; }
    const float rbias = c.in[I_RB][l * 32 + (lane & 31)];
    __syncthreads();
    float xn[16], mn[16];
#define LNR_LOAD(tok) do { const size_t b0_ = (size_t)(tok) * 1024 + 4 * lane; _Pragma("unroll") for (int jq = 0; jq < 4; ++jq) { const u32x2 xv = *(const u32x2*)(xin + b0_ + 256 * jq), mv = *(const u32x2*)(c.mixb + b0_ + 256 * jq); \
        xn[4 * jq] = bflo(xv.x); xn[4 * jq + 1] = bfhi(xv.x); xn[4 * jq + 2] = bflo(xv.y); xn[4 * jq + 3] = bfhi(xv.y); mn[4 * jq] = bflo(mv.x); mn[4 * jq + 1] = bfhi(mv.x); mn[4 * jq + 2] = bflo(mv.y); mn[4 * jq + 3] = bfhi(mv.y); } } while (0)
    if ((int)blockIdx.x < ox_T / 64) LNR_LOAD(blockIdx.x * 64 + wave * 2);
#pragma unroll 1
    for (int gi = blockIdx.x; gi < ox_T / 64; gi += c.grid) {
      if (tid < 32) cnt_l[tid] = 0;
#pragma unroll 1
      for (int q = 0; q < 4; ++q) {
        int tid2 = tid; asm volatile("" : "+v"(tid2)); const int lane = tid2 & 63;
#pragma unroll 1
        for (int tt = 0; tt < 2; ++tt) {
          const int t = gi * 64 + 16 * q + 2 * wave + tt;
          float x[16];
          const size_t base = (size_t)t * 1024 + 4 * lane; float s = 0.f;
#pragma unroll
          for (int j = 0; j < 16; ++j) { x[j] = md::ALPHA * xn[j] + mn[j]; s += x[j]; }
          { const int tn = tt == 0 ? t + 1 : (q < 3 ? t + 15 : (gi + c.grid < ox_T / 64 ? (gi + c.grid) * 64 + 2 * wave : t)); LNR_LOAD(tn); }
          const float mean = wave_sum(s) * (1.0f / 1024.0f); float qq = 0.f;
#pragma unroll
          for (int j = 0; j < 16; ++j) { x[j] -= mean; qq += x[j] * x[j]; }
          float eps_ = md::EPS; asm volatile("" : "+v"(eps_));
          const float rstd = __builtin_amdgcn_rsqf(wave_sum(qq) * (1.0f / 1024.0f) + eps_);
          LAS float* xrow = xf + (2 * wave + tt) * XP + 4 * lane;
#pragma unroll
          for (int jq = 0; jq < 4; ++jq) { const f32x4 g4 = *(const LAS f32x4*)(gb + 4 * lane + 256 * jq), b4 = *(const LAS f32x4*)(gb + 1024 + 4 * lane + 256 * jq);
              f32x4 y; y[0] = x[4 * jq] * rstd * g4[0] + b4[0]; y[1] = x[4 * jq + 1] * rstd * g4[1] + b4[1]; y[2] = x[4 * jq + 2] * rstd * g4[2] + b4[2]; y[3] = x[4 * jq + 3] * rstd * g4[3] + b4[3];
              u32x2 w; w.x = cvt_pk_bf16(y[0], y[1]); w.y = cvt_pk_bf16(y[2], y[3]);
              *(u32x2*)(c.x1b + base + 256 * jq) = w; *(unsigned*)(c.x1q + base + 256 * jq) = pk4_fp8(y[0], y[1], y[2], y[3]);
              *(LAS f32x4*)(xrow + 256 * jq) = y; }
        }
        __syncthreads();
        {
            f32x4 acc0 = zero4(), acc1 = zero4();
            const LAS float* ap = xf + (lane & 15) * XP + 128 * wave + 4 * (lane >> 4);
#pragma unroll
            for (int s4 = 0; s4 < 8; ++s4) { const f32x4 av = *(const LAS f32x4*)(ap + 16 * s4);
#pragma unroll
                for (int i = 0; i < 4; ++i) { acc0 = __builtin_amdgcn_mfma_f32_16x16x4f32(av[i], wreg[0][4 * s4 + i], acc0, 0, 0, 0); acc1 = __builtin_amdgcn_mfma_f32_16x16x4f32(av[i], wreg[1][4 * s4 + i], acc1, 0, 0, 0); } }
            LAS float* pp = part + (wave * 16 + 4 * (lane >> 4)) * 32 + (lane & 15);
#pragma unroll
            for (int r = 0; r < 4; ++r) { pp[r * 32] = acc0[r]; pp[r * 32 + 16] = acc1[r]; }
        }
        __syncthreads();
        {
            const int tl = 2 * wave + (lane >> 5), t = gi * 64 + 16 * q + tl;
            float v1 = rbias;
#pragma unroll
            for (int w2 = 0; w2 < 8; ++w2) v1 += part[(w2 * 16 + tl) * 32 + (lane & 31)];
            float tv[4]; int ti[4]; float neg_ = -3.0e38f; asm volatile("" : "+v"(neg_));
#pragma unroll
            for (int k = 0; k < 4; ++k) {
                float m = v1;
                m = fmaxf(m, SWZ_XOR(m, 1)); m = fmaxf(m, SWZ_XOR(m, 2)); m = fmaxf(m, SWZ_XOR(m, 4)); m = fmaxf(m, SWZ_XOR(m, 8)); m = fmaxf(m, SWZ_XOR(m, 16));
                const unsigned long long mask = __ballot(v1 == m);
                const unsigned mh = (unsigned)(mask >> (lane & 32));
                const int first = __builtin_ctz(mh);
                tv[k] = m; ti[k] = first;
                if ((lane & 31) == first) v1 = neg_;
            }
            const float e1 = __expf(tv[1] - tv[0]), e2 = __expf(tv[2] - tv[0]), e3 = __expf(tv[3] - tv[0]); const float inv = __builtin_amdgcn_rcpf(1.0f + e1 + e2 + e3);
            const int kk = lane & 31;
            if (kk < 4) { const int te = kk == 0 ? ti[0] : (kk == 1 ? ti[1] : (kk == 2 ? ti[2] : ti[3]));
                c.gate[t * 4 + kk] = (kk == 0 ? 1.0f : (kk == 1 ? e1 : (kk == 2 ? e2 : e3))) * inv; c.topidx[t * 4 + kk] = te; atomicAdd((int*)(cnt_l + te), 1); }
        }
      }
      __syncthreads();
      if (tid < 32) c.moe_cnt[gi * 32 + tid] = cnt_l[tid];
      __syncthreads();
    }
}
#undef LNR_LOAD
}
#endif
typedef const __attribute__((address_space(4))) Ctx* CtxK;
#if defined(__HIP_DEVICE_COMPILE__)
__device__ __forceinline__ const Ctx* ctx_ptr() { CtxK p = (CtxK)__builtin_amdgcn_kernarg_segment_ptr(); asm volatile("" : "+s"(p)); return (const Ctx*)p; }
#endif
#define PH(...) do { const Ctx& c = *ctx_ptr(); __VA_ARGS__ } while (0)

#define RUN(bit, ...) do { PH(__VA_ARGS__); if (REPMASK & (1u << (bit))) PH(__VA_ARGS__); } while (0)
#define LDSP ((LAS unsigned char*)lds)
#ifndef NCV
#define NCV 0
#endif

__global__ void __launch_bounds__(NTHREADS, 2) mk_forward(Ctx cparam) {
#if defined(__HIP_DEVICE_COMPILE__)
    extern __shared__ __attribute__((aligned(16))) unsigned char lds[];
    volatile LAS unsigned* bst = (volatile LAS unsigned*)((LAS unsigned char*)lds + LDS_BYTES - 16);
    if (threadIdx.x == 0) { bst[0] = 0u; bst[1] = 0u; bst[2] = 0u; bst[3] = 0u; }
    __syncthreads();
    XcdBarrier bar = xcd_barrier_post(ctx_ptr()->bar, bst);
    const long T = ox_T; const int depth = ctx_ptr()->depth;
    for (int l = -1; l < depth; ++l) {
        const int par = l & 1;
        if (l >= 0) RUN(0, prologue_weights<false, true>(c, l, par, LDSP, 0, c.grid); );
        else PH( LOOP(T * 128, cvt_x8(c.in[I_X], c.xbf, i)); const u32x4 z4 = uzero4(); LOOP(128, *(u32x4*)(c.x1b + (size_t)ox_T * 1024 + i * 8) = z4); LOOP(1, c.moe_done[320] = 0); LOOP(64, *(u32x4*)(c.x1q + (size_t)ox_T * 1024 + i * 16) = z4); );
        if (l + 1 < depth) { RUN(0, prologue_weights<true, false>(c, l + 1, par ^ 1, LDSP, 0, c.grid); ); RUN(0, s5::prologue(c, l + 1, par ^ 1, LDSP, c.grid >= 72 ? c.grid - 72 : 0, c.grid >= 72 ? 72 : c.grid); ); }
        if (l >= 0) {
            PH( __syncthreads(); );
            RUN(1, gx::Gemm g{c.xbf, c.Win_t + par * wsz::WIN, 1024, 0}; gx::StaticOrder S; S.init(ox_T, 14080, c.grid, (int)blockIdx.x);
                   EpiInproj<false, true> E{c.Gb, c.Zb, c.XBCb, c.QKVU, c.dtf, c.in[I_BGATE] + (size_t)l * 3072, c.Ug};
                   gx::gemm_phase(LDSP, g, S, E); );
        }
        SYNC();
        if (l < 0) continue;
        RUN(3, att::phase(c, LDSP); );
        RUN(4, gx::Gemm g{c.Ug, c.s5_W1 + par * wsz::S5W1, 256, (size_t)512 * 256 * 2}; s5::Order S{576, c.grid, (int)blockIdx.x, 1, 1}; s5::Epi1 E{c.s5_Yl, c.s5_Sloc}; gx::gemm_phase(LDSP, g, S, E); );
        RUN(2, ssd::phase_s1(c, l, LDSP); );
        SYNC();
        RUN(5, s5::scan(c, par, LDSP); );
        RUN(5, LOOP(T * 48, att::combine(c, i)); );
        PH( ssd::phase_s2(c); );
        SYNC();
        RUN(6, ssd::phase_s3<true>(c, l, LDSP); );
#pragma clang loop unroll(disable)
        for (int ps = 1; ps <= 2; ++ps) {
            if (ps == 2) SYNC();
            PH( gx::Gemm g{c.s5_Sin, c.s5_Q + par * wsz::S5Q, 256, (size_t)256 * 256 * 2}; s5::Order S{288, c.grid, (int)blockIdx.x, 0, 0, ps}; s5::Epi2 E{c.s5_Yl, c.Ug, c.in[I_S5D] + (size_t)l * 1152, c.s5hb, c.moe_done + 320}; gx::gemm_phase(LDSP, g, S, E); );
        }
        RUN(9, gx::Gemm g{c.yssdb, c.Wbs_t + par * wsz::WBS, 2048, 0}; gx::StaticOrder S; S.init(ox_T, 1024, c.grid, (int)blockIdx.x); EpiBranch<0> E{c.Gb, c.mergedb, c.ssd_ssq}; gx::gemm_phase(LDSP, g, S, E); );
        PH( gx::Gemm g{c.yattb, c.Wba_t + par * wsz::WBA, 384, 0}; gx::StaticOrder S; S.init(ox_T, 1024, c.grid, (int)blockIdx.x); EpiBranch<1> E{c.Gb, c.mergedb, nullptr}; gx::gemm_phase(LDSP, g, S, E); );
        PH( const s5::Order S2{288, c.grid, (int)blockIdx.x, 0, 0, 2}; moe_wait_rows(c.moe_done, 320, (l + 1) * S2.late_cnt() * 8); );
        RUN(8, gx::Gemm g{c.s5hb, c.Wglu_t + par * wsz::WGLU, 1152, 0}; gx::StaticOrder S; S.init(ox_T, 2304, c.grid, (int)blockIdx.x); EpiGlu E{c.ys5b}; gx::gemm_phase(LDSP, g, S, E); );
        SYNC();
        RUN(10, gx::Gemm g{c.ys5b, c.Wb5_t + par * wsz::WB5, 1152, 0}; gx::StaticOrder S; S.init(ox_T, 1024, c.grid, (int)blockIdx.x); EpiBranch<2> E{c.Gb, c.mergedb, nullptr}; gx::gemm_phase(LDSP, g, S, E); );
        SYNC();
        RUN(11, gx::Gemm g{c.mergedb, c.Wout_t + par * wsz::WOUT, 1024, 0}; gx::StaticOrder S; S.init(ox_T, 1024, c.grid, (int)blockIdx.x); EpiBf16 E{c.mixb}; gx::gemm_phase(LDSP, g, S, E); );
        SYNC();
        RUN(12, lnr::phase(c, l, LDSP); );
        SYNC();
        RUN(13, moe_assign(c, LDSP); );
        SYNC();
        RUN(14, const int nb = moe_blocks(c, LDSP); int M, fi; moe_early(nb, c.grid, M, fi); gx::Gemm g{(const bf16_t*)c.x1q, c.Wgu_t, 512, (size_t)2048 * 1024};
                MoeOrder S{(const LAS int*)(LDSP + LDS_TAB), nb * 8, c.grid, (int)blockIdx.x, 3, 0, nb, M, fi};
                EpiSwiglu E{(unsigned char*)c.actb, c.in[I_BGU] + (size_t)l * 32 * 2048, c.moe_done}; gx::gemm_phase<EpiSwiglu, MoeOrder, true, true>(LDSP, g, S, E, c.slot_tok); );
#pragma clang loop unroll(disable)
        for (int ps = 1; ps <= 2; ++ps) {
            if (ps == 2) SYNC();
            RUN(15, const int nb = moe_blocks(c, LDSP); int M, fi; moe_early(nb, c.grid, M, fi); gx::Gemm g{c.actb, c.Wdn_t, 512, (size_t)1024 * 1024};
                    MoeOrder S{(const LAS int*)(LDSP + LDS_TAB), (nb - 8 * M) * 4, c.grid, (int)blockIdx.x, 2, ps, nb, M, fi};
                    gx::Unit u0; if (ps == 1 && S.next(0, u0)) moe_wait_rows(c.moe_done, u0.pm);
                    EpiDown E{c.ys2, c.in[I_BDN] + (size_t)l * 32 * 1024, c.slot_gate}; gx::gemm_phase<EpiDown, MoeOrder, false, true>(LDSP, g, S, E); );
        }
        SYNC();
        RUN(16, moe_combine_ln(c, c.in[I_LN2G] + l * 1024, c.in[I_LN2B] + l * 1024, (l == depth - 1) ? c.out : nullptr); );
        SYNC();
    }
#endif
}

extern "C" void kernel_launch(void* const* d_in, const int* in_sizes, int n_in, void* d_out, int out_size, void* d_ws, size_t ws_size, hipStream_t stream) {
    static int grid = 0;
    Ctx c;
    const size_t need = build_ctx(c, d_in, d_out, d_ws, 4);
    if (grid == 0) {
        if (n_in != N_INPUTS || out_size != 2 * 8192 * 1024 || ws_size < need) { fprintf(stderr, "kernel_launch: unexpected shapes (n_in %d out %d ws %zu need %zu)\n", n_in, out_size, ws_size, need); grid = -1; return; }
        int dev = 0, cus = 0, per_cu = 0;
        (void)hipGetDevice(&dev); (void)hipDeviceGetAttribute(&cus, hipDeviceAttributeMultiprocessorCount, dev);
        if (hipFuncSetAttribute((const void*)mk_forward, hipFuncAttributeMaxDynamicSharedMemorySize, LDS_BYTES) != hipSuccess) { fprintf(stderr, "kernel_launch: hipFuncSetAttribute failed\n"); grid = -1; return; }
        if (hipOccupancyMaxActiveBlocksPerMultiprocessor(&per_cu, (const void*)mk_forward, NTHREADS, LDS_BYTES) != hipSuccess || per_cu < 1) { fprintf(stderr, "kernel_launch: occupancy query says %d\n", per_cu); grid = -1; return; }
        (void)hipGetLastError();
        grid = cus;
    }
    if (grid < 0) return;
    c.grid = grid;
    (void)hipMemsetAsync(c.bar, 0, 16384, stream);
    hipLaunchKernelGGL(mk_forward, dim3(grid), dim3(NTHREADS), LDS_BYTES, stream, c);
}
```

```cpp
#include <hip/hip_runtime.h>
#include <cstdio>
#include <cstdint>
#include <cstring>
#include <cmath>

#ifndef REPMASK
#define REPMASK 0u
#endif

namespace md {
constexpr int D = 1024, NIN = 13888;
constexpr int C_GATE = 0, C_Z = 3072, C_XBC = 5120, C_DT = 9216, C_QKV = 9280, C_U = 12736;
constexpr int SSD_IN = 2048, SSD_CC = 4096, NH = 32, HP = 64, NG = 8, NS = 128;
constexpr int ATT_W = 1152, ATT_O = 384;
constexpr int S5W = 1152, S5G = 72, S5C = 16, S5N = 64;
constexpr int NE = 32, TOPK = 4, FF = 1024;
constexpr float ALPHA = 1.681792830507429f;
constexpr float EPS = 1e-5f;
}

enum { I_X = 0, I_WIN, I_BGATE, I_CONVW, I_CONVB, I_ALOG, I_DTB, I_SSDD, I_NORMW, I_S5ARE, I_S5AIM, I_S5LS, I_S5BRE, I_S5BIM,
       I_S5CRE, I_S5CIM, I_S5D, I_GLU1, I_GLU2, I_WBSSD, I_WBATT, I_WBS5, I_WOUT, I_LN1G, I_LN1B, I_RW, I_RB, I_WGU, I_BGU,
       I_WDN, I_BDN, I_LN2G, I_LN2B, N_INPUTS };

struct Ctx {
    const float* in[N_INPUTS];
    float* out;
    float *attlse, *gate; unsigned short* mixb;
    int *topidx, *tok_slot;
    unsigned* bar;
    unsigned short *Win_t, *Wglu_t, *Wbs_t, *Wba_t, *Wb5_t, *Wout_t, *Wgu_t, *Wdn_t;
    unsigned short *xbf, *Gb, *Zb, *XBCb, *QKVU; float* dtf;
    unsigned short *yssdb, *yattb, *s5hb, *ys5b, *mergedb;
    unsigned short *x1b, *actb, *ys2; float* slot_gate; int *moe_cnt, *moe_pstart, *slot_tok, *moe_done; unsigned char* x1q;
    unsigned short* ssd_S; float *ssd_tot, *ssd_ssq;
    unsigned short* attob;
    unsigned short *Ug, *s5_W1, *s5_Q, *s5_Yl, *s5_Sin, *s5_Sloc; float* s5_a16;
    int depth, grid;
};

namespace wsz { constexpr size_t WIN = (size_t)14080 * 1024, WGLU = (size_t)2304 * 1152, WBS = (size_t)1024 * 2048, WBA = (size_t)1024 * 384, WB5 = (size_t)1024 * 1152, WOUT = (size_t)1024 * 1024,
    S5W1 = (size_t)72 * 512 * 256, S5Q = (size_t)72 * 256 * 256, A16 = 72 * 2 * 64 * 2; }
static inline size_t align_up(size_t x) { return (x + 255) & ~(size_t)255; }
static size_t build_ctx(Ctx& c, void* const* d_in, void* d_out, void* d_ws, int depth) {
    memset(&c, 0, sizeof(c));
    for (int i = 0; i < N_INPUTS; ++i) c.in[i] = (const float*)d_in[i];
    c.out = (float*)d_out; c.depth = depth;
    char* w = (char*)d_ws; size_t off = 0; const size_t T = 16384;
    auto take = [&](size_t bytes) { char* p = w + off; off = align_up(off + bytes); return p; };
    c.bar = (unsigned*)take(16384);
    c.attlse = (float*)take(3 * T * 6 * 4); c.mixb = (unsigned short*)take(T * 1024 * 2);
    c.gate = (float*)take(T * 4 * 4); c.topidx = (int*)take(T * 4 * 4); c.tok_slot = (int*)take(T * 4 * 4);
    c.Win_t = (unsigned short*)take(2 * wsz::WIN * 2); c.Wglu_t = (unsigned short*)take(2 * wsz::WGLU * 2); c.Wbs_t = (unsigned short*)take(2 * wsz::WBS * 2);
    c.Wba_t = (unsigned short*)take(2 * wsz::WBA * 2); c.Wb5_t = (unsigned short*)take(2 * wsz::WB5 * 2); c.Wout_t = (unsigned short*)take(2 * wsz::WOUT * 2);
    c.Wgu_t = (unsigned short*)take((size_t)32 * 2048 * 1024 * 2); c.Wdn_t = (unsigned short*)take((size_t)32 * 1024 * 1024 * 2);
    c.xbf = (unsigned short*)take(T * 1024 * 2); c.Gb = (unsigned short*)take(T * 3072 * 2); c.Zb = (unsigned short*)take(T * 2048 * 2); c.XBCb = (unsigned short*)take(T * 4096 * 2);
    c.QKVU = (unsigned short*)take(T * 4608 * 2); c.dtf = (float*)take(T * 64 * 4);
    c.x1b = (unsigned short*)take((size_t)(T + 1) * 1024 * 2); c.slot_tok = (int*)take(73728 * 4); c.actb = (unsigned short*)take((size_t)73728 * 1024 * 2); c.ys2 = (unsigned short*)take((size_t)73728 * 1024 * 2);
    c.slot_gate = (float*)take(73728 * 4); c.moe_cnt = (int*)take(8192 * 4); c.moe_pstart = (int*)take(256); c.moe_done = (int*)take(2048); c.x1q = (unsigned char*)take((size_t)(T + 1) * 1024);
    c.ssd_S = (unsigned short*)take((size_t)2 * 2 * 64 * 32 * 8192 * 2); c.ssd_tot = (float*)take(2 * 2 * 64 * 32 * 4); c.ssd_ssq = (float*)take(T * 8 * 4);
    c.attob = (unsigned short*)take(3 * T * 384 * 2);
    c.Ug = (unsigned short*)take(T * 1152 * 2); c.s5_W1 = (unsigned short*)take(2 * wsz::S5W1 * 2); c.s5_Q = (unsigned short*)take(2 * wsz::S5Q * 2);
    c.s5_Yl = (unsigned short*)take((size_t)73728 * 256 * 2); c.s5_Sin = (unsigned short*)take((size_t)73728 * 256 * 2); c.s5_Sloc = (unsigned short*)take((size_t)73728 * 256 * 2); c.s5_a16 = (float*)take(2 * wsz::A16 * 4);
    c.yssdb = (unsigned short*)take(T * 2048 * 2); c.yattb = (unsigned short*)take(T * 384 * 2); c.s5hb = (unsigned short*)take(T * 1152 * 2); c.ys5b = (unsigned short*)take(T * 1152 * 2); c.mergedb = (unsigned short*)take(T * 1024 * 2);
    return off;
}

#define XB_TMO      128
#define XB_XCNT(j)  (256  + 64 * (j))
#define XB_XSUB(j)  (1280 + 64 * (j))
#define XB_XGEN(j)  (2304 + 64 * (j))
#define XB_TOP      3328
#define XB_TOPGEN   3392
#define XCD_BAR_WORDS 3456
#define XB_SPIN_CAP (1u << 18)
#define LAS __attribute__((address_space(3)))

__device__ __forceinline__ unsigned xb_ld(unsigned* p)              { return __hip_atomic_load(p, __ATOMIC_RELAXED, __HIP_MEMORY_SCOPE_AGENT); }
__device__ __forceinline__ unsigned xb_add(unsigned* p, unsigned v) { return __hip_atomic_fetch_add(p, v, __ATOMIC_RELAXED, __HIP_MEMORY_SCOPE_AGENT); }
__device__ __forceinline__ unsigned xb_xcc_id() { return (unsigned)__builtin_amdgcn_s_getreg((3 << 11) | 20) & 0xFu; }
#define XB_SPIN(cond, bar) do { unsigned _sp = 0; while (cond) { __builtin_amdgcn_s_sleep(1); \
    if ((++_sp & 255u) == 0u) { if (xb_ld(&(bar)[XB_TMO])) break; if (_sp > XB_SPIN_CAP) { atomicAdd(&(bar)[XB_TMO], 1u); break; } } } } while (0)

struct XcdBarrier { unsigned* bar; unsigned x; volatile LAS unsigned* st; };

__device__ __forceinline__ XcdBarrier xcd_barrier_post(unsigned* bar, volatile LAS unsigned* st) {
    XcdBarrier b; b.bar = bar; b.x = xb_xcc_id(); b.st = st;
    if (threadIdx.x == 0) (void)xb_add(&bar[XB_XCNT(b.x)], 1u);
    return b;
}
__device__ __forceinline__ void xcd_barrier_complete(unsigned* bar, unsigned x, unsigned& nloc, unsigned& nx) {
    const unsigned G = gridDim.x * gridDim.y * gridDim.z;
    unsigned sum, cnt, mine, sp = 0u;
    for (;;) {
        sum = 0u; cnt = 0u; mine = 0u;
#pragma unroll
        for (unsigned j = 0; j < 16; ++j) { const unsigned c = xb_ld(&bar[XB_XCNT(j)]); sum += c; cnt += (c > 0u) ? 1u : 0u; mine = (j == x) ? c : mine; }
        if (sum == G) break;
        __builtin_amdgcn_s_sleep(1);
        if ((++sp & 255u) == 0u) { if (xb_ld(&bar[XB_TMO])) break; if (sp > XB_SPIN_CAP) { atomicAdd(&bar[XB_TMO], 1u); break; } }
    }
    nloc = mine > 0u ? mine : 1u; nx = cnt > 0u ? cnt : 1u;
}
__device__ __forceinline__ void xcd_barrier(const XcdBarrier& b) {
    asm volatile("s_waitcnt vmcnt(0)" ::: "memory");
    __syncthreads();
    if (threadIdx.x == 0) {
        unsigned* bar = b.bar;
        __builtin_amdgcn_s_waitcnt(0);
        unsigned nloc = b.st[0], nx = b.st[1];
        if (nloc == 0u) { xcd_barrier_complete(bar, b.x, nloc, nx); b.st[0] = nloc; b.st[1] = nx; }
        const unsigned old = xb_add(&bar[XB_XSUB(b.x)], 1u);
        const unsigned gen = old / nloc;
        if (old + 1u == (gen + 1u) * nloc) {
            __builtin_amdgcn_fence(__ATOMIC_RELEASE, "agent");
            asm volatile("s_waitcnt vmcnt(0)" ::: "memory");
            const unsigned og = xb_add(&bar[XB_TOP], 1u);
            const unsigned tg = og / nx;
            if (og + 1u == (tg + 1u) * nx) xb_add(&bar[XB_TOPGEN], 1u);
            else XB_SPIN(xb_ld(&bar[XB_TOPGEN]) == tg, bar);
            __builtin_amdgcn_fence(__ATOMIC_ACQUIRE, "agent");
            xb_add(&bar[XB_XGEN(b.x)], 1u);
            asm volatile("s_waitcnt vmcnt(0)" ::: "memory");
        } else {
            XB_SPIN(xb_ld(&bar[XB_XGEN(b.x)]) == gen, bar);
            __builtin_amdgcn_fence(__ATOMIC_ACQUIRE, "agent");
            asm volatile("s_waitcnt vmcnt(0)" ::: "memory");
        }
    }
    __syncthreads();
}

constexpr int NTHREADS = 512;
constexpr int LDS_BYTES = 163840;

#if defined(__HIP_DEVICE_COMPILE__)
typedef unsigned short bf16_t;
typedef short bf16x8 __attribute__((ext_vector_type(8)));
typedef float f32x4 __attribute__((ext_vector_type(4)));
typedef float f32x2 __attribute__((ext_vector_type(2)));
typedef unsigned u32x4 __attribute__((ext_vector_type(4)));
typedef unsigned u32x2 __attribute__((ext_vector_type(2)));
#define LDS_WAIT() asm volatile("s_waitcnt lgkmcnt(0)" ::: "memory")
#define VM_WAIT() asm volatile("s_waitcnt vmcnt(0)" ::: "memory")

__device__ __forceinline__ f32x4 zero4() { float z = 0.f; asm volatile("" : "+v"(z)); return (f32x4){z, z, z, z}; }
__device__ __forceinline__ u32x4 uzero4() { unsigned z = 0u; asm volatile("" : "+v"(z)); return (u32x4){z, z, z, z}; }
__device__ __forceinline__ unsigned f2bf(float f) { unsigned u = __float_as_uint(f); return (u + 0x7fffu + ((u >> 16) & 1u)) >> 16; }
__device__ __forceinline__ unsigned pk2(float lo, float hi) { return f2bf(lo) | (f2bf(hi) << 16); }
__device__ __forceinline__ float bf2f(unsigned b) { return __uint_as_float(b << 16); }
__device__ __forceinline__ float bflo(unsigned w) { return __uint_as_float(w << 16); }
__device__ __forceinline__ float bfhi(unsigned w) { return __uint_as_float(w & 0xffff0000u); }
typedef __bf16 bf16x2_t __attribute__((ext_vector_type(2)));
__device__ __forceinline__ unsigned cvt_pk_bf16(float lo, float hi) { const f32x2 v = {lo, hi}; return __builtin_bit_cast(unsigned, __builtin_convertvector(v, bf16x2_t)); }
__device__ __forceinline__ float fast_sigmoid(float x) { return __builtin_amdgcn_rcpf(1.0f + __expf(-x)); }
__device__ __forceinline__ f32x4 sig4(f32x4 v) { return (f32x4){fast_sigmoid(v[0]), fast_sigmoid(v[1]), fast_sigmoid(v[2]), fast_sigmoid(v[3])}; }
__device__ __forceinline__ unsigned pk4_fp8(float a, float b, float c2, float d) { int w = 0; w = __builtin_amdgcn_cvt_pk_fp8_f32(a, b, w, false); w = __builtin_amdgcn_cvt_pk_fp8_f32(c2, d, w, true); return (unsigned)w; }
__device__ __forceinline__ u32x4 pack8(f32x4 v0, f32x4 v1) { u32x4 w; w.x = cvt_pk_bf16(v0[0], v0[1]); w.y = cvt_pk_bf16(v0[2], v0[3]); w.z = cvt_pk_bf16(v1[0], v1[1]); w.w = cvt_pk_bf16(v1[2], v1[3]); return w; }

namespace gx {
constexpr int BM = 256, BK = 64, HALF = 128, HTB = HALF * BK * 2, STAGE_BYTES = 8 * HTB, NXCD = 8, WGM = 2;
__device__ __forceinline__ int lds_byte(int r, int c) { const int st = (r >> 4) * 2 + (c >> 5), rr = r & 15, cc = c & 31, ob = rr * 64 + cc * 2; return st * 1024 + (ob ^ (((ob >> 9) & 1) << 5)); }
__device__ __forceinline__ void stage_rc(int b, int& R, int& C) { const int st = b / 1024, sb = b % 1024, swz = sb ^ (((sb >> 9) & 1) << 5); R = (st >> 1) * 16 + swz / 64; C = (st & 1) * 32 + (swz % 64) / 2; }
__device__ __forceinline__ int perm32(int rho) { const int n = rho >> 4, i = rho & 15; return 8 * (i >> 2) + 4 * n + (i & 3); }
struct Unit { int pm, pn, e, f; };
struct Gemm { const bf16_t* A; const bf16_t* Bt; int K; size_t bexp; };
struct StaticOrder {
    int nM, nN, nwg, G, c;
    __device__ void init(int M, int N, int G_, int c_) { nM = M / BM; nN = N / BM; nwg = nM * nN; G = G_; c = c_; }
    __device__ bool next(int i, Unit& u) const {
        const long Lx = (long)i * G + c; if (Lx >= nwg) return false;
        int wgid = (int)Lx; { const int q = nwg / NXCD, r = nwg % NXCD, xcd = wgid % NXCD, off = wgid / NXCD; wgid = (xcd < r ? xcd * (q + 1) : r * (q + 1) + (xcd - r) * q) + off; }
        const int nig = WGM * nN, gid = wgid / nig, fm = gid * WGM, gsz = (nM - fm) < WGM ? (nM - fm) : WGM;
        u.pm = fm + ((wgid % nig) % gsz); u.pn = (wgid % nig) / gsz; u.e = 0; u.f = 0; return true;
    }
};
typedef int v8i32 __attribute__((ext_vector_type(8)));
template <class Epi, class Sched, bool GATHER = false, bool FP8 = false>
__device__ __forceinline__ void gemm_phase(LAS unsigned char* lds, const Gemm g, const Sched& S, const Epi& E, const int* rowidx = nullptr) {
    int tid = threadIdx.x; asm volatile("" : "+v"(tid)); const int wid = __builtin_amdgcn_readfirstlane(tid >> 6), lane = tid & 63, wr = wid >> 2, wc = wid & 3, fr = lane & 15, fq = lane >> 4;
    int K = g.K; asm volatile("" : "+s"(K)); const int nt = K / BK;
    unsigned voffA[2], voffB[2];
#pragma unroll
    for (int i = 0; i < 2; ++i) { int R, C; stage_rc(tid * 16 + i * 8192, R, C); const int Rb = Epi::PERM ? ((R & ~31) + perm32(R & 31)) : R;
        voffA[i] = (unsigned)(R * K + C) * 2u; voffB[i] = (unsigned)(Rb * K + C) * 2u; }
    const size_t kstep = (size_t)(BK * 2);
    const size_t hstep = (size_t)HALF * K * 2;
    const size_t tstep = 2 * hstep;
    const size_t hstepA = GATHER ? 0 : hstep;
    const unsigned ldsw = (unsigned)wid * 1024u;
    const int aoff = lds_byte(wr * 64 + fr, fq * 8), boff = lds_byte(wc * 32 + fr, fq * 8);
#define GX_SA(b, h) (((b) * 2 + (h)) * HTB)
#define GX_SB(b, h) ((4 + (b) * 2 + (h)) * HTB)
#define GX_STAGE(bufoff, gbase, voff) do { _Pragma("unroll") for (int _i = 0; _i < 2; ++_i) \
        __builtin_amdgcn_global_load_lds((const unsigned*)((const char*)(gbase) + (voff)[_i]), (LAS unsigned*)(lds + (bufoff) + ldsw + _i * 8192), 16, 0, 0); } while (0)
#define GX_STAGE_A(bufoff, ptr, half, usenext) do { if (GATHER) { unsigned _v[2]; _Pragma("unroll") for (int _i = 0; _i < 2; ++_i) _v[_i] = (usenext) ? nv[half][_i] : cv[half][_i]; GX_STAGE(bufoff, ptr, _v); } \
        else GX_STAGE(bufoff, (ptr) + (half) * hstepA, voffA); } while (0)
#define GX_IDX(dst, u) do { _Pragma("unroll") for (int _i = 0; _i < 2; ++_i) { int _R, _C; stage_rc(tid * 16 + _i * 8192, _R, _C); _Pragma("unroll") for (int _h = 0; _h < 2; ++_h) \
        dst[_h][_i] = (unsigned)rowidx[(u).pm * 256 + _h * 128 + _R] * (unsigned)(K * 2) + (unsigned)(_C * 2); } } while (0)
#define GX_LDA(dst, b, h) do { _Pragma("unroll") for (int m = 0; m < 4; ++m) _Pragma("unroll") for (int k = 0; k < 2; ++k) dst[m][k] = *(const LAS bf16x8*)(lds + GX_SA(b, h) + aoff + m * 2048 + k * 1024); } while (0)
#define GX_LDB(dst, b, h) do { _Pragma("unroll") for (int n = 0; n < 2; ++n) _Pragma("unroll") for (int k = 0; k < 2; ++k) dst[n][k] = *(const LAS bf16x8*)(lds + GX_SB(b, h) + boff + n * 2048 + k * 1024); } while (0)
#define GX_CAT8(lo, hi) __builtin_bit_cast(v8i32, __builtin_shufflevector(__builtin_bit_cast(u32x4, lo), __builtin_bit_cast(u32x4, hi), 0, 1, 2, 3, 4, 5, 6, 7))
#define GX_MMA(ai, bj, At, Bt) do { __builtin_amdgcn_s_setprio(1); if (FP8) { _Pragma("unroll") for (int m = 0; m < 4; ++m) _Pragma("unroll") for (int n = 0; n < 2; ++n) \
            asm volatile("v_mfma_scale_f32_16x16x128_f8f6f4 %0, %1, %2, %0, %3, %3 op_sel_hi:[0,0,0]" : "+v"(acc[ai][bj][m][n]) : "v"(GX_CAT8(Bt[n][0], Bt[n][1])), "v"(GX_CAT8(At[m][0], At[m][1])), "v"(one_scale)); } \
        else { _Pragma("unroll") for (int m = 0; m < 4; ++m) _Pragma("unroll") for (int n = 0; n < 2; ++n) _Pragma("unroll") for (int k = 0; k < 2; ++k) \
        acc[ai][bj][m][n] = __builtin_amdgcn_mfma_f32_16x16x32_bf16(Bt[n][k], At[m][k], acc[ai][bj][m][n], 0, 0, 0); } __builtin_amdgcn_s_setprio(0); } while (0)
#define GX_WAIT_V(n) asm volatile("s_waitcnt vmcnt(" #n ")" ::: "memory")
#define GX_WAIT_L(n) asm volatile("s_waitcnt lgkmcnt(" #n ")" ::: "memory")
#define GX_BAR __builtin_amdgcn_s_barrier()
#define GX_SCHED __builtin_amdgcn_sched_barrier(0)
    Unit cur, nxt, nn; int ui = 0;
    if (!S.next(0, cur)) return;
    bool has_next = S.next(1, nxt);
    unsigned cv[2][2], nv[2][2], nnv[2][2];
    if (GATHER) { GX_IDX(cv, cur); if (has_next) GX_IDX(nv, nxt); else { _Pragma("unroll") for (int h = 0; h < 2; ++h) _Pragma("unroll") for (int i = 0; i < 2; ++i) nv[h][i] = cv[h][i]; } }
    f32x4 acc[2][2][4][2];
    { float z = 0.f; asm volatile("" : "+v"(z));
#pragma unroll
    for (int a = 0; a < 2; ++a)
#pragma unroll
        for (int b = 0; b < 2; ++b)
#pragma unroll
            for (int m = 0; m < 4; ++m)
#pragma unroll
                for (int n = 0; n < 2; ++n) acc[a][b][m][n] = (f32x4){z, z, z, z}; }
    bf16x8 At[4][2], B0[2][2], B1[2][2]; int one_scale = 0x7f7f7f7f; asm volatile("" : "+v"(one_scale));
    const char* cA = (const char*)g.A + (GATHER ? 0 : (size_t)cur.pm * tstep); const char* cB = (const char*)g.Bt + (size_t)cur.e * g.bexp + (size_t)cur.pn * tstep;
    GX_STAGE(GX_SB(0, 0), cB, voffB); GX_STAGE_A(GX_SA(0, 0), cA, 0, false); GX_STAGE(GX_SB(0, 1), cB + hstep, voffB); GX_STAGE_A(GX_SA(0, 1), cA, 1, false);
    if (wr == 1) GX_BAR;
    GX_WAIT_V(4); GX_BAR;
    GX_STAGE(GX_SB(1, 0), cB + kstep, voffB); GX_STAGE_A(GX_SA(1, 0), cA + kstep, 0, false); GX_STAGE(GX_SB(1, 1), cB + hstep + kstep, voffB);
    GX_WAIT_V(6); GX_BAR;
    for (;;) {
        const char* nA = (has_next && !GATHER) ? (const char*)g.A + (size_t)nxt.pm * tstep : cA; const char* nB = has_next ? (const char*)g.Bt + (size_t)nxt.e * g.bexp + (size_t)nxt.pn * tstep : cB;
#pragma clang loop unroll(disable)
        for (int t = 0; t < nt; t += 2) {
            const bool last = (t == nt - 2);
            const char* a1 = cA + (size_t)(t + 1) * kstep;
            const char* a2 = last ? nA : cA + (size_t)(t + 2) * kstep; const char* b2 = last ? nB : cB + (size_t)(t + 2) * kstep;
            const char* a3 = a2 + kstep; const char* b3 = b2 + kstep;
            GX_LDB(B0, 0, 0); GX_SCHED; GX_LDA(At, 0, 0); GX_STAGE_A(GX_SA(1, 1), a1, 1, false);
            GX_WAIT_L(8); GX_BAR; GX_WAIT_L(0); GX_MMA(0, 0, At, B0); GX_BAR; GX_SCHED;
            GX_LDB(B1, 0, 1); GX_STAGE(GX_SB(0, 0), b2, voffB);
            GX_BAR; GX_WAIT_L(0); GX_MMA(0, 1, At, B1); GX_BAR;
            GX_LDA(At, 0, 1); GX_STAGE_A(GX_SA(0, 0), a2, 0, last);
            GX_BAR; GX_WAIT_L(0); GX_MMA(1, 0, At, B0); GX_BAR; GX_SCHED;
            GX_STAGE(GX_SB(0, 1), b2 + hstep, voffB);
            GX_WAIT_V(6); GX_BAR; GX_MMA(1, 1, At, B1); GX_BAR;
            GX_LDB(B0, 1, 0); GX_SCHED; GX_LDA(At, 1, 0); GX_STAGE_A(GX_SA(0, 1), a2, 1, last);
            GX_WAIT_L(8); GX_BAR; GX_WAIT_L(0); GX_MMA(0, 0, At, B0); GX_BAR; GX_SCHED;
            GX_LDB(B1, 1, 1); GX_STAGE(GX_SB(1, 0), b3, voffB);
            GX_BAR; GX_WAIT_L(0); GX_MMA(0, 1, At, B1); GX_BAR;
            GX_LDA(At, 1, 1); GX_STAGE_A(GX_SA(1, 0), a3, 0, last);
            GX_BAR; GX_WAIT_L(0); GX_MMA(1, 0, At, B0); GX_BAR; GX_SCHED;
            GX_STAGE(GX_SB(1, 1), b3 + hstep, voffB);
            GX_WAIT_V(6); GX_BAR; GX_MMA(1, 1, At, B1); GX_BAR;
        }
        const bool has_nn = has_next && S.next(ui + 2, nn);
        if (GATHER && has_nn) GX_IDX(nnv, nn);
        if (FP8) asm volatile("s_nop 15\n\ts_nop 15" ::: "memory");
        E(acc, cur, wr, wc, fr, fq);
        if (!has_next) break;
        { float z = 0.f; asm volatile("" : "+v"(z));
#pragma unroll
        for (int a = 0; a < 2; ++a)
#pragma unroll
            for (int b = 0; b < 2; ++b)
#pragma unroll
                for (int m = 0; m < 4; ++m)
#pragma unroll
                    for (int n = 0; n < 2; ++n) acc[a][b][m][n] = (f32x4){z, z, z, z}; }
        cur = nxt; cA = nA; cB = nB; ++ui;
        if (GATHER) { _Pragma("unroll") for (int h = 0; h < 2; ++h) _Pragma("unroll") for (int i = 0; i < 2; ++i) { cv[h][i] = nv[h][i]; if (has_nn) nv[h][i] = nnv[h][i]; } }
        nxt = nn; has_next = has_nn;
    }
    GX_WAIT_V(0);
    if (wr == 0) GX_BAR;
    GX_BAR;
#undef GX_SA
#undef GX_SB
#undef GX_STAGE
#undef GX_STAGE_A
#undef GX_IDX
#undef GX_LDA
#undef GX_LDB
#undef GX_MMA
#undef GX_CAT8
#undef GX_WAIT_V
#undef GX_WAIT_L
#undef GX_BAR
#undef GX_SCHED
}
}

template <bool RAWG, bool RAWZ> struct EpiInproj {
    static constexpr bool PERM = true;
    bf16_t *Gb, *Zb, *XBCb, *QKVU; float* dtf; const float* bgate; bf16_t* Ug;
    __device__ __forceinline__ void operator()(const f32x4 (&acc)[2][2][4][2], const gx::Unit& u, int wr, int wc, int fr, int fq) const {
        const int row0 = u.pm * 256 + wr * 64 + fr, cl = wc * 32 + 8 * fq;
        if (u.pn == 54) {
            if (wc < 2) {
#pragma unroll
                for (int ai = 0; ai < 2; ++ai)
#pragma unroll
                    for (int m = 0; m < 4; ++m) { float* rowp = dtf + (size_t)(row0 + ai * 128 + m * 16) * 64 + cl; *(f32x4*)rowp = acc[ai][0][m][0]; *(f32x4*)(rowp + 4) = acc[ai][0][m][1]; }
            }
            return;
        }
        bf16_t* base; int ldc, colt, mode;
        if (u.pn < 12) { base = Gb; ldc = 3072; colt = u.pn * 256; mode = RAWG ? 0 : 1; }
        else if (u.pn < 20) { base = Zb; ldc = 2048; colt = (u.pn - 12) * 256; mode = RAWZ ? 0 : 2; }
        else if (u.pn < 36) { base = XBCb; ldc = 4096; colt = (u.pn - 20) * 256; mode = 0; }
        else { base = QKVU; ldc = 4608; colt = (u.pn - 36) * 256; mode = 0; }
        const bool isu = u.pn >= 50;
#pragma unroll
        for (int bj = 0; bj < 2; ++bj) {
            const int col = colt + bj * 128 + cl;
            f32x4 b0 = zero4(), b1 = b0;
            if (mode == 1) { b0 = *(const f32x4*)(bgate + col); b1 = *(const f32x4*)(bgate + col + 4); }
#pragma unroll
            for (int ai = 0; ai < 2; ++ai)
#pragma unroll
                for (int m = 0; m < 4; ++m) {
                    f32x4 v0 = acc[ai][bj][m][0], v1 = acc[ai][bj][m][1];
                    if (mode == 1) { v0 = sig4(v0 + b0); v1 = sig4(v1 + b1); }
                    else if (mode == 2) { v0 = v0 * sig4(v0); v1 = v1 * sig4(v1); }
                    const u32x4 pk = pack8(v0, v1);
                    if (isu || (u.pn == 49 && bj == 1)) { const int uc = col - 3456; *(u32x4*)(Ug + ((size_t)(uc >> 4) * 16384 + (row0 + ai * 128 + m * 16)) * 16 + (uc & 15)) = pk; }
                    else *(u32x4*)(base + (size_t)(row0 + ai * 128 + m * 16) * ldc + col) = pk;
                }
        }
    }
};

struct EpiGlu {
    static constexpr bool PERM = true;
    bf16_t* O;
    __device__ __forceinline__ void operator()(const f32x4 (&acc)[2][2][4][2], const gx::Unit& u, int wr, int wc, int fr, int fq) const {
        const int row0 = u.pm * 256 + wr * 64 + fr, col = u.pn * 128 + wc * 32 + 8 * fq;
#pragma unroll
        for (int ai = 0; ai < 2; ++ai)
#pragma unroll
            for (int m = 0; m < 4; ++m) {
                const f32x4 v0 = acc[ai][0][m][0] * sig4(acc[ai][1][m][0]), v1 = acc[ai][0][m][1] * sig4(acc[ai][1][m][1]);
                *(u32x4*)(O + (size_t)(row0 + ai * 128 + m * 16) * 1152 + col) = pack8(v0, v1);
            }
    }
};
template <int STEP> struct EpiBranch {
    static constexpr bool PERM = true;
    const bf16_t* G; bf16_t* mb; const float* ssq;
    __device__ __forceinline__ void operator()(const f32x4 (&acc)[2][2][4][2], const gx::Unit& u, int wr, int wc, int fr, int fq) const {
        const int row0 = u.pm * 256 + wr * 64 + fr, cl = u.pn * 256 + wc * 32 + 8 * fq;
#pragma unroll
        for (int ai = 0; ai < 2; ++ai) {
            u32x4 gw[4][2], pw[4][2]; float rs[4];
#pragma unroll
            for (int m = 0; m < 4; ++m) { const size_t row = (size_t)(row0 + ai * 128 + m * 16);
#pragma unroll
                for (int bj = 0; bj < 2; ++bj) { const int col = cl + bj * 128; gw[m][bj] = *(const u32x4*)(G + row * 3072 + STEP * 1024 + col); if (STEP > 0) pw[m][bj] = *(const u32x4*)(mb + row * 1024 + col); }
                if (STEP == 0) { const f32x4 qa = *(const f32x4*)(ssq + row * 8), qb = *(const f32x4*)(ssq + row * 8 + 4);
                    rs[m] = __builtin_amdgcn_rsqf((((qa[0] + qa[1]) + (qa[2] + qa[3])) + ((qb[0] + qb[1]) + (qb[2] + qb[3]))) * (1.0f / 2048.0f) + md::EPS); } }
#pragma unroll
            for (int m = 0; m < 4; ++m)
#pragma unroll
                for (int bj = 0; bj < 2; ++bj) { const size_t row = (size_t)(row0 + ai * 128 + m * 16); const int col = cl + bj * 128; const u32x4 g4 = gw[m][bj];
                    const f32x4 g0 = (f32x4){bflo(g4.x), bfhi(g4.x), bflo(g4.y), bfhi(g4.y)}, g1 = (f32x4){bflo(g4.z), bfhi(g4.z), bflo(g4.w), bfhi(g4.w)};
                    f32x4 v0 = acc[ai][bj][m][0] * g0, v1 = acc[ai][bj][m][1] * g1;
                    if (STEP == 0) { v0 *= rs[m]; v1 *= rs[m]; }
                    if (STEP > 0) { const u32x4 p4 = pw[m][bj]; v0 += (f32x4){bflo(p4.x), bfhi(p4.x), bflo(p4.y), bfhi(p4.y)}; v1 += (f32x4){bflo(p4.z), bfhi(p4.z), bflo(p4.w), bfhi(p4.w)}; }
                    *(u32x4*)(mb + row * 1024 + col) = pack8(v0, v1); }
        }
    }
};
struct EpiBf16 {
    static constexpr bool PERM = true;
    bf16_t* C;
    __device__ __forceinline__ void operator()(const f32x4 (&acc)[2][2][4][2], const gx::Unit& u, int wr, int wc, int fr, int fq) const {
        const int row0 = u.pm * 256 + wr * 64 + fr, cl = u.pn * 256 + wc * 32 + 8 * fq;
#pragma unroll
        for (int ai = 0; ai < 2; ++ai)
#pragma unroll
            for (int m = 0; m < 4; ++m)
#pragma unroll
                for (int bj = 0; bj < 2; ++bj) *(u32x4*)(C + (size_t)(row0 + ai * 128 + m * 16) * 1024 + cl + bj * 128) = pack8(acc[ai][bj][m][0], acc[ai][bj][m][1]);
    }
};

__device__ __forceinline__ void cvt_item(const float* Wsrc  , int ldn, bf16_t* dst  , int K, int k0, LAS float* scr, int lane, const float* kscale) {
#pragma unroll
    for (int hb = 0; hb < 2; ++hb) {
        float v[32];
#pragma unroll
        for (int i = 0; i < 32; ++i) v[i] = __builtin_nontemporal_load(Wsrc + (size_t)(k0 + 32 * hb + i) * ldn + lane);
        if (kscale) {
#pragma unroll
            for (int i = 0; i < 32; ++i) v[i] *= kscale[k0 + 32 * hb + i];
        }
#pragma unroll
        for (int i = 0; i < 32; ++i) scr[(32 * hb + i) * 65 + lane] = v[i];
    }
    LDS_WAIT(); asm volatile("" ::: "memory");
    const int cch = lane & 7;
#pragma unroll
    for (int j = 0; j < 8; ++j) { const int n = (lane >> 3) + 8 * j; const LAS float* sp = scr + (8 * cch) * 65 + n;
        u32x4 o; o.x = cvt_pk_bf16(sp[0 * 65], sp[1 * 65]); o.y = cvt_pk_bf16(sp[2 * 65], sp[3 * 65]); o.z = cvt_pk_bf16(sp[4 * 65], sp[5 * 65]); o.w = cvt_pk_bf16(sp[6 * 65], sp[7 * 65]);
        *(u32x4*)(dst + (size_t)n * K + k0 + 8 * cch) = o; }
    LDS_WAIT(); asm volatile("" ::: "memory");
}
__device__ __forceinline__ void cvt8_load(float (&v)[64], const float* Wsrc, int ldn, int k0, int lane) {
#pragma unroll
    for (int i = 0; i < 64; ++i) v[i] = __builtin_nontemporal_load(Wsrc + (size_t)(k0 + i) * ldn + lane);
}
__device__ __forceinline__ void cvt8_put(const float (&v)[64], LAS float* scr, int lane, float wmul) {
#pragma unroll
    for (int i = 0; i < 64; ++i) scr[i * 65 + lane] = v[i] * wmul;
}
__device__ __forceinline__ void cvt8_out(unsigned char* dst  , int Kb  , int k0, LAS float* scr, int lane) {
    LDS_WAIT(); asm volatile("" ::: "memory");
    const LAS float* sp = scr + lane;
#pragma unroll
    for (int j = 0; j < 4; ++j) { u32x4 o;
        o.x = pk4_fp8(sp[(16 * j + 0) * 65], sp[(16 * j + 1) * 65], sp[(16 * j + 2) * 65], sp[(16 * j + 3) * 65]); o.y = pk4_fp8(sp[(16 * j + 4) * 65], sp[(16 * j + 5) * 65], sp[(16 * j + 6) * 65], sp[(16 * j + 7) * 65]);
        o.z = pk4_fp8(sp[(16 * j + 8) * 65], sp[(16 * j + 9) * 65], sp[(16 * j + 10) * 65], sp[(16 * j + 11) * 65]); o.w = pk4_fp8(sp[(16 * j + 12) * 65], sp[(16 * j + 13) * 65], sp[(16 * j + 14) * 65], sp[(16 * j + 15) * 65]);
        *(u32x4*)(dst + (size_t)lane * Kb + k0 + 16 * j) = o; }
    LDS_WAIT(); asm volatile("" ::: "memory");
}
template <bool SMALL, bool MOE>
__device__ __forceinline__ void prologue_weights(const Ctx& c, int l, int par, LAS unsigned char* lds, int first_wg, int n_wg) {
    int tid_ = threadIdx.x; asm volatile("" : "+v"(tid_)); const int wave = __builtin_amdgcn_readfirstlane(tid_ >> 6), lane = tid_ & 63;
    LAS float* scr = (LAS float*)(lds + wave * 16640);
    const int gw = ((int)blockIdx.x - first_wg) * 8 + wave, NGW = n_wg * 8;
    constexpr int N_WIN = 16 * 217, N_GLU = 18 * 18, N_BS = 32 * 16, N_BA = 6 * 16, N_B5 = 18 * 16, N_WO = 16 * 16, N_GU = 32 * 16 * 32, N_DN = 32 * 16 * 16;
    constexpr int N_SMALL = N_WIN + 2 * N_GLU + N_BS + N_BA + N_B5 + N_WO;
    if (SMALL) {
        bf16_t* Win_t = c.Win_t + par * wsz::WIN; bf16_t* Wglu_t = c.Wglu_t + par * wsz::WGLU; bf16_t* Wbs_t = c.Wbs_t + par * wsz::WBS; bf16_t* Wba_t = c.Wba_t + par * wsz::WBA; bf16_t* Wb5_t = c.Wb5_t + par * wsz::WB5; bf16_t* Wout_t = c.Wout_t + par * wsz::WOUT;
#pragma unroll 1
        for (int it = gw; it < N_SMALL; it += NGW) {
            int r = it; const float* src; bf16_t* dst; int ldn, K, kb; const float* ksc = nullptr;
            if (r < N_WIN) { kb = r / 217; const int n0 = (r % 217) * 64; const int drow = n0 < 9216 ? n0 : (n0 < 9280 ? 13824 + (n0 - 9216) : n0 - 64);
                src = c.in[I_WIN] + (size_t)l * 1024 * md::NIN + n0; ldn = md::NIN; dst = Win_t + (size_t)drow * 1024; K = 1024; }
            else if ((r -= N_WIN) < 2 * N_GLU) { const int w = r / N_GLU; r -= w * N_GLU; kb = r / 18; const int sb = r % 18; const int drow = 256 * (sb / 2) + 64 * (sb % 2) + 128 * w;
                src = c.in[w ? I_GLU2 : I_GLU1] + (size_t)l * 1152 * 1152 + sb * 64; ldn = 1152; dst = Wglu_t + (size_t)drow * 1152; K = 1152; }
            else if ((r -= 2 * N_GLU) < N_BS) { kb = r / 16; const int sb = r % 16; src = c.in[I_WBSSD] + (size_t)l * 2048 * 1024 + sb * 64; ldn = 1024; dst = Wbs_t + (size_t)(sb * 64) * 2048; K = 2048; ksc = c.in[I_NORMW] + (size_t)l * 2048; }
            else if ((r -= N_BS) < N_BA) { kb = r / 16; const int sb = r % 16; src = c.in[I_WBATT] + (size_t)l * 384 * 1024 + sb * 64; ldn = 1024; dst = Wba_t + (size_t)(sb * 64) * 384; K = 384; }
            else if ((r -= N_BA) < N_B5) { kb = r / 16; const int sb = r % 16; src = c.in[I_WBS5] + (size_t)l * 1152 * 1024 + sb * 64; ldn = 1024; dst = Wb5_t + (size_t)(sb * 64) * 1152; K = 1152; }
            else { r -= N_B5; kb = r / 16; const int sb = r % 16; src = c.in[I_WOUT] + (size_t)l * 1024 * 1024 + sb * 64; ldn = 1024; dst = Wout_t + (size_t)(sb * 64) * 1024; K = 1024; }
            cvt_item(src, ldn, dst, K, kb * 64, scr, lane, ksc);
        }
        for (long i = (long)((int)blockIdx.x - first_wg) * NTHREADS + tid_; i < 192 * 1024 / 8; i += (long)n_wg * NTHREADS) *(u32x4*)(Win_t + (size_t)13888 * 1024 + i * 8) = uzero4();
    }
    if (MOE) {
#define MOE_ITEM(r_, src, ldn, dst, kb) do { int r = (r_); \
            if (r < N_GU) { const int e = r / (16 * 32); r -= e * 16 * 32; kb = r / 32; const int sb = r % 32; const int s2 = sb & 15; const int drow = e * 2048 + 256 * (s2 / 2) + 64 * (s2 % 2) + (sb >= 16 ? 128 : 0); \
                src = c.in[I_WGU] + ((size_t)l * 32 + e) * 1024 * 2048 + sb * 64; ldn = 2048; dst = (unsigned char*)c.Wgu_t + (size_t)drow * 1024; } \
            else { r -= N_GU; const int e = r / (16 * 16); r -= e * 16 * 16; kb = r / 16; const int sb = r % 16; \
                src = c.in[I_WDN] + ((size_t)l * 32 + e) * 1024 * 1024 + sb * 64; ldn = 1024; dst = (unsigned char*)c.Wdn_t + (size_t)(e * 1024 + sb * 64) * 1024; } } while (0)
        float v[64]; const float* src; unsigned char* dst; int ldn, kb; int it = gw;
        if (it < N_GU + N_DN) { MOE_ITEM(it, src, ldn, dst, kb); cvt8_load(v, src, ldn, kb * 64, lane); }
#pragma unroll 1
        for (; it < N_GU + N_DN; it += NGW) {
            cvt8_put(v, scr, lane, 64.0f);
            unsigned char* dcur = dst; const int kcur = kb;
            if (it + NGW < N_GU + N_DN) { MOE_ITEM(it + NGW, src, ldn, dst, kb); cvt8_load(v, src, ldn, kb * 64, lane); }
            cvt8_out(dcur, 1024, kcur * 64, scr, lane);
        }
#undef MOE_ITEM
    }
}
__device__ __forceinline__ void cvt_x8(const float* x, bf16_t* o, long i) {
    const f32x4 a = *(const f32x4*)(x + i * 8), b = *(const f32x4*)(x + i * 8 + 4);
    *(u32x4*)(o + i * 8) = pack8(a, b);
}
#endif

#define LOOP(count, stmt) do { unsigned t_ = threadIdx.x; asm volatile("" : "+v"(t_)); const long gth_ = (long)c.grid * NTHREADS; for (long i = (long)blockIdx.x * NTHREADS + t_; i < (long)(count); i += gth_) { stmt; } } while (0)
#define SYNC() xcd_barrier(bar)
constexpr int ox_T = 16384;

#if defined(__HIP_DEVICE_COMPILE__)
constexpr int LDS_TAB = 131072;
constexpr int NSLOT_MAX = 65536 + 32 * 256;
#define SWZ_XOR(v, k) __int_as_float(__builtin_amdgcn_ds_swizzle(__float_as_int(v), ((k) << 10) | 0x1f))
__device__ __forceinline__ float wave_sum(float v) {
    v += SWZ_XOR(v, 1); v += SWZ_XOR(v, 2); v += SWZ_XOR(v, 4); v += SWZ_XOR(v, 8); v += SWZ_XOR(v, 16);
    return __int_as_float(__builtin_amdgcn_readlane(__float_as_int(v), 0)) + __int_as_float(__builtin_amdgcn_readlane(__float_as_int(v), 32));
}
__device__ __forceinline__ void moe_count(const Ctx& c, LAS unsigned char* lds) {
    int tid = threadIdx.x; asm volatile("" : "+v"(tid));
    LAS int* cl = (LAS int*)lds;
    for (int gi = blockIdx.x; gi < ox_T / 64; gi += c.grid) {
        if (tid < 32) cl[tid] = 0;
        __syncthreads();
        if (tid < 256) atomicAdd((int*)(cl + c.topidx[gi * 256 + tid]), 1);
        __syncthreads();
        if (tid < 32) c.moe_cnt[gi * 32 + tid] = cl[tid];
        __syncthreads();
    }
}
__device__ __forceinline__ void moe_assign(const Ctx& c, LAS unsigned char* lds) {
    int tid = threadIdx.x; asm volatile("" : "+v"(tid));
    LAS int* tbl = (LAS int*)lds;
    LAS int* total = tbl + 8192;
    LAS int* pstart = total + 32;
    LAS int* base = pstart + 40;
    LAS int* eids = base + 32;
    __syncthreads();
    for (int i = tid; i < 8192; i += NTHREADS) tbl[i] = c.moe_cnt[i];
    __syncthreads();
    if (tid < 32) { int s = 0; for (int gi = 0; gi < 256; ++gi) s += tbl[gi * 32 + tid]; total[tid] = s; }
    __syncthreads();
    if (tid == 0) { int p = 0; for (int e = 0; e < 32; ++e) { pstart[e] = p; p += (total[e] + 255) / 256 * 256; } pstart[32] = p; }
    __syncthreads();
    if (blockIdx.x == 0 && tid < 33) c.moe_pstart[tid] = pstart[tid];
    if (blockIdx.x == 0 && tid < 288) c.moe_done[tid] = 0;
    for (int e = blockIdx.x; e < 32; e += c.grid) {
        const int r0 = pstart[e] + total[e], r1 = pstart[e + 1];
        for (int i = r0 + tid; i < r1; i += NTHREADS) c.slot_tok[i] = ox_T;
    }
    for (int gi = blockIdx.x; gi < ox_T / 64; gi += c.grid) {
        if (tid < 32) { int s = pstart[tid]; for (int g2 = 0; g2 < gi; ++g2) s += tbl[g2 * 32 + tid]; base[tid] = s; }
        if (tid < 256) eids[tid] = c.topidx[gi * 256 + tid];
        __syncthreads();
        if (tid < 256) { const int e = eids[tid]; int r = 0; for (int a = 0; a < tid; ++a) r += (eids[a] == e) ? 1 : 0;
            const int slot = base[e] + r; c.tok_slot[gi * 256 + tid] = slot; c.slot_gate[slot] = c.gate[gi * 256 + tid]; c.slot_tok[slot] = gi * 64 + (tid >> 2); }
        __syncthreads();
    }
}
__device__ __forceinline__ int xcd_chunk(long L, int n) { const int q = n / 8, r = n % 8, xcd = (int)(L % 8), off = (int)(L / 8); return (xcd < r ? xcd * (q + 1) : r * (q + 1) + (xcd - r) * q) + off; }
__device__ __forceinline__ void moe_early(int nb, int G, int& M, int& first_idle) {
    const int rem = (nb * 8) % G; first_idle = rem; const int idle = rem ? G - rem : 0, left = (nb * 4) % G;
    int m = (left + 31) / 32; if (m > 7 || 32 * m > idle) m = 0;
    M = m;
}
struct MoeOrder {
    const LAS int* blkexp; int nunits, G, c, lgN, mode, nb, M, first_idle;
    __device__ __forceinline__ int base(int x) const { return (x * nb + 7) / 8 + 20; }
    __device__ __forceinline__ bool next(int i, gx::Unit& u) const {
        if (mode == 1) { const int j = c - first_idle; if (i > 0 || j < 0 || j >= 32 * M) return false; const int t = j >> 3; u.pm = base(j & 7) + (t >> 2); u.pn = t & 3; u.e = blkexp[u.pm]; u.f = 0; return true; }
        const long L = (long)i * G + c; if (L >= nunits) return false;
        int id = xcd_chunk(L, nunits); if (mode == 2) id = nunits - 1 - id;
        int pm = id >> lgN, f = 0; u.pn = id & ((1 << lgN) - 1);
        if (mode == 2) { for (int x = 0; x < 8; ++x) pm += (pm >= base(x)) ? M : 0; }
        else { for (int x = 0; x < 8; ++x) f |= ((unsigned)(pm - base(x)) < (unsigned)M) ? 1 : 0; }
        u.pm = pm; u.e = blkexp[pm]; u.f = f; return true;
    }
};
__device__ __forceinline__ void moe_wait_rows(const int* done, int rb, int need = 64) {
    int tid = threadIdx.x; asm volatile("" : "+v"(tid));
    if (tid == 0) { unsigned sp = 0; while (__hip_atomic_load(done + rb, __ATOMIC_RELAXED, __HIP_MEMORY_SCOPE_AGENT) < need && ++sp < (1u << 22)) __builtin_amdgcn_s_sleep(2); }
    __syncthreads();
    __builtin_amdgcn_fence(__ATOMIC_ACQUIRE, "agent");
}
__device__ __forceinline__ int moe_blocks(const Ctx& c, LAS unsigned char* lds) {
    int tid = threadIdx.x; asm volatile("" : "+v"(tid));
    LAS int* blkexp = (LAS int*)(lds + LDS_TAB); LAS int* ps = blkexp + 288;
    if (tid < 33) ps[tid] = c.moe_pstart[tid];
    __syncthreads();
    const int nb = ps[32] / 256;
    if (tid < nb) { int e = 0; for (int k = 1; k < 32; ++k) e += (ps[k] <= tid * 256) ? 1 : 0; blkexp[tid] = e; }
    __syncthreads();
    return nb;
}
struct EpiSwiglu {
    static constexpr bool PERM = true;
    unsigned char* O; const float* bgu; int* done;
    __device__ __forceinline__ void operator()(const f32x4 (&acc)[2][2][4][2], const gx::Unit& u, int wr, int wc, int fr, int fq) const {
        const int row0 = u.pm * 256 + wr * 64 + fr, col = u.pn * 128 + wc * 32 + 8 * fq;
        const float* bp = bgu + (size_t)u.e * 2048 + col;
        const f32x4 bg0 = *(const f32x4*)bp, bg1 = *(const f32x4*)(bp + 4), bl0 = *(const f32x4*)(bp + 1024), bl1 = *(const f32x4*)(bp + 1028);
#pragma unroll
        for (int ai = 0; ai < 2; ++ai)
#pragma unroll
            for (int m = 0; m < 4; ++m) {
                f32x4 o[2];
#pragma unroll
                for (int n = 0; n < 2; ++n) {
                    const f32x4 xg = acc[ai][0][m][n] * (1.0f / 64.0f) + (n ? bg1 : bg0), xl = acc[ai][1][m][n] * (1.0f / 64.0f) + (n ? bl1 : bl0);
#pragma unroll
                    for (int j = 0; j < 4; ++j) { const float a = fminf(xg[j], 7.0f), b = fminf(fmaxf(xl[j], -7.0f), 7.0f); o[n][j] = a * fast_sigmoid(1.702f * a) * (b + 1.0f); }
                }
                u32x2 w; w.x = pk4_fp8(o[0][0], o[0][1], o[0][2], o[0][3]); w.y = pk4_fp8(o[1][0], o[1][1], o[1][2], o[1][3]); unsigned char* dst = O + (size_t)(row0 + ai * 128 + m * 16) * 1024 + col;
                if (u.f) __hip_atomic_store((unsigned long long*)dst, (unsigned long long)w.x | ((unsigned long long)w.y << 32), __ATOMIC_RELAXED, __HIP_MEMORY_SCOPE_AGENT);
                else *(u32x2*)dst = w;
            }
        if (u.f) { asm volatile("s_waitcnt vmcnt(0)" ::: "memory"); if ((fr | fq) == 0) (void)__hip_atomic_fetch_add(done + u.pm, 1, __ATOMIC_RELAXED, __HIP_MEMORY_SCOPE_AGENT); }
    }
};
struct EpiDown {
    static constexpr bool PERM = true;
    bf16_t* O; const float* bdn; const float* sg;
    __device__ __forceinline__ void operator()(const f32x4 (&acc)[2][2][4][2], const gx::Unit& u, int wr, int wc, int fr, int fq) const {
        const int row0 = u.pm * 256 + wr * 64 + fr, cl = u.pn * 256 + wc * 32 + 8 * fq;
        f32x4 b[2][2];
#pragma unroll
        for (int bj = 0; bj < 2; ++bj) { b[bj][0] = *(const f32x4*)(bdn + (size_t)u.e * 1024 + cl + bj * 128); b[bj][1] = *(const f32x4*)(bdn + (size_t)u.e * 1024 + cl + bj * 128 + 4); }
#pragma unroll
        for (int ai = 0; ai < 2; ++ai)
#pragma unroll
            for (int m = 0; m < 4; ++m) { const size_t row = (size_t)(row0 + ai * 128 + m * 16); const float gt = sg[row];
#pragma unroll
                for (int bj = 0; bj < 2; ++bj) *(u32x4*)(O + row * 1024 + cl + bj * 128) = pack8((acc[ai][bj][m][0] * (1.0f / 64.0f) + b[bj][0]) * gt, (acc[ai][bj][m][1] * (1.0f / 64.0f) + b[bj][1]) * gt); }
    }
};
__device__ __forceinline__ void moe_combine_ln(const Ctx& c, const float* g, const float* b, float* out  ) {
    int tid = threadIdx.x; asm volatile("" : "+v"(tid)); const int wave = __builtin_amdgcn_readfirstlane(tid >> 6), lane = tid & 63;
    const int stride = c.grid * 8; int t = blockIdx.x * 8 + wave;
    if (t >= ox_T) return;
    u32x2 xa[4]; u32x2 ya[4][4]; int sn[4];
#define CMB_SLOTS(dst, tt) do { _Pragma("unroll") for (int k = 0; k < 4; ++k) dst[k] = c.tok_slot[(tt) * 4 + k]; } while (0)
#define CMB_ROWS(xd, yd, tt, sl) do { _Pragma("unroll") for (int j = 0; j < 4; ++j) { const int col = lane * 4 + 256 * j; xd[j] = *(const u32x2*)(c.x1b + (size_t)(tt) * 1024 + col); \
        _Pragma("unroll") for (int k = 0; k < 4; ++k) yd[k][j] = *(const u32x2*)(c.ys2 + (size_t)sl[k] * 1024 + col); } } while (0)
    CMB_SLOTS(sn, t); CMB_ROWS(xa, ya, t, sn);
    { const int t1 = t + stride < ox_T ? t + stride : t; CMB_SLOTS(sn, t1); }
#pragma unroll 1
    for (; t < ox_T; t += stride) {
        f32x4 v[4]; float s = 0.f;
#pragma unroll
        for (int j = 0; j < 4; ++j) { f32x4 a = (f32x4){bflo(xa[j].x), bfhi(xa[j].x), bflo(xa[j].y), bfhi(xa[j].y)} * md::ALPHA;
            a[0] += (bflo(ya[0][j].x) + bflo(ya[1][j].x)) + (bflo(ya[2][j].x) + bflo(ya[3][j].x)); a[1] += (bfhi(ya[0][j].x) + bfhi(ya[1][j].x)) + (bfhi(ya[2][j].x) + bfhi(ya[3][j].x));
            a[2] += (bflo(ya[0][j].y) + bflo(ya[1][j].y)) + (bflo(ya[2][j].y) + bflo(ya[3][j].y)); a[3] += (bfhi(ya[0][j].y) + bfhi(ya[1][j].y)) + (bfhi(ya[2][j].y) + bfhi(ya[3][j].y));
            v[j] = a; s += (a[0] + a[1]) + (a[2] + a[3]); }
        { const int t1 = t + stride < ox_T ? t + stride : t, t2 = t + 2 * stride < ox_T ? t + 2 * stride : t; CMB_ROWS(xa, ya, t1, sn); CMB_SLOTS(sn, t2); }
        const float mean = wave_sum(s) * (1.0f / 1024.0f); float q = 0.f;
#pragma unroll
        for (int j = 0; j < 4; ++j) { v[j] = v[j] - mean; q += (v[j][0] * v[j][0] + v[j][1] * v[j][1]) + (v[j][2] * v[j][2] + v[j][3] * v[j][3]); }
        const float rstd = __builtin_amdgcn_rsqf(wave_sum(q) * (1.0f / 1024.0f) + md::EPS);
#pragma unroll
        for (int j = 0; j < 4; ++j) { const int col = lane * 4 + 256 * j; const f32x4 gg = *(const f32x4*)(g + col), bb = *(const f32x4*)(b + col);
            const f32x4 y = v[j] * rstd * gg + bb; if (out) *(f32x4*)(out + (size_t)t * 1024 + col) = y;
            u32x2 w; w.x = cvt_pk_bf16(y[0], y[1]); w.y = cvt_pk_bf16(y[2], y[3]); *(u32x2*)(c.xbf + (size_t)t * 1024 + col) = w; }
    }
#undef CMB_SLOTS
#undef CMB_ROWS
}
namespace ssd {
constexpr int PITCH = 272;
constexpr int XST_OFF = 0;
constexpr int R1_OFF = 69632;
constexpr int R2_OFF = 104448;
constexpr int S1_VEC = 104448;
constexpr int S3_VEC = 139264;
constexpr int NC = 64;
__device__ __forceinline__ size_t st_index(int dir, int b, int cidx, int h) { return ((((size_t)dir * 2 + b) * NC + cidx) * 32 + h) * 8192; }

__device__ __forceinline__ float softplus_fast(float x) { const float e = __expf(-fabsf(x)); return fmaxf(x, 0.0f) + (e < 1e-3f ? e * (1.0f - 0.5f * e) : __logf(1.0f + e)); }

__device__ __forceinline__ float cumsum8(LAS float* a, int wave, int lane) {
    LAS float* p = a + wave * 128 + 2 * lane;
    const float a0 = p[0], a1 = p[1];
    float v = a0 + a1;
#pragma unroll
    for (int off = 1; off < 64; off <<= 1) { const float t = __int_as_float(__builtin_amdgcn_ds_bpermute((lane - off) << 2, __float_as_int(v))); if (lane >= off) v += t; }
    const float total = __int_as_float(__builtin_amdgcn_readlane(__float_as_int(v), 63));
    if (wave < 4) { p[0] = v - a1; p[1] = v; } else { p[0] = total - (v - a1 - a0); p[1] = total - (v - a1); }
    return total;
}
template <int MODE>
__device__ __forceinline__ void load_conv(const Ctx& c, int l, int b, int cidx, int g, LAS unsigned char* lds, int tid) {
    const int cg = tid & 63, lg = tid >> 6;
    if (MODE == 1 && cg >= 48) return;
    const int col = cg < 32 ? 256 * g + 8 * cg : (cg < 48 ? 2048 + 128 * g + 8 * (cg - 32) : 3072 + 128 * g + 8 * (cg - 48));
    const float* cw = c.in[I_CONVW] + (size_t)l * 5 * 4096 + col; const float* cb = c.in[I_CONVB] + (size_t)l * 4096 + col;
    float w[5][8], bias[8];
#pragma unroll
    for (int k = 0; k < 5; ++k) { const f32x4 a = *(const f32x4*)(cw + k * 4096), bq = *(const f32x4*)(cw + k * 4096 + 4);
        w[k][0] = a[0]; w[k][1] = a[1]; w[k][2] = a[2]; w[k][3] = a[3]; w[k][4] = bq[0]; w[k][5] = bq[1]; w[k][6] = bq[2]; w[k][7] = bq[3]; }
    { const f32x4 a = *(const f32x4*)cb, bq = *(const f32x4*)(cb + 4); bias[0] = a[0]; bias[1] = a[1]; bias[2] = a[2]; bias[3] = a[3]; bias[4] = bq[0]; bias[5] = bq[1]; bias[6] = bq[2]; bias[7] = bq[3]; }
    const int tl0 = cidx * 128 + lg * 16 - 2;
    const bf16_t* src = c.XBCb + ((size_t)b * 8192) * 4096 + col;
    u32x4 rows[20];
#pragma unroll
    for (int i = 0; i < 20; ++i) { const int tl = tl0 + i; rows[i] = (tl >= 0 && tl < 8192) ? *(const u32x4*)(src + (size_t)tl * 4096) : uzero4(); }
    unsigned outp[8][8];
#pragma unroll
    for (int lo = 0; lo < 16; lo += 2) {
        float v[2][8];
#pragma unroll
        for (int d = 0; d < 2; ++d) {
#pragma unroll
            for (int j = 0; j < 8; ++j) v[d][j] = bias[j];
#pragma unroll
            for (int k = 0; k < 5; ++k) { const u32x4 r = rows[lo + d + k];
                v[d][0] += w[k][0] * bflo(r.x); v[d][1] += w[k][1] * bfhi(r.x); v[d][2] += w[k][2] * bflo(r.y); v[d][3] += w[k][3] * bfhi(r.y);
                v[d][4] += w[k][4] * bflo(r.z); v[d][5] += w[k][5] * bfhi(r.z); v[d][6] += w[k][6] * bflo(r.w); v[d][7] += w[k][7] * bfhi(r.w); }
#pragma unroll
            for (int j = 0; j < 8; ++j) v[d][j] = v[d][j] * fast_sigmoid(v[d][j]);
        }
        if (MODE == 3 && cg >= 32) {
            LAS unsigned char* base = lds + (cg < 48 ? R2_OFF : R1_OFF) + (8 * (cg < 48 ? cg - 32 : cg - 48)) * 2;
#pragma unroll
            for (int d = 0; d < 2; ++d) { f32x4 v0 = (f32x4){v[d][0], v[d][1], v[d][2], v[d][3]}, v1 = (f32x4){v[d][4], v[d][5], v[d][6], v[d][7]};
                *(LAS u32x4*)(base + (lg * 16 + lo + d) * PITCH) = pack8(v0, v1); }
        } else {
#pragma unroll
            for (int j = 0; j < 8; ++j) outp[j][lo >> 1] = cvt_pk_bf16(v[0][j], v[1][j]);
        }
    }
    if (!(MODE == 3 && cg >= 32)) {
        LAS unsigned char* base = lds + (cg < 32 ? XST_OFF + (8 * cg) * PITCH : R1_OFF + (8 * (cg - 32)) * PITCH) + (lg * 16) * 2;
#pragma unroll
        for (int j = 0; j < 8; ++j) { *(LAS u32x4*)(base + j * PITCH) = (u32x4){outp[j][0], outp[j][1], outp[j][2], outp[j][3]}; *(LAS u32x4*)(base + j * PITCH + 16) = (u32x4){outp[j][4], outp[j][5], outp[j][6], outp[j][7]}; }
    }
}

__device__ __forceinline__ void phase_s1(const Ctx& c, int l, LAS unsigned char* lds) {
    int tid = threadIdx.x;
    LAS float* dl = (LAS float*)(lds + S1_VEC); LAS float* ac = dl + 1024; LAS float* wv = ac + 1024;
    for (int item_ = blockIdx.x; item_ < 1024; item_ += c.grid) { const int item = 1023 - item_;
        asm volatile("" : "+v"(tid));
        const int wave = __builtin_amdgcn_readfirstlane(tid >> 6), lane = tid & 63, fr = lane & 15, q = lane >> 4;
        const int g = item & 7, cidx = (item >> 3) & 63, b = item >> 9; const size_t t0 = (size_t)b * 8192 + cidx * 128;
        load_conv<1>(c, l, b, cidx, g, lds, tid);
#pragma unroll
        for (int k = 0; k < 2; ++k) { const int e = tid + 512 * k, dir = e >> 9, r = (e >> 7) & 3, ll = e & 127, h = 4 * g + r;
            const float delta = softplus_fast(c.dtf[(t0 + ll) * 64 + dir * 32 + h] + c.in[I_DTB][l * 64 + dir * 32 + h]);
            dl[e] = delta; ac[e] = -__expf(c.in[I_ALOG][l * 64 + dir * 32 + h]) * delta; }
        __syncthreads();
        { const float tot = cumsum8(ac, wave, lane); if (lane == 0) c.ssd_tot[(((wave >> 2) * 2 + b) * NC + cidx) * 32 + 4 * g + (wave & 3)] = tot; }
        __syncthreads();
#pragma unroll
        for (int k = 0; k < 2; ++k) { const int e = tid + 512 * k, dir = e >> 9; const float tot = ac[(e & ~127) + (dir ? 0 : 127)]; wv[e] = dl[e] * __expf(tot - ac[e]); }
        __syncthreads();
        {
            const int r = wave & 3, dir = wave >> 2;
            f32x4 acc[8][4];
#pragma unroll
            for (int nt = 0; nt < 8; ++nt)
#pragma unroll
                for (int pt = 0; pt < 4; ++pt) acc[nt][pt] = zero4();
#pragma unroll
            for (int k = 0; k < 4; ++k) {
                const LAS float* wp = wv + (dir * 4 + r) * 128 + 32 * k + 8 * q;
                const f32x4 w0 = *(const LAS f32x4*)wp, w1 = *(const LAS f32x4*)(wp + 4);
                bf16x8 bfrag[4];
#pragma unroll
                for (int pt = 0; pt < 4; ++pt) { const u32x4 x = *(const LAS u32x4*)(lds + XST_OFF + (r * 64 + 16 * pt + fr) * PITCH + (32 * k + 8 * q) * 2);
                    u32x4 y; y.x = cvt_pk_bf16(bflo(x.x) * w0[0], bfhi(x.x) * w0[1]); y.y = cvt_pk_bf16(bflo(x.y) * w0[2], bfhi(x.y) * w0[3]);
                    y.z = cvt_pk_bf16(bflo(x.z) * w1[0], bfhi(x.z) * w1[1]); y.w = cvt_pk_bf16(bflo(x.w) * w1[2], bfhi(x.w) * w1[3]);
                    bfrag[pt] = __builtin_bit_cast(bf16x8, y); }
#pragma unroll
                for (int nt = 0; nt < 8; ++nt) { const bf16x8 af = *(const LAS bf16x8*)(lds + R1_OFF + (16 * nt + fr) * PITCH + (32 * k + 8 * q) * 2);
#pragma unroll
                    for (int pt = 0; pt < 4; ++pt) acc[nt][pt] = __builtin_amdgcn_mfma_f32_16x16x32_bf16(af, bfrag[pt], acc[nt][pt], 0, 0, 0); }
            }
            bf16_t* So = c.ssd_S + st_index(dir, b, cidx, 4 * g + r);
#pragma unroll
            for (int nt = 0; nt < 8; ++nt)
#pragma unroll
                for (int pt = 0; pt < 4; ++pt) { u32x2 o; o.x = cvt_pk_bf16(acc[nt][pt][0], acc[nt][pt][1]); o.y = cvt_pk_bf16(acc[nt][pt][2], acc[nt][pt][3]);
                    *(u32x2*)(So + (size_t)(16 * pt + fr) * 128 + 16 * nt + 4 * q) = o; }
        }
        __syncthreads();
    }
}
__device__ __forceinline__ void phase_s2(const Ctx& c) {
    int tid = threadIdx.x; asm volatile("" : "+v"(tid));
    for (int i = blockIdx.x * NTHREADS + tid; i < 2 * 2 * 32 * 64 * 16; i += c.grid * NTHREADS) {
        const int n8 = i & 15, p = (i >> 4) & 63, h = (i >> 10) & 31, b = (i >> 15) & 1, dir = i >> 16;
        float st[8];
#pragma unroll
        for (int j = 0; j < 8; ++j) st[j] = 0.f;
#pragma unroll 1
        for (int s0 = 0; s0 < NC; s0 += 8) {
            u32x4 x[8]; float dec[8];
#pragma unroll
            for (int u = 0; u < 8; ++u) { const int cidx = dir ? NC - 1 - (s0 + u) : s0 + u;
                x[u] = *(const u32x4*)(c.ssd_S + st_index(dir, b, cidx, h) + p * 128 + n8 * 8); dec[u] = c.ssd_tot[((dir * 2 + b) * NC + cidx) * 32 + h]; }
#pragma unroll
            for (int u = 0; u < 8; ++u) { const int cidx = dir ? NC - 1 - (s0 + u) : s0 + u; const float dq = __expf(dec[u]);
                *(u32x4*)(c.ssd_S + st_index(dir, b, cidx, h) + p * 128 + n8 * 8) = pack8((f32x4){st[0], st[1], st[2], st[3]}, (f32x4){st[4], st[5], st[6], st[7]});
                st[0] = st[0] * dq + bflo(x[u].x); st[1] = st[1] * dq + bfhi(x[u].x); st[2] = st[2] * dq + bflo(x[u].y); st[3] = st[3] * dq + bfhi(x[u].y);
                st[4] = st[4] * dq + bflo(x[u].z); st[5] = st[5] * dq + bfhi(x[u].z); st[6] = st[6] * dq + bflo(x[u].w); st[7] = st[7] * dq + bfhi(x[u].w); }
        }
    }
}
template <bool ZRAW>
__device__ __forceinline__ void phase_s3(const Ctx& c, int l, LAS unsigned char* lds) {
    int tid = threadIdx.x;
    LAS float* acf = (LAS float*)(lds + S3_VEC); LAS float* rcb = acf + 512; LAS float* gf = rcb + 512; LAS float* gb = gf + 512; LAS float* dl = gb + 512; LAS float* ssq = dl + 1024;
    for (int item = blockIdx.x; item < 1024; item += c.grid) {
        asm volatile("" : "+v"(tid));
        const int wave = __builtin_amdgcn_readfirstlane(tid >> 6), lane = tid & 63, fr = lane & 15, q = lane >> 4;
        const int g = item & 7, cidx = (item >> 3) & 63, b = item >> 9; const size_t t0 = (size_t)b * 8192 + cidx * 128;
        const int hrow = tid >> 2, hpart = tid & 3;
        u32x4 hreg[4];
        { const bf16_t* src = c.ssd_S + st_index(hrow >> 6, b, cidx, 4 * g) + (size_t)(hrow & 63) * 128 + hpart * 32;
            hreg[0] = *(const u32x4*)src; hreg[1] = *(const u32x4*)(src + 8); hreg[2] = *(const u32x4*)(src + 16); hreg[3] = *(const u32x4*)(src + 24); }
        load_conv<3>(c, l, b, cidx, g, lds, tid);
#pragma unroll
        for (int k = 0; k < 2; ++k) { const int e = tid + 512 * k, dir = e >> 9, r = (e >> 7) & 3, ll = e & 127, h = 4 * g + r;
            const float delta = softplus_fast(c.dtf[(t0 + ll) * 64 + dir * 32 + h] + c.in[I_DTB][l * 64 + dir * 32 + h]);
            dl[e] = delta; acf[e] = -__expf(c.in[I_ALOG][l * 64 + dir * 32 + h]) * delta; }
        __syncthreads();
        (void)cumsum8(acf, wave, lane);
        __syncthreads();
#pragma unroll
        for (int k = 0; k < 2; ++k) { const int e = tid + 512 * k; gf[e] = __logf(dl[e]) - acf[e]; }
        __syncthreads();
        const int lrow = 16 * wave + fr;
        bf16x8 cfrag[4];
#pragma unroll
        for (int k = 0; k < 4; ++k) cfrag[k] = *(const LAS bf16x8*)(lds + R1_OFF + lrow * PITCH + (32 * k + 8 * q) * 2);
        f32x4 cbt[8];
#pragma unroll
        for (int a = 0; a < 8; ++a) { cbt[a] = zero4();
#pragma unroll
            for (int k = 0; k < 4; ++k) { const bf16x8 bf = *(const LAS bf16x8*)(lds + R2_OFF + (16 * a + fr) * PITCH + (32 * k + 8 * q) * 2);
                cbt[a] = __builtin_amdgcn_mfma_f32_16x16x32_bf16(bf, cfrag[k], cbt[a], 0, 0, 0); } }
        __syncthreads();
        float ssq_l = 0.f;
#pragma unroll 1
        for (int r = 0; r < 4; ++r) {
            const int h = 4 * g + r;
            LAS unsigned char* hb = lds + ((r & 1) ? R1_OFF : R2_OFF);
            { LAS u32x4* dst = (LAS u32x4*)(hb + hrow * PITCH + hpart * 64); dst[0] = hreg[0]; dst[1] = hreg[1]; dst[2] = hreg[2]; dst[3] = hreg[3]; }
            if (r < 3) { const bf16_t* src = c.ssd_S + st_index(hrow >> 6, b, cidx, h + 1) + (size_t)(hrow & 63) * 128 + hpart * 32;
                hreg[0] = *(const u32x4*)src; hreg[1] = *(const u32x4*)(src + 8); hreg[2] = *(const u32x4*)(src + 16); hreg[3] = *(const u32x4*)(src + 24); }
            const size_t trow = t0 + lrow;
            u32x2 zpre[4];
#pragma unroll
            for (int pt = 0; pt < 4; ++pt) zpre[pt] = *(const u32x2*)(c.Zb + trow * 2048 + h * 64 + 16 * pt + 4 * q);
            const float af_l = acf[r * 128 + lrow], rb_l = rcb[r * 128 + lrow], dsk = c.in[I_SSDD][l * 32 + h];
            bf16x8 mfrag[4];
#pragma unroll
            for (int kk = 0; kk < 4; ++kk) {
                float m[8];
#pragma unroll
                for (int half = 0; half < 2; ++half) { const int a = 2 * kk + half, s0 = 16 * a + 4 * q;
                    if (a < wave) {
                        const f32x4 gfv = *(const LAS f32x4*)(gf + r * 128 + s0);
#pragma unroll
                        for (int j = 0; j < 4; ++j) m[half * 4 + j] = cbt[a][j] * __expf(af_l + gfv[j]);
                    } else if (a > wave) {
                        const f32x4 gbv = *(const LAS f32x4*)(gb + r * 128 + s0);
#pragma unroll
                        for (int j = 0; j < 4; ++j) m[half * 4 + j] = cbt[a][j] * __expf(rb_l + gbv[j]);
                    } else {
                        const f32x4 gfv = *(const LAS f32x4*)(gf + r * 128 + s0), gbv = *(const LAS f32x4*)(gb + r * 128 + s0);
#pragma unroll
                        for (int j = 0; j < 4; ++j) { const int s = s0 + j;
                            const float tf = (s <= lrow) ? __expf(af_l + gfv[j]) : 0.f, tb = (s >= lrow) ? __expf(rb_l + gbv[j]) : 0.f;
                            m[half * 4 + j] = cbt[a][j] * (tf + tb) + ((s == lrow) ? dsk : 0.f); } } }
                u32x4 y; y.x = cvt_pk_bf16(m[0], m[1]); y.y = cvt_pk_bf16(m[2], m[3]); y.z = cvt_pk_bf16(m[4], m[5]); y.w = cvt_pk_bf16(m[6], m[7]);
                mfrag[kk] = __builtin_bit_cast(bf16x8, y);
            }
            __syncthreads();
            const float ef = __expf(af_l), eb = __expf(rb_l);
#pragma unroll 1
            for (int ph = 0; ph < 2; ++ph) {
                f32x4 accd[2], accf[2], accb[2];
#pragma unroll
                for (int p2 = 0; p2 < 2; ++p2) { accd[p2] = zero4(); accf[p2] = accd[p2]; accb[p2] = accd[p2]; }
#pragma unroll
                for (int kk = 0; kk < 4; ++kk)
#pragma unroll
                    for (int p2 = 0; p2 < 2; ++p2) { const int pt = 2 * ph + p2;
                        const LAS unsigned char* xr = lds + XST_OFF + (r * 64 + 16 * pt + fr) * PITCH + (32 * kk + 4 * q) * 2;
                        const u32x2 x0 = *(const LAS u32x2*)xr, x1 = *(const LAS u32x2*)(xr + 32);
                        const u32x4 xa = (u32x4){x0.x, x0.y, x1.x, x1.y};
                        accd[p2] = __builtin_amdgcn_mfma_f32_16x16x32_bf16(__builtin_bit_cast(bf16x8, xa), mfrag[kk], accd[p2], 0, 0, 0);
                        const bf16x8 hf = *(const LAS bf16x8*)(hb + (16 * pt + fr) * PITCH + (32 * kk + 8 * q) * 2);
                        const bf16x8 hbk = *(const LAS bf16x8*)(hb + (64 + 16 * pt + fr) * PITCH + (32 * kk + 8 * q) * 2);
                        accf[p2] = __builtin_amdgcn_mfma_f32_16x16x32_bf16(hf, cfrag[kk], accf[p2], 0, 0, 0);
                        accb[p2] = __builtin_amdgcn_mfma_f32_16x16x32_bf16(hbk, cfrag[kk], accb[p2], 0, 0, 0);
                    }
#pragma unroll
                for (int p2 = 0; p2 < 2; ++p2) { const int pt = 2 * ph + p2;
                    const int col = h * 64 + 16 * pt + 4 * q;
                    const u32x2 zw = p2 ? (ph ? zpre[3] : zpre[1]) : (ph ? zpre[2] : zpre[0]);
                    float zz[4] = {bflo(zw.x), bfhi(zw.x), bflo(zw.y), bfhi(zw.y)}, yv[4];
#pragma unroll
                    for (int j = 0; j < 4; ++j) { const float zg = ZRAW ? zz[j] * fast_sigmoid(zz[j]) : zz[j]; yv[j] = (accd[p2][j] + ef * accf[p2][j] + eb * accb[p2][j]) * zg; ssq_l += yv[j] * yv[j]; }
                    u32x2 o; o.x = cvt_pk_bf16(yv[0], yv[1]); o.y = cvt_pk_bf16(yv[2], yv[3]);
                    *(u32x2*)(c.yssdb + trow * 2048 + col) = o;
                }
            }
        }
        ssq[lrow * 4 + q] = ssq_l;
        __syncthreads();
        if (tid < 128) c.ssd_ssq[(t0 + tid) * 8 + g] = (ssq[tid * 4] + ssq[tid * 4 + 1]) + (ssq[tid * 4 + 2] + ssq[tid * 4 + 3]);
        __syncthreads();
    }
}
}
namespace s5 {
constexpr int NROWS = 72 * 1024;
__device__ __forceinline__ void prologue(const Ctx& c, int l, int par, LAS unsigned char* lds, int first_wg, int n_wg, int g0, int g1) {
    int tid = threadIdx.x; asm volatile("" : "+v"(tid));
    LAS float* pw = (LAS float*)lds;
    LAS float* bb = pw + 2 * 17 * 64 * 2;
    LAS float* cc = bb + 2 * 64 * 16 * 2;
    LAS float* Kt = cc + 2 * 16 * 130;
    __syncthreads();
    for (int g = (int)blockIdx.x >= first_wg ? g0 + (int)blockIdx.x - first_wg : g1; g < g1; g += n_wg) {
        if (tid < 128) { const int d = tid >> 6, n = tid & 63;
            const float ar = c.in[I_S5ARE][((size_t)(l * 2 + d) * 72 + g) * 64 + n], ai = c.in[I_S5AIM][((size_t)(l * 2 + d) * 72 + g) * 64 + n];
            const float step = __expf(c.in[I_S5LS][(l * 2 + d) * 72 + g]);
            const float mag = __expf(step * ar); const float abr = mag * __cosf(step * ai), abi = mag * __sinf(step * ai);
            const float rden = __builtin_amdgcn_rcpf(ar * ar + ai * ai); const float fr = ((abr - 1.0f) * ar + abi * ai) * rden, fi = (abi * ar - (abr - 1.0f) * ai) * rden;
            { const float* brp = c.in[I_S5BRE] + (((size_t)l * 72 + g) * 64 + n) * 16; const float* bip = c.in[I_S5BIM] + (((size_t)l * 72 + g) * 64 + n) * 16;
              f32x4 brv[4], biv[4];
#pragma unroll
              for (int q4 = 0; q4 < 4; ++q4) { brv[q4] = *(const f32x4*)(brp + 4 * q4); biv[q4] = *(const f32x4*)(bip + 4 * q4); }
#pragma unroll
              for (int ch = 0; ch < 16; ++ch) { const float br = brv[ch >> 2][ch & 3], bi = biv[ch >> 2][ch & 3];
                  bb[((d * 64 + n) * 16 + ch) * 2] = fr * br - fi * bi; bb[((d * 64 + n) * 16 + ch) * 2 + 1] = fr * bi + fi * br; } }
            float pr = 1.0f, pi = 0.0f;
#pragma clang loop unroll(disable)
            for (int j = 0; j <= 16; ++j) { pw[((d * 17 + j) * 64 + n) * 2] = pr; pw[((d * 17 + j) * 64 + n) * 2 + 1] = pi; const float nr = pr * abr - pi * abi, ni = pr * abi + pi * abr; pr = nr; pi = ni; }
            float* a16 = c.s5_a16 + par * wsz::A16; a16[((g * 2 + d) * 64 + n) * 2] = pw[((d * 17 + 16) * 64 + n) * 2]; a16[((g * 2 + d) * 64 + n) * 2 + 1] = pw[((d * 17 + 16) * 64 + n) * 2 + 1]; }
        for (int i = tid; i < 2 * 16 * 64; i += NTHREADS) { const int d = i >> 10, ch = (i >> 6) & 15, n = i & 63;
            cc[(d * 16 + ch) * 130 + n * 2] = c.in[I_S5CRE][(((size_t)(l * 2 + d) * 72 + g) * 16 + ch) * 64 + n]; cc[(d * 16 + ch) * 130 + n * 2 + 1] = c.in[I_S5CIM][(((size_t)(l * 2 + d) * 72 + g) * 16 + ch) * 64 + n]; }
        __syncthreads();
        { const int lane = tid & 63, wv = __builtin_amdgcn_readfirstlane(tid >> 6), d = wv >> 2, r16 = lane & 15, kq = lane >> 4;
          float bre[16], bim[16];
#pragma unroll
          for (int sidx = 0; sidx < 16; ++sidx) { const LAS float* bp = bb + ((d * 64 + 4 * sidx + kq) * 16 + r16) * 2; bre[sidx] = bp[0]; bim[sidx] = bp[1]; }
#pragma clang loop unroll(disable)
          for (int jj = 0; jj < 4; ++jj) { const int j = 4 * (wv & 3) + jj; f32x4 acc = zero4();
#pragma unroll
              for (int sidx = 0; sidx < 16; ++sidx) { const int n = 4 * sidx + kq;
                  const float cr = cc[(d * 16 + r16) * 130 + n * 2], ci = cc[(d * 16 + r16) * 130 + n * 2 + 1], pr = pw[((d * 17 + j) * 64 + n) * 2], pi = pw[((d * 17 + j) * 64 + n) * 2 + 1];
                  const float wr = cr * pr - ci * pi, wi = cr * pi + ci * pr;
                  acc = __builtin_amdgcn_mfma_f32_16x16x4f32(wr, bre[sidx], acc, 0, 0, 0); acc = __builtin_amdgcn_mfma_f32_16x16x4f32(-wi, bim[sidx], acc, 0, 0, 0); }
#pragma unroll
              for (int r = 0; r < 4; ++r) Kt[((d * 16 + j) * 16 + 4 * kq + r) * 16 + r16] = acc[r]; } }
        __syncthreads();
        bf16_t* W1 = c.s5_W1 + par * wsz::S5W1 + (size_t)g * 512 * 256; bf16_t* Qm = c.s5_Q + par * wsz::S5Q + (size_t)g * 256 * 256;
        for (int i = tid; i < 256 * 256 / 2; i += NTHREADS) { const int row = i >> 7, col = (i & 127) * 2; const int l1 = row >> 4, c1 = row & 15, l2 = col >> 4, c2 = col & 15; float v[2];
#pragma unroll
            for (int e = 0; e < 2; ++e) { float s = 0.f; if (l2 <= l1) s += Kt[((0 * 16 + (l1 - l2)) * 16 + c1) * 16 + c2 + e]; if (l2 >= l1) s += Kt[((1 * 16 + (l2 - l1)) * 16 + c1) * 16 + c2 + e]; v[e] = s; }
            *(unsigned*)(W1 + (size_t)row * 256 + col) = cvt_pk_bf16(v[0], v[1]); }
        for (int i = tid; i < 256 * 256 / 2; i += NTHREADS) { const int row = i >> 7, col = (i & 127) * 2; const int d = row >> 7, part = (row >> 6) & 1, n = row & 63, l2 = col >> 4, c2 = col & 15;
            const int j = d ? l2 : 15 - l2; const float pr = pw[((d * 17 + j) * 64 + n) * 2], pi = pw[((d * 17 + j) * 64 + n) * 2 + 1]; float v[2];
#pragma unroll
            for (int e = 0; e < 2; ++e) { const float br = bb[((d * 64 + n) * 16 + c2 + e) * 2], bi = bb[((d * 64 + n) * 16 + c2 + e) * 2 + 1]; v[e] = part ? (pr * bi + pi * br) : (pr * br - pi * bi); }
            *(unsigned*)(W1 + (size_t)(256 + row) * 256 + col) = cvt_pk_bf16(v[0], v[1]); }
        for (int i = tid; i < 256 * 256 / 2; i += NTHREADS) { const int row = i >> 7, col = (i & 127) * 2; const int l1 = row >> 4, c1 = row & 15, d = col >> 7, part = (col >> 6) & 1, n = col & 63;
            const int j = d ? 16 - l1 : l1 + 1; float v[2];
#pragma unroll
            for (int e = 0; e < 2; ++e) { const float cr = cc[(d * 16 + c1) * 130 + (n + e) * 2], ci = cc[(d * 16 + c1) * 130 + (n + e) * 2 + 1], pr = pw[((d * 17 + j) * 64 + n + e) * 2], pi = pw[((d * 17 + j) * 64 + n + e) * 2 + 1];
                v[e] = part ? -(cr * pi + ci * pr) : (cr * pr - ci * pi); }
            *(unsigned*)(Qm + (size_t)row * 256 + col) = cvt_pk_bf16(v[0], v[1]); }
        __syncthreads();
    }
}
struct Order { int nunits, G, c, lgN, rev, mode;
    __device__ __forceinline__ int late_cnt() const { return (nunits > G && nunits <= 2 * G) ? nunits - G : 0; }
    __device__ __forceinline__ bool next(int i, gx::Unit& u) const {
        long L = (long)i * G + c; const int lc = late_cnt();
        if (mode == 2) { const int g3 = 576 % G, off = (g3 + lc <= G) ? g3 : 0, j = c - off; if (i > 0 || j < 0 || j >= lc) return false; L = G + j; }
        else if (L >= nunits || (mode == 1 && lc > 0 && i > 0)) return false;
        int id = xcd_chunk(L, nunits); if (rev) id = nunits - 1 - id; u.pm = (int)(id >> lgN); u.pn = (int)(id & ((1 << lgN) - 1)); u.e = u.pm >> 2; u.f = (mode == 2) ? 1 : 0; return true; } };
struct Epi1 {
    static constexpr bool PERM = true;
    bf16_t* Y; bf16_t* S;
    __device__ __forceinline__ void operator()(const f32x4 (&acc)[2][2][4][2], const gx::Unit& u, int wr, int wc, int fr, int fq) const {
        const int row0 = u.pm * 256 + wr * 64 + fr, cl = wc * 32 + 8 * fq;
#pragma unroll
        for (int ai = 0; ai < 2; ++ai)
#pragma unroll
            for (int m = 0; m < 4; ++m)
#pragma unroll
                for (int bj = 0; bj < 2; ++bj) { const size_t off = (size_t)(row0 + ai * 128 + m * 16) * 256 + bj * 128 + cl;
                    *(u32x4*)((u.pn == 0 ? Y : S) + off) = pack8(acc[ai][bj][m][0], acc[ai][bj][m][1]); }
    }
};
__device__ __forceinline__ void scan(const Ctx& c, int par, LAS unsigned char* lds) {
    int tid = threadIdx.x; asm volatile("" : "+v"(tid)); const int nl = tid & 31, seg = tid >> 5;
    LAS float* seg_r = (LAS float*)lds; LAS float* seg_i = seg_r + 512;
    __syncthreads();
    for (int item = blockIdx.x; item < 576; item += c.grid) {
        const int nh = item & 1, d = (item >> 1) & 1, b = (item >> 2) & 1, g = item >> 3, n = nh * 32 + nl;
        const float ar = c.s5_a16[par * wsz::A16 + ((g * 2 + d) * 64 + n) * 2], ai = c.s5_a16[par * wsz::A16 + ((g * 2 + d) * 64 + n) * 2 + 1];
        const size_t base = ((size_t)g * 1024 + b * 512) * 256 + d * 128 + n;
        float lr[32], li[32];
#pragma unroll
        for (int j = 0; j < 32; ++j) { const int p = 32 * seg + j; const size_t o = base + (size_t)(d ? 511 - p : p) * 256; lr[j] = bf2f(c.s5_Sloc[o]); li[j] = bf2f(c.s5_Sloc[o + 64]); }
        float sr = 0.f, si = 0.f;
#pragma unroll
        for (int j = 0; j < 32; ++j) { const float nr = ar * sr - ai * si + lr[j], ni = ar * si + ai * sr + li[j]; sr = nr; si = ni; }
        seg_r[seg * 32 + nl] = sr; seg_i[seg * 32 + nl] = si;
        float pr = ar, pi = ai;
#pragma unroll
        for (int q = 0; q < 5; ++q) { const float nr = pr * pr - pi * pi, ni = 2.0f * pr * pi; pr = nr; pi = ni; }
        __syncthreads();
        float cr = 0.f, ci = 0.f;
        for (int s2 = 0; s2 < seg; ++s2) { const float er = seg_r[s2 * 32 + nl], ei = seg_i[s2 * 32 + nl]; const float nr = pr * cr - pi * ci + er, ni = pr * ci + pi * cr + ei; cr = nr; ci = ni; }
        sr = cr; si = ci;
#pragma unroll
        for (int j = 0; j < 32; ++j) { const int p = 32 * seg + j; const size_t o = base + (size_t)(d ? 511 - p : p) * 256;
            c.s5_Sin[o] = (bf16_t)f2bf(sr); c.s5_Sin[o + 64] = (bf16_t)f2bf(si);
            const float nr = ar * sr - ai * si + lr[j], ni = ar * si + ai * sr + li[j]; sr = nr; si = ni; }
        __syncthreads();
    }
}
struct Epi2 {
    static constexpr bool PERM = true;
    const bf16_t* Y; const bf16_t* U; const float* dsk; bf16_t* O; int* done;
    __device__ __forceinline__ void operator()(const f32x4 (&acc)[2][2][4][2], const gx::Unit& u, int wr, int wc, int fr, int fq) const {
        const int row0 = u.pm * 256 + wr * 64 + fr, cl = wc * 32 + 8 * fq, g = u.e, c0 = cl & 15;
        const f32x4 d0 = *(const f32x4*)(dsk + g * 16 + c0), d1 = *(const f32x4*)(dsk + g * 16 + c0 + 4);
#pragma unroll
        for (int ai = 0; ai < 2; ++ai) {
            u32x4 yw[4][2], uw[4][2];
#pragma unroll
            for (int m = 0; m < 4; ++m)
#pragma unroll
                for (int bj = 0; bj < 2; ++bj) { const size_t off = (size_t)(row0 + ai * 128 + m * 16) * 256 + bj * 128 + cl; yw[m][bj] = *(const u32x4*)(Y + off); uw[m][bj] = *(const u32x4*)(U + off); }
#pragma unroll
            for (int m = 0; m < 4; ++m)
#pragma unroll
                for (int bj = 0; bj < 2; ++bj) { const int R = row0 + ai * 128 + m * 16, col = bj * 128 + cl; const int tok = (R & 1023) * 16 + (col >> 4);
                    const u32x4 y4 = yw[m][bj], u4 = uw[m][bj];
                    f32x4 v0 = acc[ai][bj][m][0] + (f32x4){bflo(y4.x), bfhi(y4.x), bflo(y4.y), bfhi(y4.y)} + d0 * (f32x4){bflo(u4.x), bfhi(u4.x), bflo(u4.y), bfhi(u4.y)};
                    f32x4 v1 = acc[ai][bj][m][1] + (f32x4){bflo(y4.z), bfhi(y4.z), bflo(y4.w), bfhi(y4.w)} + d1 * (f32x4){bflo(u4.z), bfhi(u4.z), bflo(u4.w), bfhi(u4.w)};
#pragma unroll
                    for (int j = 0; j < 4; ++j) { const float a = v0[j], bq = v1[j];
                        v0[j] = a * fast_sigmoid(1.5957691216f * (a + 0.044715f * a * a * a)); v1[j] = bq * fast_sigmoid(1.5957691216f * (bq + 0.044715f * bq * bq * bq)); }
                    const u32x4 w = pack8(v0, v1); bf16_t* dst = O + (size_t)tok * 1152 + g * 16 + c0;
                    if (u.f) {
                        __hip_atomic_store((unsigned long long*)dst, (unsigned long long)w.x | ((unsigned long long)w.y << 32), __ATOMIC_RELAXED, __HIP_MEMORY_SCOPE_AGENT);
                        __hip_atomic_store((unsigned long long*)dst + 1, (unsigned long long)w.z | ((unsigned long long)w.w << 32), __ATOMIC_RELAXED, __HIP_MEMORY_SCOPE_AGENT);
                    } else *(u32x4*)dst = w; }
        }
        if (u.f) { asm volatile("s_waitcnt vmcnt(0)" ::: "memory"); if ((fr | fq) == 0) (void)__hip_atomic_fetch_add(done, 1, __ATOMIC_RELAXED, __HIP_MEMORY_SCOPE_AGENT); }
    }
};
}
namespace att {
constexpr int KP = 144, VP = 776;
constexpr int K_OFF = 0, VT_OFF = 384 * KP;
typedef float f32x16 __attribute__((ext_vector_type(16)));
__device__ __forceinline__ f32x16 zero16() { float z = 0.f; asm volatile("" : "+v"(z)); return (f32x16){z, z, z, z, z, z, z, z, z, z, z, z, z, z, z, z}; }
__device__ __forceinline__ void phase(const Ctx& c, LAS unsigned char* lds) {
    int tid = threadIdx.x;
    for (int item = ((int)blockIdx.x + c.grid / 2) % c.grid; item < 1152; item += c.grid) {
        asm volatile("" : "+v"(tid));
        const int wave = __builtin_amdgcn_readfirstlane(tid >> 6), lane = tid & 63, lr = lane & 31, hh = lane >> 5;
        const int itm = 1151 - item;
        const int blk = itm & 31, rest = itm >> 5, h = rest % 6, g = (rest / 6) % 3, b = rest / 18;
        const int dil = g == 0 ? 1 : (g == 1 ? 4 : 16), ls = 8192 / dil, ipc = 32 / dil, r = blk / ipc, i0 = (blk % ipc) * 256;
        const float slope = __builtin_amdgcn_exp2f((float)(h * 3 + g + 1) * (-8.0f / 18.0f)) * (float)dil;
        const bf16_t* qkv = c.QKVU + (size_t)b * 8192 * 4608 + g * 384 + h * 64;
        for (int u = tid; u < 384 * 8; u += NTHREADS) { const int kl = u >> 3, part = u & 7, ik = i0 - 64 + kl;
            u32x4 v = uzero4();
            if (ik >= 0 && ik < ls) v = *(const u32x4*)(qkv + (size_t)(ik * dil + r) * 4608 + 1152 + part * 8);
            *(LAS u32x4*)(lds + K_OFF + kl * KP + part * 16) = v; }
        for (int u = tid; u < 192 * 8; u += NTHREADS) { const int part = u / 192, kp = u % 192, ik = i0 - 64 + 2 * kp;
            u32x4 v0 = uzero4(), v1 = v0;
            if (ik >= 0 && ik < ls) v0 = *(const u32x4*)(qkv + (size_t)(ik * dil + r) * 4608 + 2304 + part * 8);
            if (ik + 1 >= 0 && ik + 1 < ls) v1 = *(const u32x4*)(qkv + (size_t)((ik + 1) * dil + r) * 4608 + 2304 + part * 8);
            LAS unsigned char* dst = lds + VT_OFF + (part * 8) * VP + kp * 4;
            *(LAS unsigned*)(dst + 0 * VP) = (v0.x & 0xffffu) | (v1.x << 16); *(LAS unsigned*)(dst + 1 * VP) = (v0.x >> 16) | (v1.x & 0xffff0000u);
            *(LAS unsigned*)(dst + 2 * VP) = (v0.y & 0xffffu) | (v1.y << 16); *(LAS unsigned*)(dst + 3 * VP) = (v0.y >> 16) | (v1.y & 0xffff0000u);
            *(LAS unsigned*)(dst + 4 * VP) = (v0.z & 0xffffu) | (v1.z << 16); *(LAS unsigned*)(dst + 5 * VP) = (v0.z >> 16) | (v1.z & 0xffff0000u);
            *(LAS unsigned*)(dst + 6 * VP) = (v0.w & 0xffffu) | (v1.w << 16); *(LAS unsigned*)(dst + 7 * VP) = (v0.w >> 16) | (v1.w & 0xffff0000u); }
        const int q0 = 32 * wave, iq = i0 + q0 + lr;
        const size_t tq = (size_t)(iq * dil + r);
        bf16x8 qf[4];
#pragma unroll
        for (int ks = 0; ks < 4; ++ks) qf[ks] = *(const bf16x8*)(qkv + tq * 4608 + 16 * ks + 8 * hh);
        __syncthreads();
        f32x16 st[5];
#pragma unroll
        for (int kt = 0; kt < 5; ++kt) { st[kt] = zero16();
#pragma unroll
            for (int ks = 0; ks < 4; ++ks) { const bf16x8 kf = *(const LAS bf16x8*)(lds + K_OFF + (q0 + 32 * kt + lr) * KP + (16 * ks + 8 * hh) * 2);
                st[kt] = __builtin_amdgcn_mfma_f32_32x32x16_bf16(kf, qf[ks], st[kt], 0, 0, 0); } }
        float mx = -1e30f;
        int dlt = 4 * hh - lr; asm volatile("" : "+v"(dlt));
        const int ikb = i0 - 64 + q0 + 4 * hh;
#pragma unroll
        for (int kt = 0; kt < 5; ++kt)
#pragma unroll
            for (int reg = 0; reg < 16; ++reg) { const int kc = 32 * kt + (reg & 3) + 8 * (reg >> 2);
                const int d = kc - 64 + dlt, dist = d < 0 ? -d : d, ik = ikb + kc;
                const bool ok = dist <= 64 && ik >= 0 && ik < ls;
                const float s = ok ? st[kt][reg] * 0.125f - slope * (float)dist : -1e30f;
                st[kt][reg] = s; mx = fmaxf(mx, s); }
        mx = fmaxf(mx, __int_as_float(__builtin_amdgcn_ds_bpermute((lane ^ 32) << 2, __float_as_int(mx))));
        float sum = 0.f;
#pragma unroll
        for (int kt = 0; kt < 5; ++kt)
#pragma unroll
            for (int reg = 0; reg < 16; ++reg) { const float p = st[kt][reg] > -1e29f ? __expf(st[kt][reg] - mx) : 0.f; st[kt][reg] = p; sum += p; }
        sum += __int_as_float(__builtin_amdgcn_ds_bpermute((lane ^ 32) << 2, __float_as_int(sum)));
        f32x16 o[2];
#pragma unroll
        for (int dt = 0; dt < 2; ++dt) o[dt] = zero16();
#pragma unroll
        for (int kt = 0; kt < 5; ++kt)
#pragma unroll
            for (int s2 = 0; s2 < 2; ++s2) {
                u32x4 pw; pw.x = cvt_pk_bf16(st[kt][8 * s2 + 0], st[kt][8 * s2 + 1]); pw.y = cvt_pk_bf16(st[kt][8 * s2 + 2], st[kt][8 * s2 + 3]);
                pw.z = cvt_pk_bf16(st[kt][8 * s2 + 4], st[kt][8 * s2 + 5]); pw.w = cvt_pk_bf16(st[kt][8 * s2 + 6], st[kt][8 * s2 + 7]);
                const bf16x8 pf = __builtin_bit_cast(bf16x8, pw);
#pragma unroll
                for (int dt = 0; dt < 2; ++dt) { const LAS unsigned char* vp = lds + VT_OFF + (32 * dt + lr) * VP + (q0 + 32 * kt + 16 * s2 + 4 * hh) * 2;
                    const u32x2 a0 = *(const LAS u32x2*)vp, a1 = *(const LAS u32x2*)(vp + 16);
                    const u32x4 av = (u32x4){a0.x, a0.y, a1.x, a1.y};
                    o[dt] = __builtin_amdgcn_mfma_f32_32x32x16_bf16(__builtin_bit_cast(bf16x8, av), pf, o[dt], 0, 0, 0); }
            }
        const float inv = __builtin_amdgcn_rcpf(sum); const size_t tglob = (size_t)b * 8192 + tq;
        bf16_t* op = c.attob + ((size_t)g * 16384 + tglob) * 384 + h * 64;
#pragma unroll
        for (int dt = 0; dt < 2; ++dt)
#pragma unroll
            for (int rg = 0; rg < 4; ++rg) { u32x2 w; w.x = cvt_pk_bf16(o[dt][4 * rg + 0] * inv, o[dt][4 * rg + 1] * inv); w.y = cvt_pk_bf16(o[dt][4 * rg + 2] * inv, o[dt][4 * rg + 3] * inv);
                *(u32x2*)(op + 32 * dt + 8 * rg + 4 * hh) = w; }
        if (hh == 0) c.attlse[((size_t)g * 16384 + tglob) * 6 + h] = mx + __logf(sum);
        __syncthreads();
    }
}
__device__ __forceinline__ void combine(const Ctx& c, long i) {
    const int c8 = (int)(i % 48); const long t = i / 48; const int h = c8 >> 3;
    const float l0 = c.attlse[((size_t)0 * 16384 + t) * 6 + h], l1 = c.attlse[((size_t)1 * 16384 + t) * 6 + h], l2 = c.attlse[((size_t)2 * 16384 + t) * 6 + h];
    const float m = fmaxf(l0, fmaxf(l1, l2)); float w0 = __expf(l0 - m), w1 = __expf(l1 - m), w2 = __expf(l2 - m); const float inv = __builtin_amdgcn_rcpf(w0 + w1 + w2); w0 *= inv; w1 *= inv; w2 *= inv;
    const u32x4 a = *(const u32x4*)(c.attob + ((size_t)0 * 16384 + t) * 384 + c8 * 8), bq = *(const u32x4*)(c.attob + ((size_t)1 * 16384 + t) * 384 + c8 * 8), cq = *(const u32x4*)(c.attob + ((size_t)2 * 16384 + t) * 384 + c8 * 8);
    f32x4 v0, v1;
    v0[0] = w0 * bflo(a.x) + w1 * bflo(bq.x) + w2 * bflo(cq.x); v0[1] = w0 * bfhi(a.x) + w1 * bfhi(bq.x) + w2 * bfhi(cq.x);
    v0[2] = w0 * bflo(a.y) + w1 * bflo(bq.y) + w2 * bflo(cq.y); v0[3] = w0 * bfhi(a.y) + w1 * bfhi(bq.y) + w2 * bfhi(cq.y);
    v1[0] = w0 * bflo(a.z) + w1 * bflo(bq.z) + w2 * bflo(cq.z); v1[1] = w0 * bfhi(a.z) + w1 * bfhi(bq.z) + w2 * bfhi(cq.z);
    v1[2] = w0 * bflo(a.w) + w1 * bflo(bq.w) + w2 * bflo(cq.w); v1[3] = w0 * bfhi(a.w) + w1 * bfhi(bq.w) + w2 * bfhi(cq.w);
    *(u32x4*)(c.yattb + t * 384 + c8 * 8) = pack8(v0, v1);
}
}
namespace lnr {
constexpr int XP = 1028;
constexpr int PART_OFF = 16 * XP * 4, CNT_OFF = PART_OFF + 8 * 16 * 32 * 4, GB_OFF = CNT_OFF + 128;
__device__ __forceinline__ void phase(const Ctx& c, int l, LAS unsigned char* lds) {
    int tid = threadIdx.x; asm volatile("" : "+v"(tid)); const int wave = __builtin_amdgcn_readfirstlane(tid >> 6), lane = tid & 63;
    const bf16_t* xin = c.xbf;
    LAS float* xf = (LAS float*)lds; LAS float* part = (LAS float*)(lds + PART_OFF); LAS int* cnt_l = (LAS int*)(lds + CNT_OFF);
    float wreg[2][32];
    { const float* rw = c.in[I_RW] + (size_t)l * 1024 * 32 + (size_t)(128 * wave + 4 * (lane >> 4)) * 32 + (lane & 15);
#pragma unroll
      for (int s4 = 0; s4 < 8; ++s4)
#pragma unroll
        for (int i = 0; i < 4; ++i) { wreg[0][4 * s4 + i] = rw[(16 * s4 + i) * 32]; wreg[1][4 * s4 + i] = rw[(16 * s4 + i) * 32 + 16]; } }
    LAS float* gb = (LAS float*)(lds + GB_OFF);
    __syncthreads();
    for (int i = tid; i < 1024; i += NTHREADS) { gb[i] = c.in[I_LN1G][l * 1024 + i]; gb[1024 + i] = c.in[I_LN1B][l * 1024 + i]; }
    const float rbias = c.in[I_RB][l * 32 + (lane & 31)];
    __syncthreads();
    float xn[16], mn[16];
#define LNR_LOAD(tok) do { const size_t b0_ = (size_t)(tok) * 1024 + 4 * lane; _Pragma("unroll") for (int jq = 0; jq < 4; ++jq) { const u32x2 xv = *(const u32x2*)(xin + b0_ + 256 * jq), mv = *(const u32x2*)(c.mixb + b0_ + 256 * jq); \
        xn[4 * jq] = bflo(xv.x); xn[4 * jq + 1] = bfhi(xv.x); xn[4 * jq + 2] = bflo(xv.y); xn[4 * jq + 3] = bfhi(xv.y); mn[4 * jq] = bflo(mv.x); mn[4 * jq + 1] = bfhi(mv.x); mn[4 * jq + 2] = bflo(mv.y); mn[4 * jq + 3] = bfhi(mv.y); } } while (0)
    if ((int)blockIdx.x < ox_T / 64) LNR_LOAD(blockIdx.x * 64 + wave * 2);
#pragma unroll 1
    for (int gi = blockIdx.x; gi < ox_T / 64; gi += c.grid) {
      if (tid < 32) cnt_l[tid] = 0;
#pragma unroll 1
      for (int q = 0; q < 4; ++q) {
        int tid2 = tid; asm volatile("" : "+v"(tid2)); const int lane = tid2 & 63;
#pragma unroll 1
        for (int tt = 0; tt < 2; ++tt) {
          const int t = gi * 64 + 16 * q + 2 * wave + tt;
          float x[16];
          const size_t base = (size_t)t * 1024 + 4 * lane; float s = 0.f;
#pragma unroll
          for (int j = 0; j < 16; ++j) { x[j] = md::ALPHA * xn[j] + mn[j]; s += x[j]; }
          { const int tn = tt == 0 ? t + 1 : (q < 3 ? t + 15 : (gi + c.grid < ox_T / 64 ? (gi + c.grid) * 64 + 2 * wave : t)); LNR_LOAD(tn); }
          const float mean = wave_sum(s) * (1.0f / 1024.0f); float qq = 0.f;
#pragma unroll
          for (int j = 0; j < 16; ++j) { x[j] -= mean; qq += x[j] * x[j]; }
          float eps_ = md::EPS; asm volatile("" : "+v"(eps_));
          const float rstd = __builtin_amdgcn_rsqf(wave_sum(qq) * (1.0f / 1024.0f) + eps_);
          LAS float* xrow = xf + (2 * wave + tt) * XP + 4 * lane;
#pragma unroll
          for (int jq = 0; jq < 4; ++jq) { const f32x4 g4 = *(const LAS f32x4*)(gb + 4 * lane + 256 * jq), b4 = *(const LAS f32x4*)(gb + 1024 + 4 * lane + 256 * jq);
              f32x4 y; y[0] = x[4 * jq] * rstd * g4[0] + b4[0]; y[1] = x[4 * jq + 1] * rstd * g4[1] + b4[1]; y[2] = x[4 * jq + 2] * rstd * g4[2] + b4[2]; y[3] = x[4 * jq + 3] * rstd * g4[3] + b4[3];
              u32x2 w; w.x = cvt_pk_bf16(y[0], y[1]); w.y = cvt_pk_bf16(y[2], y[3]);
              *(u32x2*)(c.x1b + base + 256 * jq) = w; *(unsigned*)(c.x1q + base + 256 * jq) = pk4_fp8(y[0], y[1], y[2], y[3]);
              *(LAS f32x4*)(xrow + 256 * jq) = y; }
        }
        __syncthreads();
        {
            f32x4 acc0 = zero4(), acc1 = zero4();
            const LAS float* ap = xf + (lane & 15) * XP + 128 * wave + 4 * (lane >> 4);
#pragma unroll
            for (int s4 = 0; s4 < 8; ++s4) { const f32x4 av = *(const LAS f32x4*)(ap + 16 * s4);
#pragma unroll
                for (int i = 0; i < 4; ++i) { acc0 = __builtin_amdgcn_mfma_f32_16x16x4f32(av[i], wreg[0][4 * s4 + i], acc0, 0, 0, 0); acc1 = __builtin_amdgcn_mfma_f32_16x16x4f32(av[i], wreg[1][4 * s4 + i], acc1, 0, 0, 0); } }
            LAS float* pp = part + (wave * 16 + 4 * (lane >> 4)) * 32 + (lane & 15);
#pragma unroll
            for (int r = 0; r < 4; ++r) { pp[r * 32] = acc0[r]; pp[r * 32 + 16] = acc1[r]; }
        }
        __syncthreads();
        {
            const int tl = 2 * wave + (lane >> 5), t = gi * 64 + 16 * q + tl;
            float v1 = rbias;
#pragma unroll
            for (int w2 = 0; w2 < 8; ++w2) v1 += part[(w2 * 16 + tl) * 32 + (lane & 31)];
            float tv[4]; int ti[4]; float neg_ = -3.0e38f; asm volatile("" : "+v"(neg_));
#pragma unroll
            for (int k = 0; k < 4; ++k) {
                float m = v1;
                m = fmaxf(m, SWZ_XOR(m, 1)); m = fmaxf(m, SWZ_XOR(m, 2)); m = fmaxf(m, SWZ_XOR(m, 4)); m = fmaxf(m, SWZ_XOR(m, 8)); m = fmaxf(m, SWZ_XOR(m, 16));
                const unsigned long long mask = __ballot(v1 == m);
                const unsigned mh = (unsigned)(mask >> (lane & 32));
                const int first = __builtin_ctz(mh);
                tv[k] = m; ti[k] = first;
                if ((lane & 31) == first) v1 = neg_;
            }
            const float e1 = __expf(tv[1] - tv[0]), e2 = __expf(tv[2] - tv[0]), e3 = __expf(tv[3] - tv[0]); const float inv = __builtin_amdgcn_rcpf(1.0f + e1 + e2 + e3);
            const int kk = lane & 31;
            if (kk < 4) { const int te = kk == 0 ? ti[0] : (kk == 1 ? ti[1] : (kk == 2 ? ti[2] : ti[3]));
                c.gate[t * 4 + kk] = (kk == 0 ? 1.0f : (kk == 1 ? e1 : (kk == 2 ? e2 : e3))) * inv; c.topidx[t * 4 + kk] = te; atomicAdd((int*)(cnt_l + te), 1); }
        }
      }
      __syncthreads();
      if (tid < 32) c.moe_cnt[gi * 32 + tid] = cnt_l[tid];
      __syncthreads();
    }
}
#undef LNR_LOAD
}
#endif
typedef const __attribute__((address_space(4))) Ctx* CtxK;
#if defined(__HIP_DEVICE_COMPILE__)
__device__ __forceinline__ const Ctx* ctx_ptr() { CtxK p = (CtxK)__builtin_amdgcn_kernarg_segment_ptr(); asm volatile("" : "+s"(p)); return (const Ctx*)p; }
#endif
#define PH(...) do { const Ctx& c = *ctx_ptr(); __VA_ARGS__ } while (0)

#define RUN(bit, ...) do { PH(__VA_ARGS__); if (REPMASK & (1u << (bit))) PH(__VA_ARGS__); } while (0)
#define LDSP ((LAS unsigned char*)lds)
#ifndef NCV
#define NCV 0
#endif

__global__ void __launch_bounds__(NTHREADS, 2) mk_forward(Ctx cparam) {
#if defined(__HIP_DEVICE_COMPILE__)
    extern __shared__ __attribute__((aligned(16))) unsigned char lds[];
    volatile LAS unsigned* bst = (volatile LAS unsigned*)((LAS unsigned char*)lds + LDS_BYTES - 16);
    if (threadIdx.x == 0) { bst[0] = 0u; bst[1] = 0u; bst[2] = 0u; bst[3] = 0u; }
    __syncthreads();
    XcdBarrier bar = xcd_barrier_post(ctx_ptr()->bar, bst);
    const long T = ox_T; const int depth = ctx_ptr()->depth;
    for (int l = -1; l < depth; ++l) {
        const int par = l & 1;
        if (l >= 0) RUN(0, prologue_weights<false, true>(c, l, par, LDSP, 0, c.grid); );
        else PH( LOOP(T * 128, cvt_x8(c.in[I_X], c.xbf, i)); const u32x4 z4 = uzero4(); LOOP(128, *(u32x4*)(c.x1b + (size_t)ox_T * 1024 + i * 8) = z4); LOOP(1, c.moe_done[320] = 0); LOOP(64, *(u32x4*)(c.x1q + (size_t)ox_T * 1024 + i * 16) = z4); );
        if (l + 1 < depth) { RUN(0, prologue_weights<true, false>(c, l + 1, par ^ 1, LDSP, 0, c.grid); ); RUN(0, const bool sp = (l >= 0 && c.grid == 256);
                                 s5::prologue(c, l + 1, par ^ 1, LDSP, sp ? 192 : (c.grid >= 72 ? c.grid - 72 : 0), sp ? 64 : (c.grid >= 72 ? 72 : c.grid), 0, sp ? 0 : 72); ); }
        if (l >= 0) {
            PH( __syncthreads(); );
            RUN(1, gx::Gemm g{c.xbf, c.Win_t + par * wsz::WIN, 1024, 0}; gx::StaticOrder S; S.init(ox_T, 14080, c.grid, (int)blockIdx.x);
                   EpiInproj<false, true> E{c.Gb, c.Zb, c.XBCb, c.QKVU, c.dtf, c.in[I_BGATE] + (size_t)l * 3072, c.Ug};
                   gx::gemm_phase(LDSP, g, S, E); );
        }
        SYNC();
        if (l < 0) continue;
        RUN(3, att::phase(c, LDSP); );
        RUN(4, gx::Gemm g{c.Ug, c.s5_W1 + par * wsz::S5W1, 256, (size_t)512 * 256 * 2}; s5::Order S{576, c.grid, (int)blockIdx.x, 1, 1}; s5::Epi1 E{c.s5_Yl, c.s5_Sloc}; gx::gemm_phase(LDSP, g, S, E); );
        RUN(2, ssd::phase_s1(c, l, LDSP); );
        SYNC();
        RUN(5, s5::scan(c, par, LDSP); );
        RUN(5, LOOP(T * 48, att::combine(c, i)); );
        PH( ssd::phase_s2(c); );
        SYNC();
        RUN(6, ssd::phase_s3<true>(c, l, LDSP); );
#pragma clang loop unroll(disable)
        for (int ps = 1; ps <= 2; ++ps) {
            if (ps == 2) SYNC();
            PH( gx::Gemm g{c.s5_Sin, c.s5_Q + par * wsz::S5Q, 256, (size_t)256 * 256 * 2}; s5::Order S{288, c.grid, (int)blockIdx.x, 0, 0, ps}; s5::Epi2 E{c.s5_Yl, c.Ug, c.in[I_S5D] + (size_t)l * 1152, c.s5hb, c.moe_done + 320}; gx::gemm_phase(LDSP, g, S, E); );
        }
        if (l + 1 < depth && ctx_ptr()->grid == 256) PH( s5::prologue(c, l + 1, par ^ 1, LDSP, 96, 72, 0, 72); );
        RUN(9, gx::Gemm g{c.yssdb, c.Wbs_t + par * wsz::WBS, 2048, 0}; gx::StaticOrder S; S.init(ox_T, 1024, c.grid, (int)blockIdx.x); EpiBranch<0> E{c.Gb, c.mergedb, c.ssd_ssq}; gx::gemm_phase(LDSP, g, S, E); );
        PH( gx::Gemm g{c.yattb, c.Wba_t + par * wsz::WBA, 384, 0}; gx::StaticOrder S; S.init(ox_T, 1024, c.grid, (int)blockIdx.x); EpiBranch<1> E{c.Gb, c.mergedb, nullptr}; gx::gemm_phase(LDSP, g, S, E); );
        PH( const s5::Order S2{288, c.grid, (int)blockIdx.x, 0, 0, 2}; moe_wait_rows(c.moe_done, 320, (l + 1) * S2.late_cnt() * 8); );
        RUN(8, gx::Gemm g{c.s5hb, c.Wglu_t + par * wsz::WGLU, 1152, 0}; gx::StaticOrder S; S.init(ox_T, 2304, c.grid, (int)blockIdx.x); EpiGlu E{c.ys5b}; gx::gemm_phase(LDSP, g, S, E); );
        SYNC();
        RUN(10, gx::Gemm g{c.ys5b, c.Wb5_t + par * wsz::WB5, 1152, 0}; gx::StaticOrder S; S.init(ox_T, 1024, c.grid, (int)blockIdx.x); EpiBranch<2> E{c.Gb, c.mergedb, nullptr}; gx::gemm_phase(LDSP, g, S, E); );
        SYNC();
        RUN(11, gx::Gemm g{c.mergedb, c.Wout_t + par * wsz::WOUT, 1024, 0}; gx::StaticOrder S; S.init(ox_T, 1024, c.grid, (int)blockIdx.x); EpiBf16 E{c.mixb}; gx::gemm_phase(LDSP, g, S, E); );
        SYNC();
        RUN(12, lnr::phase(c, l, LDSP); );
        SYNC();
        RUN(13, moe_assign(c, LDSP); );
        SYNC();
        RUN(14, const int nb = moe_blocks(c, LDSP); int M, fi; moe_early(nb, c.grid, M, fi); gx::Gemm g{(const bf16_t*)c.x1q, c.Wgu_t, 512, (size_t)2048 * 1024};
                MoeOrder S{(const LAS int*)(LDSP + LDS_TAB), nb * 8, c.grid, (int)blockIdx.x, 3, 0, nb, M, fi};
                EpiSwiglu E{(unsigned char*)c.actb, c.in[I_BGU] + (size_t)l * 32 * 2048, c.moe_done}; gx::gemm_phase<EpiSwiglu, MoeOrder, true, true>(LDSP, g, S, E, c.slot_tok); );
#pragma clang loop unroll(disable)
        for (int ps = 1; ps <= 2; ++ps) {
            if (ps == 2) SYNC();
            RUN(15, const int nb = moe_blocks(c, LDSP); int M, fi; moe_early(nb, c.grid, M, fi); gx::Gemm g{c.actb, c.Wdn_t, 512, (size_t)1024 * 1024};
                    MoeOrder S{(const LAS int*)(LDSP + LDS_TAB), (nb - 8 * M) * 4, c.grid, (int)blockIdx.x, 2, ps, nb, M, fi};
                    gx::Unit u0; if (ps == 1 && S.next(0, u0)) moe_wait_rows(c.moe_done, u0.pm);
                    EpiDown E{c.ys2, c.in[I_BDN] + (size_t)l * 32 * 1024, c.slot_gate}; gx::gemm_phase<EpiDown, MoeOrder, false, true>(LDSP, g, S, E); );
        }
        SYNC();
        RUN(16, moe_combine_ln(c, c.in[I_LN2G] + l * 1024, c.in[I_LN2B] + l * 1024, (l == depth - 1) ? c.out : nullptr); );
        SYNC();
    }
#endif
}

extern "C" void kernel_launch(void* const* d_in, const int* in_sizes, int n_in, void* d_out, int out_size, void* d_ws, size_t ws_size, hipStream_t stream) {
    static int grid = 0;
    Ctx c;
    const size_t need = build_ctx(c, d_in, d_out, d_ws, 4);
    if (grid == 0) {
        if (n_in != N_INPUTS || out_size != 2 * 8192 * 1024 || ws_size < need) { fprintf(stderr, "kernel_launch: unexpected shapes (n_in %d out %d ws %zu need %zu)\n", n_in, out_size, ws_size, need); grid = -1; return; }
        int dev = 0, cus = 0, per_cu = 0;
        (void)hipGetDevice(&dev); (void)hipDeviceGetAttribute(&cus, hipDeviceAttributeMultiprocessorCount, dev);
        if (hipFuncSetAttribute((const void*)mk_forward, hipFuncAttributeMaxDynamicSharedMemorySize, LDS_BYTES) != hipSuccess) { fprintf(stderr, "kernel_launch: hipFuncSetAttribute failed\n"); grid = -1; return; }
        if (hipOccupancyMaxActiveBlocksPerMultiprocessor(&per_cu, (const void*)mk_forward, NTHREADS, LDS_BYTES) != hipSuccess || per_cu < 1) { fprintf(stderr, "kernel_launch: occupancy query says %d\n", per_cu); grid = -1; return; }
        (void)hipGetLastError();
        grid = cus;
    }
    if (grid < 0) return;
    c.grid = grid;
    (void)hipMemsetAsync(c.bar, 0, 16384, stream);
    hipLaunchKernelGGL(mk_forward, dim3(grid), dim3(NTHREADS), LDS_BYTES, stream, c);
}
```

```cpp
#include <hip/hip_runtime.h>
#include <cstdio>
#include <cstdint>
#include <cstring>
#include <cmath>

#ifndef REPMASK
#define REPMASK 0u
#endif

namespace md {
constexpr int D = 1024, NIN = 13888;
constexpr int C_GATE = 0, C_Z = 3072, C_XBC = 5120, C_DT = 9216, C_QKV = 9280, C_U = 12736;
constexpr int SSD_IN = 2048, SSD_CC = 4096, NH = 32, HP = 64, NG = 8, NS = 128;
constexpr int ATT_W = 1152, ATT_O = 384;
constexpr int S5W = 1152, S5G = 72, S5C = 16, S5N = 64;
constexpr int NE = 32, TOPK = 4, FF = 1024;
constexpr float ALPHA = 1.681792830507429f;
constexpr float EPS = 1e-5f;
}

enum { I_X = 0, I_WIN, I_BGATE, I_CONVW, I_CONVB, I_ALOG, I_DTB, I_SSDD, I_NORMW, I_S5ARE, I_S5AIM, I_S5LS, I_S5BRE, I_S5BIM,
       I_S5CRE, I_S5CIM, I_S5D, I_GLU1, I_GLU2, I_WBSSD, I_WBATT, I_WBS5, I_WOUT, I_LN1G, I_LN1B, I_RW, I_RB, I_WGU, I_BGU,
       I_WDN, I_BDN, I_LN2G, I_LN2B, N_INPUTS };

struct Ctx {
    const float* in[N_INPUTS];
    float* out;
    float *attlse, *gate; unsigned short* mixb;
    int *topidx, *tok_slot;
    unsigned* bar;
    unsigned short *Win_t, *Wglu_t, *Wbs_t, *Wba_t, *Wb5_t, *Wout_t, *Wgu_t, *Wdn_t;
    unsigned short *xbf, *Gb, *Zb, *XBCb, *QKVU; float* dtf;
    unsigned short *yssdb, *yattb, *s5hb, *ys5b, *mergedb;
    unsigned short *x1b, *actb, *ys2; float* slot_gate; int *moe_cnt, *moe_pstart, *slot_tok, *moe_done; unsigned char* x1q;
    unsigned short* ssd_S; float *ssd_tot, *ssd_ssq;
    unsigned short* attob;
    unsigned short *Ug, *s5_W1, *s5_Q, *s5_Yl, *s5_Sin, *s5_Sloc; float* s5_a16;
    int depth, grid;
};

namespace wsz { constexpr size_t WIN = (size_t)14080 * 1024, WGLU = (size_t)2304 * 1152, WBS = (size_t)1024 * 2048, WBA = (size_t)1024 * 384, WB5 = (size_t)1024 * 1152, WOUT = (size_t)1024 * 1024,
    S5W1 = (size_t)72 * 512 * 256, S5Q = (size_t)72 * 256 * 256, A16 = 72 * 2 * 64 * 2; }
static inline size_t align_up(size_t x) { return (x + 255) & ~(size_t)255; }
static size_t build_ctx(Ctx& c, void* const* d_in, void* d_out, void* d_ws, int depth) {
    memset(&c, 0, sizeof(c));
    for (int i = 0; i < N_INPUTS; ++i) c.in[i] = (const float*)d_in[i];
    c.out = (float*)d_out; c.depth = depth;
    char* w = (char*)d_ws; size_t off = 0; const size_t T = 16384;
    auto take = [&](size_t bytes) { char* p = w + off; off = align_up(off + bytes); return p; };
    c.bar = (unsigned*)take(16384);
    c.attlse = (float*)take(3 * T * 6 * 4); c.mixb = (unsigned short*)take(T * 1024 * 2);
    c.gate = (float*)take(T * 4 * 4); c.topidx = (int*)take(T * 4 * 4); c.tok_slot = (int*)take(T * 4 * 4);
    c.Win_t = (unsigned short*)take(2 * wsz::WIN * 2); c.Wglu_t = (unsigned short*)take(2 * wsz::WGLU * 2); c.Wbs_t = (unsigned short*)take(2 * wsz::WBS * 2);
    c.Wba_t = (unsigned short*)take(2 * wsz::WBA * 2); c.Wb5_t = (unsigned short*)take(2 * wsz::WB5 * 2); c.Wout_t = (unsigned short*)take(2 * wsz::WOUT * 2);
    c.Wgu_t = (unsigned short*)take((size_t)32 * 2048 * 1024 * 2); c.Wdn_t = (unsigned short*)take((size_t)32 * 1024 * 1024 * 2);
    c.xbf = (unsigned short*)take(T * 1024 * 2); c.Gb = (unsigned short*)take(T * 3072 * 2); c.Zb = (unsigned short*)take(T * 2048 * 2); c.XBCb = (unsigned short*)take(T * 4096 * 2);
    c.QKVU = (unsigned short*)take(T * 4608 * 2); c.dtf = (float*)take(T * 64 * 4);
    c.x1b = (unsigned short*)take((size_t)(T + 1) * 1024 * 2); c.slot_tok = (int*)take(73728 * 4); c.actb = (unsigned short*)take((size_t)73728 * 1024 * 2); c.ys2 = (unsigned short*)take((size_t)73728 * 1024 * 2);
    c.slot_gate = (float*)take(73728 * 4); c.moe_cnt = (int*)take(8192 * 4); c.moe_pstart = (int*)take(256); c.moe_done = (int*)take(2048); c.x1q = (unsigned char*)take((size_t)(T + 1) * 1024);
    c.ssd_S = (unsigned short*)take((size_t)2 * 2 * 64 * 32 * 8192 * 2); c.ssd_tot = (float*)take(2 * 2 * 64 * 32 * 4); c.ssd_ssq = (float*)take(T * 8 * 4);
    c.attob = (unsigned short*)take(3 * T * 384 * 2);
    c.Ug = (unsigned short*)take(T * 1152 * 2); c.s5_W1 = (unsigned short*)take(2 * wsz::S5W1 * 2); c.s5_Q = (unsigned short*)take(2 * wsz::S5Q * 2);
    c.s5_Yl = (unsigned short*)take((size_t)73728 * 256 * 2); c.s5_Sin = (unsigned short*)take((size_t)73728 * 256 * 2); c.s5_Sloc = (unsigned short*)take((size_t)73728 * 256 * 2); c.s5_a16 = (float*)take(2 * wsz::A16 * 4);
    c.yssdb = (unsigned short*)take(T * 2048 * 2); c.yattb = (unsigned short*)take(T * 384 * 2); c.s5hb = (unsigned short*)take(T * 1152 * 2); c.ys5b = (unsigned short*)take(T * 1152 * 2); c.mergedb = (unsigned short*)take(T * 1024 * 2);
    return off;
}

#define XB_TMO      128
#define XB_XCNT(j)  (256  + 64 * (j))
#define XB_XSUB(j)  (1280 + 64 * (j))
#define XB_XGEN(j)  (2304 + 64 * (j))
#define XB_TOP      3328
#define XB_TOPGEN   3392
#define XCD_BAR_WORDS 3456
#define XB_SPIN_CAP (1u << 18)
#define LAS __attribute__((address_space(3)))

__device__ __forceinline__ unsigned xb_ld(unsigned* p)              { return __hip_atomic_load(p, __ATOMIC_RELAXED, __HIP_MEMORY_SCOPE_AGENT); }
__device__ __forceinline__ unsigned xb_add(unsigned* p, unsigned v) { return __hip_atomic_fetch_add(p, v, __ATOMIC_RELAXED, __HIP_MEMORY_SCOPE_AGENT); }
__device__ __forceinline__ unsigned xb_xcc_id() { return (unsigned)__builtin_amdgcn_s_getreg((3 << 11) | 20) & 0xFu; }
#define XB_SPIN(cond, bar) do { unsigned _sp = 0; while (cond) { __builtin_amdgcn_s_sleep(1); \
    if ((++_sp & 255u) == 0u) { if (xb_ld(&(bar)[XB_TMO])) break; if (_sp > XB_SPIN_CAP) { atomicAdd(&(bar)[XB_TMO], 1u); break; } } } } while (0)

struct XcdBarrier { unsigned* bar; unsigned x; volatile LAS unsigned* st; };

__device__ __forceinline__ XcdBarrier xcd_barrier_post(unsigned* bar, volatile LAS unsigned* st) {
    XcdBarrier b; b.bar = bar; b.x = xb_xcc_id(); b.st = st;
    if (threadIdx.x == 0) (void)xb_add(&bar[XB_XCNT(b.x)], 1u);
    return b;
}
__device__ __forceinline__ void xcd_barrier_complete(unsigned* bar, unsigned x, unsigned& nloc, unsigned& nx) {
    const unsigned G = gridDim.x * gridDim.y * gridDim.z;
    unsigned sum, cnt, mine, sp = 0u;
    for (;;) {
        sum = 0u; cnt = 0u; mine = 0u;
#pragma unroll
        for (unsigned j = 0; j < 16; ++j) { const unsigned c = xb_ld(&bar[XB_XCNT(j)]); sum += c; cnt += (c > 0u) ? 1u : 0u; mine = (j == x) ? c : mine; }
        if (sum == G) break;
        __builtin_amdgcn_s_sleep(1);
        if ((++sp & 255u) == 0u) { if (xb_ld(&bar[XB_TMO])) break; if (sp > XB_SPIN_CAP) { atomicAdd(&bar[XB_TMO], 1u); break; } }
    }
    nloc = mine > 0u ? mine : 1u; nx = cnt > 0u ? cnt : 1u;
}
__device__ __forceinline__ void xcd_barrier(const XcdBarrier& b) {
    asm volatile("s_waitcnt vmcnt(0)" ::: "memory");
    __syncthreads();
    if (threadIdx.x == 0) {
        unsigned* bar = b.bar;
        __builtin_amdgcn_s_waitcnt(0);
        unsigned nloc = b.st[0], nx = b.st[1];
        if (nloc == 0u) { xcd_barrier_complete(bar, b.x, nloc, nx); b.st[0] = nloc; b.st[1] = nx; }
        const unsigned old = xb_add(&bar[XB_XSUB(b.x)], 1u);
        const unsigned gen = old / nloc;
        if (old + 1u == (gen + 1u) * nloc) {
            __builtin_amdgcn_fence(__ATOMIC_RELEASE, "agent");
            asm volatile("s_waitcnt vmcnt(0)" ::: "memory");
            const unsigned og = xb_add(&bar[XB_TOP], 1u);
            const unsigned tg = og / nx;
            if (og + 1u == (tg + 1u) * nx) xb_add(&bar[XB_TOPGEN], 1u);
            else XB_SPIN(xb_ld(&bar[XB_TOPGEN]) == tg, bar);
            __builtin_amdgcn_fence(__ATOMIC_ACQUIRE, "agent");
            xb_add(&bar[XB_XGEN(b.x)], 1u);
            asm volatile("s_waitcnt vmcnt(0)" ::: "memory");
        } else {
            XB_SPIN(xb_ld(&bar[XB_XGEN(b.x)]) == gen, bar);
            __builtin_amdgcn_fence(__ATOMIC_ACQUIRE, "agent");
            asm volatile("s_waitcnt vmcnt(0)" ::: "memory");
        }
    }
    __syncthreads();
}

constexpr int NTHREADS = 512;
constexpr int LDS_BYTES = 163840;

#if defined(__HIP_DEVICE_COMPILE__)
typedef unsigned short bf16_t;
typedef short bf16x8 __attribute__((ext_vector_type(8)));
typedef float f32x4 __attribute__((ext_vector_type(4)));
typedef float f32x2 __attribute__((ext_vector_type(2)));
typedef unsigned u32x4 __attribute__((ext_vector_type(4)));
typedef unsigned u32x2 __attribute__((ext_vector_type(2)));
#define LDS_WAIT() asm volatile("s_waitcnt lgkmcnt(0)" ::: "memory")
#define VM_WAIT() asm volatile("s_waitcnt vmcnt(0)" ::: "memory")

__device__ __forceinline__ f32x4 zero4() { float z = 0.f; asm volatile("" : "+v"(z)); return (f32x4){z, z, z, z}; }
__device__ __forceinline__ u32x4 uzero4() { unsigned z = 0u; asm volatile("" : "+v"(z)); return (u32x4){z, z, z, z}; }
__device__ __forceinline__ unsigned f2bf(float f) { unsigned u = __float_as_uint(f); return (u + 0x7fffu + ((u >> 16) & 1u)) >> 16; }
__device__ __forceinline__ unsigned pk2(float lo, float hi) { return f2bf(lo) | (f2bf(hi) << 16); }
__device__ __forceinline__ float bf2f(unsigned b) { return __uint_as_float(b << 16); }
__device__ __forceinline__ float bflo(unsigned w) { return __uint_as_float(w << 16); }
__device__ __forceinline__ float bfhi(unsigned w) { return __uint_as_float(w & 0xffff0000u); }
typedef __bf16 bf16x2_t __attribute__((ext_vector_type(2)));
__device__ __forceinline__ unsigned cvt_pk_bf16(float lo, float hi) { const f32x2 v = {lo, hi}; return __builtin_bit_cast(unsigned, __builtin_convertvector(v, bf16x2_t)); }
__device__ __forceinline__ float fast_sigmoid(float x) { return __builtin_amdgcn_rcpf(1.0f + __expf(-x)); }
__device__ __forceinline__ f32x4 sig4(f32x4 v) { return (f32x4){fast_sigmoid(v[0]), fast_sigmoid(v[1]), fast_sigmoid(v[2]), fast_sigmoid(v[3])}; }
__device__ __forceinline__ unsigned pk4_fp8(float a, float b, float c2, float d) { int w = 0; w = __builtin_amdgcn_cvt_pk_fp8_f32(a, b, w, false); w = __builtin_amdgcn_cvt_pk_fp8_f32(c2, d, w, true); return (unsigned)w; }
__device__ __forceinline__ u32x4 pack8(f32x4 v0, f32x4 v1) { u32x4 w; w.x = cvt_pk_bf16(v0[0], v0[1]); w.y = cvt_pk_bf16(v0[2], v0[3]); w.z = cvt_pk_bf16(v1[0], v1[1]); w.w = cvt_pk_bf16(v1[2], v1[3]); return w; }

namespace gx {
constexpr int BM = 256, BK = 64, HALF = 128, HTB = HALF * BK * 2, STAGE_BYTES = 8 * HTB, NXCD = 8, WGM = 2;
__device__ __forceinline__ int lds_byte(int r, int c) { const int st = (r >> 4) * 2 + (c >> 5), rr = r & 15, cc = c & 31, ob = rr * 64 + cc * 2; return st * 1024 + (ob ^ (((ob >> 9) & 1) << 5)); }
__device__ __forceinline__ void stage_rc(int b, int& R, int& C) { const int st = b / 1024, sb = b % 1024, swz = sb ^ (((sb >> 9) & 1) << 5); R = (st >> 1) * 16 + swz / 64; C = (st & 1) * 32 + (swz % 64) / 2; }
__device__ __forceinline__ int perm32(int rho) { const int n = rho >> 4, i = rho & 15; return 8 * (i >> 2) + 4 * n + (i & 3); }
struct Unit { int pm, pn, e, f; };
struct Gemm { const bf16_t* A; const bf16_t* Bt; int K; size_t bexp; };
struct StaticOrder {
    int nM, nN, nwg, G, c;
    __device__ void init(int M, int N, int G_, int c_) { nM = M / BM; nN = N / BM; nwg = nM * nN; G = G_; c = c_; }
    __device__ bool next(int i, Unit& u) const {
        const long Lx = (long)i * G + c; if (Lx >= nwg) return false;
        int wgid = (int)Lx; { const int q = nwg / NXCD, r = nwg % NXCD, xcd = wgid % NXCD, off = wgid / NXCD; wgid = (xcd < r ? xcd * (q + 1) : r * (q + 1) + (xcd - r) * q) + off; }
        const int nig = WGM * nN, gid = wgid / nig, fm = gid * WGM, gsz = (nM - fm) < WGM ? (nM - fm) : WGM;
        u.pm = fm + ((wgid % nig) % gsz); u.pn = (wgid % nig) / gsz; u.e = 0; u.f = 0; return true;
    }
};
typedef int v8i32 __attribute__((ext_vector_type(8)));
template <class Epi, class Sched, bool GATHER = false, bool FP8 = false>
__device__ __forceinline__ void gemm_phase(LAS unsigned char* lds, const Gemm g, const Sched& S, const Epi& E, const int* rowidx = nullptr) {
    int tid = threadIdx.x; asm volatile("" : "+v"(tid)); const int wid = __builtin_amdgcn_readfirstlane(tid >> 6), lane = tid & 63, wr = wid >> 2, wc = wid & 3, fr = lane & 15, fq = lane >> 4;
    int K = g.K; asm volatile("" : "+s"(K)); const int nt = K / BK;
    unsigned voffA[2], voffB[2];
#pragma unroll
    for (int i = 0; i < 2; ++i) { int R, C; stage_rc(tid * 16 + i * 8192, R, C); const int Rb = Epi::PERM ? ((R & ~31) + perm32(R & 31)) : R;
        voffA[i] = (unsigned)(R * K + C) * 2u; voffB[i] = (unsigned)(Rb * K + C) * 2u; }
    const size_t kstep = (size_t)(BK * 2);
    const size_t hstep = (size_t)HALF * K * 2;
    const size_t tstep = 2 * hstep;
    const size_t hstepA = GATHER ? 0 : hstep;
    const unsigned ldsw = (unsigned)wid * 1024u;
    const int aoff = lds_byte(wr * 64 + fr, fq * 8), boff = lds_byte(wc * 32 + fr, fq * 8);
#define GX_SA(b, h) (((b) * 2 + (h)) * HTB)
#define GX_SB(b, h) ((4 + (b) * 2 + (h)) * HTB)
#define GX_STAGE(bufoff, gbase, voff) do { _Pragma("unroll") for (int _i = 0; _i < 2; ++_i) \
        __builtin_amdgcn_global_load_lds((const unsigned*)((const char*)(gbase) + (voff)[_i]), (LAS unsigned*)(lds + (bufoff) + ldsw + _i * 8192), 16, 0, 0); } while (0)
#define GX_STAGE_A(bufoff, ptr, half, usenext) do { if (GATHER) { unsigned _v[2]; _Pragma("unroll") for (int _i = 0; _i < 2; ++_i) _v[_i] = (usenext) ? nv[half][_i] : cv[half][_i]; GX_STAGE(bufoff, ptr, _v); } \
        else GX_STAGE(bufoff, (ptr) + (half) * hstepA, voffA); } while (0)
#define GX_IDX(dst, u) do { _Pragma("unroll") for (int _i = 0; _i < 2; ++_i) { int _R, _C; stage_rc(tid * 16 + _i * 8192, _R, _C); _Pragma("unroll") for (int _h = 0; _h < 2; ++_h) \
        dst[_h][_i] = (unsigned)rowidx[(u).pm * 256 + _h * 128 + _R] * (unsigned)(K * 2) + (unsigned)(_C * 2); } } while (0)
#define GX_LDA(dst, b, h) do { _Pragma("unroll") for (int m = 0; m < 4; ++m) _Pragma("unroll") for (int k = 0; k < 2; ++k) dst[m][k] = *(const LAS bf16x8*)(lds + GX_SA(b, h) + aoff + m * 2048 + k * 1024); } while (0)
#define GX_LDB(dst, b, h) do { _Pragma("unroll") for (int n = 0; n < 2; ++n) _Pragma("unroll") for (int k = 0; k < 2; ++k) dst[n][k] = *(const LAS bf16x8*)(lds + GX_SB(b, h) + boff + n * 2048 + k * 1024); } while (0)
#define GX_CAT8(lo, hi) __builtin_bit_cast(v8i32, __builtin_shufflevector(__builtin_bit_cast(u32x4, lo), __builtin_bit_cast(u32x4, hi), 0, 1, 2, 3, 4, 5, 6, 7))
#define GX_MMA(ai, bj, At, Bt) do { __builtin_amdgcn_s_setprio(1); if (FP8) { _Pragma("unroll") for (int m = 0; m < 4; ++m) _Pragma("unroll") for (int n = 0; n < 2; ++n) \
            asm volatile("v_mfma_scale_f32_16x16x128_f8f6f4 %0, %1, %2, %0, %3, %3 op_sel_hi:[0,0,0]" : "+v"(acc[ai][bj][m][n]) : "v"(GX_CAT8(Bt[n][0], Bt[n][1])), "v"(GX_CAT8(At[m][0], At[m][1])), "v"(one_scale)); } \
        else { _Pragma("unroll") for (int m = 0; m < 4; ++m) _Pragma("unroll") for (int n = 0; n < 2; ++n) _Pragma("unroll") for (int k = 0; k < 2; ++k) \
        acc[ai][bj][m][n] = __builtin_amdgcn_mfma_f32_16x16x32_bf16(Bt[n][k], At[m][k], acc[ai][bj][m][n], 0, 0, 0); } __builtin_amdgcn_s_setprio(0); } while (0)
#define GX_WAIT_V(n) asm volatile("s_waitcnt vmcnt(" #n ")" ::: "memory")
#define GX_WAIT_L(n) asm volatile("s_waitcnt lgkmcnt(" #n ")" ::: "memory")
#define GX_BAR __builtin_amdgcn_s_barrier()
#define GX_SCHED __builtin_amdgcn_sched_barrier(0)
    Unit cur, nxt, nn; int ui = 0;
    if (!S.next(0, cur)) return;
    bool has_next = S.next(1, nxt);
    unsigned cv[2][2], nv[2][2], nnv[2][2];
    if (GATHER) { GX_IDX(cv, cur); if (has_next) GX_IDX(nv, nxt); else { _Pragma("unroll") for (int h = 0; h < 2; ++h) _Pragma("unroll") for (int i = 0; i < 2; ++i) nv[h][i] = cv[h][i]; } }
    f32x4 acc[2][2][4][2];
    { float z = 0.f; asm volatile("" : "+v"(z));
#pragma unroll
    for (int a = 0; a < 2; ++a)
#pragma unroll
        for (int b = 0; b < 2; ++b)
#pragma unroll
            for (int m = 0; m < 4; ++m)
#pragma unroll
                for (int n = 0; n < 2; ++n) acc[a][b][m][n] = (f32x4){z, z, z, z}; }
    bf16x8 At[4][2], B0[2][2], B1[2][2]; int one_scale = 0x7f7f7f7f; asm volatile("" : "+v"(one_scale));
    const char* cA = (const char*)g.A + (GATHER ? 0 : (size_t)cur.pm * tstep); const char* cB = (const char*)g.Bt + (size_t)cur.e * g.bexp + (size_t)cur.pn * tstep;
    GX_STAGE(GX_SB(0, 0), cB, voffB); GX_STAGE_A(GX_SA(0, 0), cA, 0, false); GX_STAGE(GX_SB(0, 1), cB + hstep, voffB); GX_STAGE_A(GX_SA(0, 1), cA, 1, false);
    if (wr == 1) GX_BAR;
    GX_WAIT_V(4); GX_BAR;
    GX_STAGE(GX_SB(1, 0), cB + kstep, voffB); GX_STAGE_A(GX_SA(1, 0), cA + kstep, 0, false); GX_STAGE(GX_SB(1, 1), cB + hstep + kstep, voffB);
    GX_WAIT_V(6); GX_BAR;
    for (;;) {
        const char* nA = (has_next && !GATHER) ? (const char*)g.A + (size_t)nxt.pm * tstep : cA; const char* nB = has_next ? (const char*)g.Bt + (size_t)nxt.e * g.bexp + (size_t)nxt.pn * tstep : cB;
#pragma clang loop unroll(disable)
        for (int t = 0; t < nt; t += 2) {
            const bool last = (t == nt - 2);
            const char* a1 = cA + (size_t)(t + 1) * kstep;
            const char* a2 = last ? nA : cA + (size_t)(t + 2) * kstep; const char* b2 = last ? nB : cB + (size_t)(t + 2) * kstep;
            const char* a3 = a2 + kstep; const char* b3 = b2 + kstep;
            GX_LDB(B0, 0, 0); GX_SCHED; GX_LDA(At, 0, 0); GX_STAGE_A(GX_SA(1, 1), a1, 1, false);
            GX_WAIT_L(8); GX_BAR; GX_WAIT_L(0); GX_MMA(0, 0, At, B0); GX_BAR; GX_SCHED;
            GX_LDB(B1, 0, 1); GX_STAGE(GX_SB(0, 0), b2, voffB);
            GX_BAR; GX_WAIT_L(0); GX_MMA(0, 1, At, B1); GX_BAR;
            GX_LDA(At, 0, 1); GX_STAGE_A(GX_SA(0, 0), a2, 0, last);
            GX_BAR; GX_WAIT_L(0); GX_MMA(1, 0, At, B0); GX_BAR; GX_SCHED;
            GX_STAGE(GX_SB(0, 1), b2 + hstep, voffB);
            GX_WAIT_V(6); GX_BAR; GX_MMA(1, 1, At, B1); GX_BAR;
            GX_LDB(B0, 1, 0); GX_SCHED; GX_LDA(At, 1, 0); GX_STAGE_A(GX_SA(0, 1), a2, 1, last);
            GX_WAIT_L(8); GX_BAR; GX_WAIT_L(0); GX_MMA(0, 0, At, B0); GX_BAR; GX_SCHED;
            GX_LDB(B1, 1, 1); GX_STAGE(GX_SB(1, 0), b3, voffB);
            GX_BAR; GX_WAIT_L(0); GX_MMA(0, 1, At, B1); GX_BAR;
            GX_LDA(At, 1, 1); GX_STAGE_A(GX_SA(1, 0), a3, 0, last);
            GX_BAR; GX_WAIT_L(0); GX_MMA(1, 0, At, B0); GX_BAR; GX_SCHED;
            GX_STAGE(GX_SB(1, 1), b3 + hstep, voffB);
            GX_WAIT_V(6); GX_BAR; GX_MMA(1, 1, At, B1); GX_BAR;
        }
        const bool has_nn = has_next && S.next(ui + 2, nn);
        if (GATHER && has_nn) GX_IDX(nnv, nn);
        if (FP8) asm volatile("s_nop 15\n\ts_nop 15" ::: "memory");
        E(acc, cur, wr, wc, fr, fq);
        if (!has_next) break;
        { float z = 0.f; asm volatile("" : "+v"(z));
#pragma unroll
        for (int a = 0; a < 2; ++a)
#pragma unroll
            for (int b = 0; b < 2; ++b)
#pragma unroll
                for (int m = 0; m < 4; ++m)
#pragma unroll
                    for (int n = 0; n < 2; ++n) acc[a][b][m][n] = (f32x4){z, z, z, z}; }
        cur = nxt; cA = nA; cB = nB; ++ui;
        if (GATHER) { _Pragma("unroll") for (int h = 0; h < 2; ++h) _Pragma("unroll") for (int i = 0; i < 2; ++i) { cv[h][i] = nv[h][i]; if (has_nn) nv[h][i] = nnv[h][i]; } }
        nxt = nn; has_next = has_nn;
    }
    GX_WAIT_V(0);
    if (wr == 0) GX_BAR;
    GX_BAR;
#undef GX_SA
#undef GX_SB
#undef GX_STAGE
#undef GX_STAGE_A
#undef GX_IDX
#undef GX_LDA
#undef GX_LDB
#undef GX_MMA
#undef GX_CAT8
#undef GX_WAIT_V
#undef GX_WAIT_L
#undef GX_BAR
#undef GX_SCHED
}
}

template <bool RAWG, bool RAWZ> struct EpiInproj {
    static constexpr bool PERM = true;
    bf16_t *Gb, *Zb, *XBCb, *QKVU; float* dtf; const float* bgate; bf16_t* Ug;
    __device__ __forceinline__ void operator()(const f32x4 (&acc)[2][2][4][2], const gx::Unit& u, int wr, int wc, int fr, int fq) const {
        const int row0 = u.pm * 256 + wr * 64 + fr, cl = wc * 32 + 8 * fq;
        if (u.pn == 54) {
            if (wc < 2) {
#pragma unroll
                for (int ai = 0; ai < 2; ++ai)
#pragma unroll
                    for (int m = 0; m < 4; ++m) { float* rowp = dtf + (size_t)(row0 + ai * 128 + m * 16) * 64 + cl; *(f32x4*)rowp = acc[ai][0][m][0]; *(f32x4*)(rowp + 4) = acc[ai][0][m][1]; }
            }
            return;
        }
        bf16_t* base; int ldc, colt, mode;
        if (u.pn < 12) { base = Gb; ldc = 3072; colt = u.pn * 256; mode = RAWG ? 0 : 1; }
        else if (u.pn < 20) { base = Zb; ldc = 2048; colt = (u.pn - 12) * 256; mode = RAWZ ? 0 : 2; }
        else if (u.pn < 36) { base = XBCb; ldc = 4096; colt = (u.pn - 20) * 256; mode = 0; }
        else { base = QKVU; ldc = 4608; colt = (u.pn - 36) * 256; mode = 0; }
        const bool isu = u.pn >= 50;
#pragma unroll
        for (int bj = 0; bj < 2; ++bj) {
            const int col = colt + bj * 128 + cl;
            f32x4 b0 = zero4(), b1 = b0;
            if (mode == 1) { b0 = *(const f32x4*)(bgate + col); b1 = *(const f32x4*)(bgate + col + 4); }
#pragma unroll
            for (int ai = 0; ai < 2; ++ai)
#pragma unroll
                for (int m = 0; m < 4; ++m) {
                    f32x4 v0 = acc[ai][bj][m][0], v1 = acc[ai][bj][m][1];
                    if (mode == 1) { v0 = sig4(v0 + b0); v1 = sig4(v1 + b1); }
                    else if (mode == 2) { v0 = v0 * sig4(v0); v1 = v1 * sig4(v1); }
                    const u32x4 pk = pack8(v0, v1);
                    if (isu || (u.pn == 49 && bj == 1)) { const int uc = col - 3456; *(u32x4*)(Ug + ((size_t)(uc >> 4) * 16384 + (row0 + ai * 128 + m * 16)) * 16 + (uc & 15)) = pk; }
                    else *(u32x4*)(base + (size_t)(row0 + ai * 128 + m * 16) * ldc + col) = pk;
                }
        }
    }
};

struct EpiGlu {
    static constexpr bool PERM = true;
    bf16_t* O;
    __device__ __forceinline__ void operator()(const f32x4 (&acc)[2][2][4][2], const gx::Unit& u, int wr, int wc, int fr, int fq) const {
        const int row0 = u.pm * 256 + wr * 64 + fr, col = u.pn * 128 + wc * 32 + 8 * fq;
#pragma unroll
        for (int ai = 0; ai < 2; ++ai)
#pragma unroll
            for (int m = 0; m < 4; ++m) {
                const f32x4 v0 = acc[ai][0][m][0] * sig4(acc[ai][1][m][0]), v1 = acc[ai][0][m][1] * sig4(acc[ai][1][m][1]);
                *(u32x4*)(O + (size_t)(row0 + ai * 128 + m * 16) * 1152 + col) = pack8(v0, v1);
            }
    }
};
template <int STEP> struct EpiBranch {
    static constexpr bool PERM = true;
    const bf16_t* G; bf16_t* mb; const float* ssq;
    __device__ __forceinline__ void operator()(const f32x4 (&acc)[2][2][4][2], const gx::Unit& u, int wr, int wc, int fr, int fq) const {
        const int row0 = u.pm * 256 + wr * 64 + fr, cl = u.pn * 256 + wc * 32 + 8 * fq;
#pragma unroll
        for (int ai = 0; ai < 2; ++ai) {
            u32x4 gw[4][2], pw[4][2]; float rs[4];
#pragma unroll
            for (int m = 0; m < 4; ++m) { const size_t row = (size_t)(row0 + ai * 128 + m * 16);
#pragma unroll
                for (int bj = 0; bj < 2; ++bj) { const int col = cl + bj * 128; gw[m][bj] = *(const u32x4*)(G + row * 3072 + STEP * 1024 + col); if (STEP > 0) pw[m][bj] = *(const u32x4*)(mb + row * 1024 + col); }
                if (STEP == 0) { const f32x4 qa = *(const f32x4*)(ssq + row * 8), qb = *(const f32x4*)(ssq + row * 8 + 4);
                    rs[m] = __builtin_amdgcn_rsqf((((qa[0] + qa[1]) + (qa[2] + qa[3])) + ((qb[0] + qb[1]) + (qb[2] + qb[3]))) * (1.0f / 2048.0f) + md::EPS); } }
#pragma unroll
            for (int m = 0; m < 4; ++m)
#pragma unroll
                for (int bj = 0; bj < 2; ++bj) { const size_t row = (size_t)(row0 + ai * 128 + m * 16); const int col = cl + bj * 128; const u32x4 g4 = gw[m][bj];
                    const f32x4 g0 = (f32x4){bflo(g4.x), bfhi(g4.x), bflo(g4.y), bfhi(g4.y)}, g1 = (f32x4){bflo(g4.z), bfhi(g4.z), bflo(g4.w), bfhi(g4.w)};
                    f32x4 v0 = acc[ai][bj][m][0] * g0, v1 = acc[ai][bj][m][1] * g1;
                    if (STEP == 0) { v0 *= rs[m]; v1 *= rs[m]; }
                    if (STEP > 0) { const u32x4 p4 = pw[m][bj]; v0 += (f32x4){bflo(p4.x), bfhi(p4.x), bflo(p4.y), bfhi(p4.y)}; v1 += (f32x4){bflo(p4.z), bfhi(p4.z), bflo(p4.w), bfhi(p4.w)}; }
                    *(u32x4*)(mb + row * 1024 + col) = pack8(v0, v1); }
        }
    }
};
struct EpiBf16 {
    static constexpr bool PERM = true;
    bf16_t* C;
    __device__ __forceinline__ void operator()(const f32x4 (&acc)[2][2][4][2], const gx::Unit& u, int wr, int wc, int fr, int fq) const {
        const int row0 = u.pm * 256 + wr * 64 + fr, cl = u.pn * 256 + wc * 32 + 8 * fq;
#pragma unroll
        for (int ai = 0; ai < 2; ++ai)
#pragma unroll
            for (int m = 0; m < 4; ++m)
#pragma unroll
                for (int bj = 0; bj < 2; ++bj) *(u32x4*)(C + (size_t)(row0 + ai * 128 + m * 16) * 1024 + cl + bj * 128) = pack8(acc[ai][bj][m][0], acc[ai][bj][m][1]);
    }
};

__device__ __forceinline__ void cvt_item(const float* Wsrc  , int ldn, bf16_t* dst  , int K, int k0, LAS float* scr, int lane, const float* kscale) {
#pragma unroll
    for (int hb = 0; hb < 2; ++hb) {
        float v[32];
#pragma unroll
        for (int i = 0; i < 32; ++i) v[i] = __builtin_nontemporal_load(Wsrc + (size_t)(k0 + 32 * hb + i) * ldn + lane);
        if (kscale) {
#pragma unroll
            for (int i = 0; i < 32; ++i) v[i] *= kscale[k0 + 32 * hb + i];
        }
#pragma unroll
        for (int i = 0; i < 32; ++i) scr[(32 * hb + i) * 65 + lane] = v[i];
    }
    LDS_WAIT(); asm volatile("" ::: "memory");
    const int cch = lane & 7;
#pragma unroll
    for (int j = 0; j < 8; ++j) { const int n = (lane >> 3) + 8 * j; const LAS float* sp = scr + (8 * cch) * 65 + n;
        u32x4 o; o.x = cvt_pk_bf16(sp[0 * 65], sp[1 * 65]); o.y = cvt_pk_bf16(sp[2 * 65], sp[3 * 65]); o.z = cvt_pk_bf16(sp[4 * 65], sp[5 * 65]); o.w = cvt_pk_bf16(sp[6 * 65], sp[7 * 65]);
        *(u32x4*)(dst + (size_t)n * K + k0 + 8 * cch) = o; }
    LDS_WAIT(); asm volatile("" ::: "memory");
}
__device__ __forceinline__ void cvt8_load(float (&v)[64], const float* Wsrc, int ldn, int k0, int lane) {
#pragma unroll
    for (int i = 0; i < 64; ++i) v[i] = __builtin_nontemporal_load(Wsrc + (size_t)(k0 + i) * ldn + lane);
}
__device__ __forceinline__ void cvt8_put(const float (&v)[64], LAS float* scr, int lane, float wmul) {
#pragma unroll
    for (int i = 0; i < 64; ++i) scr[i * 65 + lane] = v[i] * wmul;
}
__device__ __forceinline__ void cvt8_out(unsigned char* dst  , int Kb  , int k0, LAS float* scr, int lane) {
    LDS_WAIT(); asm volatile("" ::: "memory");
    const LAS float* sp = scr + lane;
#pragma unroll
    for (int j = 0; j < 4; ++j) { u32x4 o;
        o.x = pk4_fp8(sp[(16 * j + 0) * 65], sp[(16 * j + 1) * 65], sp[(16 * j + 2) * 65], sp[(16 * j + 3) * 65]); o.y = pk4_fp8(sp[(16 * j + 4) * 65], sp[(16 * j + 5) * 65], sp[(16 * j + 6) * 65], sp[(16 * j + 7) * 65]);
        o.z = pk4_fp8(sp[(16 * j + 8) * 65], sp[(16 * j + 9) * 65], sp[(16 * j + 10) * 65], sp[(16 * j + 11) * 65]); o.w = pk4_fp8(sp[(16 * j + 12) * 65], sp[(16 * j + 13) * 65], sp[(16 * j + 14) * 65], sp[(16 * j + 15) * 65]);
        *(u32x4*)(dst + (size_t)lane * Kb + k0 + 16 * j) = o; }
    LDS_WAIT(); asm volatile("" ::: "memory");
}
template <bool SMALL, bool MOE>
__device__ __forceinline__ void prologue_weights(const Ctx& c, int l, int par, LAS unsigned char* lds, int first_wg, int n_wg) {
    int tid_ = threadIdx.x; asm volatile("" : "+v"(tid_)); const int wave = __builtin_amdgcn_readfirstlane(tid_ >> 6), lane = tid_ & 63;
    LAS float* scr = (LAS float*)(lds + wave * 16640);
    const int gw = ((int)blockIdx.x - first_wg) * 8 + wave, NGW = n_wg * 8;
    constexpr int N_WIN = 16 * 217, N_GLU = 18 * 18, N_BS = 32 * 16, N_BA = 6 * 16, N_B5 = 18 * 16, N_WO = 16 * 16, N_GU = 32 * 16 * 32, N_DN = 32 * 16 * 16;
    constexpr int N_SMALL = N_WIN + 2 * N_GLU + N_BS + N_BA + N_B5 + N_WO;
    if (SMALL) {
        bf16_t* Win_t = c.Win_t + par * wsz::WIN; bf16_t* Wglu_t = c.Wglu_t + par * wsz::WGLU; bf16_t* Wbs_t = c.Wbs_t + par * wsz::WBS; bf16_t* Wba_t = c.Wba_t + par * wsz::WBA; bf16_t* Wb5_t = c.Wb5_t + par * wsz::WB5; bf16_t* Wout_t = c.Wout_t + par * wsz::WOUT;
#pragma unroll 1
        for (int it = gw; it < N_SMALL; it += NGW) {
            int r = it; const float* src; bf16_t* dst; int ldn, K, kb; const float* ksc = nullptr;
            if (r < N_WIN) { kb = r / 217; const int n0 = (r % 217) * 64; const int drow = n0 < 9216 ? n0 : (n0 < 9280 ? 13824 + (n0 - 9216) : n0 - 64);
                src = c.in[I_WIN] + (size_t)l * 1024 * md::NIN + n0; ldn = md::NIN; dst = Win_t + (size_t)drow * 1024; K = 1024; }
            else if ((r -= N_WIN) < 2 * N_GLU) { const int w = r / N_GLU; r -= w * N_GLU; kb = r / 18; const int sb = r % 18; const int drow = 256 * (sb / 2) + 64 * (sb % 2) + 128 * w;
                src = c.in[w ? I_GLU2 : I_GLU1] + (size_t)l * 1152 * 1152 + sb * 64; ldn = 1152; dst = Wglu_t + (size_t)drow * 1152; K = 1152; }
            else if ((r -= 2 * N_GLU) < N_BS) { kb = r / 16; const int sb = r % 16; src = c.in[I_WBSSD] + (size_t)l * 2048 * 1024 + sb * 64; ldn = 1024; dst = Wbs_t + (size_t)(sb * 64) * 2048; K = 2048; ksc = c.in[I_NORMW] + (size_t)l * 2048; }
            else if ((r -= N_BS) < N_BA) { kb = r / 16; const int sb = r % 16; src = c.in[I_WBATT] + (size_t)l * 384 * 1024 + sb * 64; ldn = 1024; dst = Wba_t + (size_t)(sb * 64) * 384; K = 384; }
            else if ((r -= N_BA) < N_B5) { kb = r / 16; const int sb = r % 16; src = c.in[I_WBS5] + (size_t)l * 1152 * 1024 + sb * 64; ldn = 1024; dst = Wb5_t + (size_t)(sb * 64) * 1152; K = 1152; }
            else { r -= N_B5; kb = r / 16; const int sb = r % 16; src = c.in[I_WOUT] + (size_t)l * 1024 * 1024 + sb * 64; ldn = 1024; dst = Wout_t + (size_t)(sb * 64) * 1024; K = 1024; }
            cvt_item(src, ldn, dst, K, kb * 64, scr, lane, ksc);
        }
        for (long i = (long)((int)blockIdx.x - first_wg) * NTHREADS + tid_; i < 192 * 1024 / 8; i += (long)n_wg * NTHREADS) *(u32x4*)(Win_t + (size_t)13888 * 1024 + i * 8) = uzero4();
    }
    if (MOE) {
#define MOE_ITEM(r_, src, ldn, dst, kb) do { int r = (r_); \
            if (r < N_GU) { const int e = r / (16 * 32); r -= e * 16 * 32; kb = r / 32; const int sb = r % 32; const int s2 = sb & 15; const int drow = e * 2048 + 256 * (s2 / 2) + 64 * (s2 % 2) + (sb >= 16 ? 128 : 0); \
                src = c.in[I_WGU] + ((size_t)l * 32 + e) * 1024 * 2048 + sb * 64; ldn = 2048; dst = (unsigned char*)c.Wgu_t + (size_t)drow * 1024; } \
            else { r -= N_GU; const int e = r / (16 * 16); r -= e * 16 * 16; kb = r / 16; const int sb = r % 16; \
                src = c.in[I_WDN] + ((size_t)l * 32 + e) * 1024 * 1024 + sb * 64; ldn = 1024; dst = (unsigned char*)c.Wdn_t + (size_t)(e * 1024 + sb * 64) * 1024; } } while (0)
        float v[64]; const float* src; unsigned char* dst; int ldn, kb; int it = gw;
        if (it < N_GU + N_DN) { MOE_ITEM(it, src, ldn, dst, kb); cvt8_load(v, src, ldn, kb * 64, lane); }
#pragma unroll 1
        for (; it < N_GU + N_DN; it += NGW) {
            cvt8_put(v, scr, lane, 64.0f);
            unsigned char* dcur = dst; const int kcur = kb;
            if (it + NGW < N_GU + N_DN) { MOE_ITEM(it + NGW, src, ldn, dst, kb); cvt8_load(v, src, ldn, kb * 64, lane); }
            cvt8_out(dcur, 1024, kcur * 64, scr, lane);
        }
#undef MOE_ITEM
    }
}
__device__ __forceinline__ void cvt_x8(const float* x, bf16_t* o, long i) {
    const f32x4 a = *(const f32x4*)(x + i * 8), b = *(const f32x4*)(x + i * 8 + 4);
    *(u32x4*)(o + i * 8) = pack8(a, b);
}
#endif

#define LOOP(count, stmt) do { unsigned t_ = threadIdx.x; asm volatile("" : "+v"(t_)); const long gth_ = (long)c.grid * NTHREADS; for (long i = (long)blockIdx.x * NTHREADS + t_; i < (long)(count); i += gth_) { stmt; } } while (0)
#define SYNC() xcd_barrier(bar)
constexpr int ox_T = 16384;

#if defined(__HIP_DEVICE_COMPILE__)
constexpr int LDS_TAB = 131072;
constexpr int NSLOT_MAX = 65536 + 32 * 256;
#define SWZ_XOR(v, k) __int_as_float(__builtin_amdgcn_ds_swizzle(__float_as_int(v), ((k) << 10) | 0x1f))
__device__ __forceinline__ float wave_sum(float v) {
    v += SWZ_XOR(v, 1); v += SWZ_XOR(v, 2); v += SWZ_XOR(v, 4); v += SWZ_XOR(v, 8); v += SWZ_XOR(v, 16);
    return __int_as_float(__builtin_amdgcn_readlane(__float_as_int(v), 0)) + __int_as_float(__builtin_amdgcn_readlane(__float_as_int(v), 32));
}
__device__ __forceinline__ void moe_count(const Ctx& c, LAS unsigned char* lds) {
    int tid = threadIdx.x; asm volatile("" : "+v"(tid));
    LAS int* cl = (LAS int*)lds;
    for (int gi = blockIdx.x; gi < ox_T / 64; gi += c.grid) {
        if (tid < 32) cl[tid] = 0;
        __syncthreads();
        if (tid < 256) atomicAdd((int*)(cl + c.topidx[gi * 256 + tid]), 1);
        __syncthreads();
        if (tid < 32) c.moe_cnt[gi * 32 + tid] = cl[tid];
        __syncthreads();
    }
}
__device__ __forceinline__ void moe_assign(const Ctx& c, LAS unsigned char* lds) {
    int tid = threadIdx.x; asm volatile("" : "+v"(tid));
    LAS int* tbl = (LAS int*)lds;
    LAS int* total = tbl + 8192;
    LAS int* pstart = total + 32;
    LAS int* base = pstart + 40;
    LAS int* eids = base + 32;
    __syncthreads();
    int pe = 0; float pg = 0.f;
    if (tid < 256 && (int)blockIdx.x < ox_T / 64) { pe = c.topidx[blockIdx.x * 256 + tid]; pg = c.gate[blockIdx.x * 256 + tid]; }
    for (int i = tid; i < 8192; i += NTHREADS) tbl[i] = c.moe_cnt[i];
    __syncthreads();
    if (tid < 32) { int s = 0; for (int gi = 0; gi < 256; ++gi) s += tbl[gi * 32 + tid]; total[tid] = s; }
    __syncthreads();
    if (tid == 0) { int p = 0; for (int e = 0; e < 32; ++e) { pstart[e] = p; p += (total[e] + 255) / 256 * 256; } pstart[32] = p; }
    __syncthreads();
    if (blockIdx.x == 0 && tid < 33) c.moe_pstart[tid] = pstart[tid];
    if (blockIdx.x == 0 && tid < 288) c.moe_done[tid] = 0;
    for (int e = blockIdx.x; e < 32; e += c.grid) {
        const int r0 = pstart[e] + total[e], r1 = pstart[e + 1];
        for (int i = r0 + tid; i < r1; i += NTHREADS) c.slot_tok[i] = ox_T;
    }
    for (int gi = blockIdx.x; gi < ox_T / 64; gi += c.grid) {
        if (tid < 32) { int s = pstart[tid]; for (int g2 = 0; g2 < gi; ++g2) s += tbl[g2 * 32 + tid]; base[tid] = s; }
        const bool first = (gi == (int)blockIdx.x);
        if (tid < 256) { if (!first) { pe = c.topidx[gi * 256 + tid]; pg = c.gate[gi * 256 + tid]; } eids[tid] = pe; }
        __syncthreads();
        if (tid < 256) { const int e = eids[tid]; int r = 0; for (int a = 0; a < tid; ++a) r += (eids[a] == e) ? 1 : 0;
            const int slot = base[e] + r; c.tok_slot[gi * 256 + tid] = slot; c.slot_gate[slot] = pg; c.slot_tok[slot] = gi * 64 + (tid >> 2); }
        __syncthreads();
    }
}
__device__ __forceinline__ int xcd_chunk(long L, int n) { const int q = n / 8, r = n % 8, xcd = (int)(L % 8), off = (int)(L / 8); return (xcd < r ? xcd * (q + 1) : r * (q + 1) + (xcd - r) * q) + off; }
__device__ __forceinline__ void moe_early(int nb, int G, int& M, int& first_idle) {
    const int rem = (nb * 8) % G; first_idle = rem; const int idle = rem ? G - rem : 0, left = (nb * 4) % G;
    int m = (left + 31) / 32; if (m > 7 || 32 * m > idle) m = 0;
    M = m;
}
struct MoeOrder {
    const LAS int* blkexp; int nunits, G, c, lgN, mode, nb, M, first_idle;
    __device__ __forceinline__ int base(int x) const { return (x * nb + 7) / 8 + 20; }
    __device__ __forceinline__ bool next(int i, gx::Unit& u) const {
        if (mode == 1) { const int j = c - first_idle; if (i > 0 || j < 0 || j >= 32 * M) return false; const int t = j >> 3; u.pm = base(j & 7) + (t >> 2); u.pn = t & 3; u.e = blkexp[u.pm]; u.f = 0; return true; }
        const long L = (long)i * G + c; if (L >= nunits) return false;
        int id = xcd_chunk(L, nunits); if (mode == 2) id = nunits - 1 - id;
        int pm = id >> lgN, f = 0; u.pn = id & ((1 << lgN) - 1);
        if (mode == 2) { for (int x = 0; x < 8; ++x) pm += (pm >= base(x)) ? M : 0; }
        else { for (int x = 0; x < 8; ++x) f |= ((unsigned)(pm - base(x)) < (unsigned)M) ? 1 : 0; }
        u.pm = pm; u.e = blkexp[pm]; u.f = f; return true;
    }
};
__device__ __forceinline__ void moe_wait_rows(const int* done, int rb, int need = 64) {
    int tid = threadIdx.x; asm volatile("" : "+v"(tid));
    if (tid == 0) { unsigned sp = 0; while (__hip_atomic_load(done + rb, __ATOMIC_RELAXED, __HIP_MEMORY_SCOPE_AGENT) < need && ++sp < (1u << 22)) __builtin_amdgcn_s_sleep(2); }
    __syncthreads();
    __builtin_amdgcn_fence(__ATOMIC_ACQUIRE, "agent");
}
__device__ __forceinline__ int moe_blocks(const Ctx& c, LAS unsigned char* lds) {
    int tid = threadIdx.x; asm volatile("" : "+v"(tid));
    LAS int* blkexp = (LAS int*)(lds + LDS_TAB); LAS int* ps = blkexp + 288;
    if (tid < 33) ps[tid] = c.moe_pstart[tid];
    __syncthreads();
    const int nb = ps[32] / 256;
    if (tid < nb) { int e = 0; for (int k = 1; k < 32; ++k) e += (ps[k] <= tid * 256) ? 1 : 0; blkexp[tid] = e; }
    __syncthreads();
    return nb;
}
struct EpiSwiglu {
    static constexpr bool PERM = true;
    unsigned char* O; const float* bgu; int* done;
    __device__ __forceinline__ void operator()(const f32x4 (&acc)[2][2][4][2], const gx::Unit& u, int wr, int wc, int fr, int fq) const {
        const int row0 = u.pm * 256 + wr * 64 + fr, col = u.pn * 128 + wc * 32 + 8 * fq;
        const float* bp = bgu + (size_t)u.e * 2048 + col;
        const f32x4 bg0 = *(const f32x4*)bp, bg1 = *(const f32x4*)(bp + 4), bl0 = *(const f32x4*)(bp + 1024), bl1 = *(const f32x4*)(bp + 1028);
#pragma unroll
        for (int ai = 0; ai < 2; ++ai)
#pragma unroll
            for (int m = 0; m < 4; ++m) {
                f32x4 o[2];
#pragma unroll
                for (int n = 0; n < 2; ++n) {
                    const f32x4 xg = acc[ai][0][m][n] * (1.0f / 64.0f) + (n ? bg1 : bg0), xl = acc[ai][1][m][n] * (1.0f / 64.0f) + (n ? bl1 : bl0);
#pragma unroll
                    for (int j = 0; j < 4; ++j) { const float a = fminf(xg[j], 7.0f), b = fminf(fmaxf(xl[j], -7.0f), 7.0f); o[n][j] = a * fast_sigmoid(1.702f * a) * (b + 1.0f); }
                }
                u32x2 w; w.x = pk4_fp8(o[0][0], o[0][1], o[0][2], o[0][3]); w.y = pk4_fp8(o[1][0], o[1][1], o[1][2], o[1][3]); unsigned char* dst = O + (size_t)(row0 + ai * 128 + m * 16) * 1024 + col;
                if (u.f) __hip_atomic_store((unsigned long long*)dst, (unsigned long long)w.x | ((unsigned long long)w.y << 32), __ATOMIC_RELAXED, __HIP_MEMORY_SCOPE_AGENT);
                else *(u32x2*)dst = w;
            }
        if (u.f) { asm volatile("s_waitcnt vmcnt(0)" ::: "memory"); if ((fr | fq) == 0) (void)__hip_atomic_fetch_add(done + u.pm, 1, __ATOMIC_RELAXED, __HIP_MEMORY_SCOPE_AGENT); }
    }
};
struct EpiDown {
    static constexpr bool PERM = true;
    bf16_t* O; const float* bdn; const float* sg;
    __device__ __forceinline__ void operator()(const f32x4 (&acc)[2][2][4][2], const gx::Unit& u, int wr, int wc, int fr, int fq) const {
        const int row0 = u.pm * 256 + wr * 64 + fr, cl = u.pn * 256 + wc * 32 + 8 * fq;
        f32x4 b[2][2];
#pragma unroll
        for (int bj = 0; bj < 2; ++bj) { b[bj][0] = *(const f32x4*)(bdn + (size_t)u.e * 1024 + cl + bj * 128); b[bj][1] = *(const f32x4*)(bdn + (size_t)u.e * 1024 + cl + bj * 128 + 4); }
#pragma unroll
        for (int ai = 0; ai < 2; ++ai)
#pragma unroll
            for (int m = 0; m < 4; ++m) { const size_t row = (size_t)(row0 + ai * 128 + m * 16); const float gt = sg[row];
#pragma unroll
                for (int bj = 0; bj < 2; ++bj) *(u32x4*)(O + row * 1024 + cl + bj * 128) = pack8((acc[ai][bj][m][0] * (1.0f / 64.0f) + b[bj][0]) * gt, (acc[ai][bj][m][1] * (1.0f / 64.0f) + b[bj][1]) * gt); }
    }
};
__device__ __forceinline__ void moe_combine_ln(const Ctx& c, const float* g, const float* b, float* out  ) {
    int tid = threadIdx.x; asm volatile("" : "+v"(tid)); const int wave = __builtin_amdgcn_readfirstlane(tid >> 6), lane = tid & 63;
    const int stride = c.grid * 8; int t = blockIdx.x * 8 + wave;
    if (t >= ox_T) return;
    u32x2 xa[4]; u32x2 ya[4][4]; int sn[4];
#define CMB_SLOTS(dst, tt) do { _Pragma("unroll") for (int k = 0; k < 4; ++k) dst[k] = c.tok_slot[(tt) * 4 + k]; } while (0)
#define CMB_ROWS(xd, yd, tt, sl) do { _Pragma("unroll") for (int j = 0; j < 4; ++j) { const int col = lane * 4 + 256 * j; xd[j] = *(const u32x2*)(c.x1b + (size_t)(tt) * 1024 + col); \
        _Pragma("unroll") for (int k = 0; k < 4; ++k) yd[k][j] = *(const u32x2*)(c.ys2 + (size_t)sl[k] * 1024 + col); } } while (0)
    CMB_SLOTS(sn, t); CMB_ROWS(xa, ya, t, sn);
    { const int t1 = t + stride < ox_T ? t + stride : t; CMB_SLOTS(sn, t1); }
#pragma unroll 1
    for (; t < ox_T; t += stride) {
        f32x4 v[4]; float s = 0.f;
#pragma unroll
        for (int j = 0; j < 4; ++j) { f32x4 a = (f32x4){bflo(xa[j].x), bfhi(xa[j].x), bflo(xa[j].y), bfhi(xa[j].y)} * md::ALPHA;
            a[0] += (bflo(ya[0][j].x) + bflo(ya[1][j].x)) + (bflo(ya[2][j].x) + bflo(ya[3][j].x)); a[1] += (bfhi(ya[0][j].x) + bfhi(ya[1][j].x)) + (bfhi(ya[2][j].x) + bfhi(ya[3][j].x));
            a[2] += (bflo(ya[0][j].y) + bflo(ya[1][j].y)) + (bflo(ya[2][j].y) + bflo(ya[3][j].y)); a[3] += (bfhi(ya[0][j].y) + bfhi(ya[1][j].y)) + (bfhi(ya[2][j].y) + bfhi(ya[3][j].y));
            v[j] = a; s += (a[0] + a[1]) + (a[2] + a[3]); }
        { const int t1 = t + stride < ox_T ? t + stride : t, t2 = t + 2 * stride < ox_T ? t + 2 * stride : t; CMB_ROWS(xa, ya, t1, sn); CMB_SLOTS(sn, t2); }
        const float mean = wave_sum(s) * (1.0f / 1024.0f); float q = 0.f;
#pragma unroll
        for (int j = 0; j < 4; ++j) { v[j] = v[j] - mean; q += (v[j][0] * v[j][0] + v[j][1] * v[j][1]) + (v[j][2] * v[j][2] + v[j][3] * v[j][3]); }
        const float rstd = __builtin_amdgcn_rsqf(wave_sum(q) * (1.0f / 1024.0f) + md::EPS);
#pragma unroll
        for (int j = 0; j < 4; ++j) { const int col = lane * 4 + 256 * j; const f32x4 gg = *(const f32x4*)(g + col), bb = *(const f32x4*)(b + col);
            const f32x4 y = v[j] * rstd * gg + bb; if (out) *(f32x4*)(out + (size_t)t * 1024 + col) = y;
            u32x2 w; w.x = cvt_pk_bf16(y[0], y[1]); w.y = cvt_pk_bf16(y[2], y[3]); *(u32x2*)(c.xbf + (size_t)t * 1024 + col) = w; }
    }
#undef CMB_SLOTS
#undef CMB_ROWS
}
namespace ssd {
constexpr int PITCH = 272;
constexpr int XST_OFF = 0;
constexpr int R1_OFF = 69632;
constexpr int R2_OFF = 104448;
constexpr int S1_VEC = 104448;
constexpr int S3_VEC = 139264;
constexpr int NC = 64;
__device__ __forceinline__ size_t st_index(int dir, int b, int cidx, int h) { return ((((size_t)dir * 2 + b) * NC + cidx) * 32 + h) * 8192; }

__device__ __forceinline__ float softplus_fast(float x) { const float e = __expf(-fabsf(x)); return fmaxf(x, 0.0f) + (e < 1e-3f ? e * (1.0f - 0.5f * e) : __logf(1.0f + e)); }

__device__ __forceinline__ float cumsum8(LAS float* a, int wave, int lane) {
    LAS float* p = a + wave * 128 + 2 * lane;
    const float a0 = p[0], a1 = p[1];
    float v = a0 + a1;
#pragma unroll
    for (int off = 1; off < 64; off <<= 1) { const float t = __int_as_float(__builtin_amdgcn_ds_bpermute((lane - off) << 2, __float_as_int(v))); if (lane >= off) v += t; }
    const float total = __int_as_float(__builtin_amdgcn_readlane(__float_as_int(v), 63));
    if (wave < 4) { p[0] = v - a1; p[1] = v; } else { p[0] = total - (v - a1 - a0); p[1] = total - (v - a1); }
    return total;
}
template <int MODE>
__device__ __forceinline__ void load_conv(const Ctx& c, int l, int b, int cidx, int g, LAS unsigned char* lds, int tid) {
    const int cg = tid & 63, lg = tid >> 6;
    if (MODE == 1 && cg >= 48) return;
    const int col = cg < 32 ? 256 * g + 8 * cg : (cg < 48 ? 2048 + 128 * g + 8 * (cg - 32) : 3072 + 128 * g + 8 * (cg - 48));
    const float* cw = c.in[I_CONVW] + (size_t)l * 5 * 4096 + col; const float* cb = c.in[I_CONVB] + (size_t)l * 4096 + col;
    float w[5][8], bias[8];
#pragma unroll
    for (int k = 0; k < 5; ++k) { const f32x4 a = *(const f32x4*)(cw + k * 4096), bq = *(const f32x4*)(cw + k * 4096 + 4);
        w[k][0] = a[0]; w[k][1] = a[1]; w[k][2] = a[2]; w[k][3] = a[3]; w[k][4] = bq[0]; w[k][5] = bq[1]; w[k][6] = bq[2]; w[k][7] = bq[3]; }
    { const f32x4 a = *(const f32x4*)cb, bq = *(const f32x4*)(cb + 4); bias[0] = a[0]; bias[1] = a[1]; bias[2] = a[2]; bias[3] = a[3]; bias[4] = bq[0]; bias[5] = bq[1]; bias[6] = bq[2]; bias[7] = bq[3]; }
    const int tl0 = cidx * 128 + lg * 16 - 2;
    const bf16_t* src = c.XBCb + ((size_t)b * 8192) * 4096 + col;
    u32x4 rows[20];
#pragma unroll
    for (int i = 0; i < 20; ++i) { const int tl = tl0 + i; rows[i] = (tl >= 0 && tl < 8192) ? *(const u32x4*)(src + (size_t)tl * 4096) : uzero4(); }
    unsigned outp[8][8];
#pragma unroll
    for (int lo = 0; lo < 16; lo += 2) {
        float v[2][8];
#pragma unroll
        for (int d = 0; d < 2; ++d) {
#pragma unroll
            for (int j = 0; j < 8; ++j) v[d][j] = bias[j];
#pragma unroll
            for (int k = 0; k < 5; ++k) { const u32x4 r = rows[lo + d + k];
                v[d][0] += w[k][0] * bflo(r.x); v[d][1] += w[k][1] * bfhi(r.x); v[d][2] += w[k][2] * bflo(r.y); v[d][3] += w[k][3] * bfhi(r.y);
                v[d][4] += w[k][4] * bflo(r.z); v[d][5] += w[k][5] * bfhi(r.z); v[d][6] += w[k][6] * bflo(r.w); v[d][7] += w[k][7] * bfhi(r.w); }
#pragma unroll
            for (int j = 0; j < 8; ++j) v[d][j] = v[d][j] * fast_sigmoid(v[d][j]);
        }
        if (MODE == 3 && cg >= 32) {
            LAS unsigned char* base = lds + (cg < 48 ? R2_OFF : R1_OFF) + (8 * (cg < 48 ? cg - 32 : cg - 48)) * 2;
#pragma unroll
            for (int d = 0; d < 2; ++d) { f32x4 v0 = (f32x4){v[d][0], v[d][1], v[d][2], v[d][3]}, v1 = (f32x4){v[d][4], v[d][5], v[d][6], v[d][7]};
                *(LAS u32x4*)(base + (lg * 16 + lo + d) * PITCH) = pack8(v0, v1); }
        } else {
#pragma unroll
            for (int j = 0; j < 8; ++j) outp[j][lo >> 1] = cvt_pk_bf16(v[0][j], v[1][j]);
        }
    }
    if (!(MODE == 3 && cg >= 32)) {
        LAS unsigned char* base = lds + (cg < 32 ? XST_OFF + (8 * cg) * PITCH : R1_OFF + (8 * (cg - 32)) * PITCH) + (lg * 16) * 2;
#pragma unroll
        for (int j = 0; j < 8; ++j) { *(LAS u32x4*)(base + j * PITCH) = (u32x4){outp[j][0], outp[j][1], outp[j][2], outp[j][3]}; *(LAS u32x4*)(base + j * PITCH + 16) = (u32x4){outp[j][4], outp[j][5], outp[j][6], outp[j][7]}; }
    }
}

__device__ __forceinline__ void phase_s1(const Ctx& c, int l, LAS unsigned char* lds) {
    int tid = threadIdx.x;
    LAS float* dl = (LAS float*)(lds + S1_VEC); LAS float* ac = dl + 1024; LAS float* wv = ac + 1024;
    for (int item_ = blockIdx.x; item_ < 1024; item_ += c.grid) { const int item = 1023 - item_;
        asm volatile("" : "+v"(tid));
        const int wave = __builtin_amdgcn_readfirstlane(tid >> 6), lane = tid & 63, fr = lane & 15, q = lane >> 4;
        const int g = item & 7, cidx = (item >> 3) & 63, b = item >> 9; const size_t t0 = (size_t)b * 8192 + cidx * 128;
        load_conv<1>(c, l, b, cidx, g, lds, tid);
#pragma unroll
        for (int k = 0; k < 2; ++k) { const int e = tid + 512 * k, dir = e >> 9, r = (e >> 7) & 3, ll = e & 127, h = 4 * g + r;
            const float delta = softplus_fast(c.dtf[(t0 + ll) * 64 + dir * 32 + h] + c.in[I_DTB][l * 64 + dir * 32 + h]);
            dl[e] = delta; ac[e] = -__expf(c.in[I_ALOG][l * 64 + dir * 32 + h]) * delta; }
        __syncthreads();
        { const float tot = cumsum8(ac, wave, lane); if (lane == 0) c.ssd_tot[(((wave >> 2) * 2 + b) * NC + cidx) * 32 + 4 * g + (wave & 3)] = tot; }
        __syncthreads();
#pragma unroll
        for (int k = 0; k < 2; ++k) { const int e = tid + 512 * k, dir = e >> 9; const float tot = ac[(e & ~127) + (dir ? 0 : 127)]; wv[e] = dl[e] * __expf(tot - ac[e]); }
        __syncthreads();
        {
            const int r = wave & 3, dir = wave >> 2;
            f32x4 acc[8][4];
#pragma unroll
            for (int nt = 0; nt < 8; ++nt)
#pragma unroll
                for (int pt = 0; pt < 4; ++pt) acc[nt][pt] = zero4();
#pragma unroll
            for (int k = 0; k < 4; ++k) {
                const LAS float* wp = wv + (dir * 4 + r) * 128 + 32 * k + 8 * q;
                const f32x4 w0 = *(const LAS f32x4*)wp, w1 = *(const LAS f32x4*)(wp + 4);
                bf16x8 bfrag[4];
#pragma unroll
                for (int pt = 0; pt < 4; ++pt) { const u32x4 x = *(const LAS u32x4*)(lds + XST_OFF + (r * 64 + 16 * pt + fr) * PITCH + (32 * k + 8 * q) * 2);
                    u32x4 y; y.x = cvt_pk_bf16(bflo(x.x) * w0[0], bfhi(x.x) * w0[1]); y.y = cvt_pk_bf16(bflo(x.y) * w0[2], bfhi(x.y) * w0[3]);
                    y.z = cvt_pk_bf16(bflo(x.z) * w1[0], bfhi(x.z) * w1[1]); y.w = cvt_pk_bf16(bflo(x.w) * w1[2], bfhi(x.w) * w1[3]);
                    bfrag[pt] = __builtin_bit_cast(bf16x8, y); }
#pragma unroll
                for (int nt = 0; nt < 8; ++nt) { const bf16x8 af = *(const LAS bf16x8*)(lds + R1_OFF + (16 * nt + fr) * PITCH + (32 * k + 8 * q) * 2);
#pragma unroll
                    for (int pt = 0; pt < 4; ++pt) acc[nt][pt] = __builtin_amdgcn_mfma_f32_16x16x32_bf16(af, bfrag[pt], acc[nt][pt], 0, 0, 0); }
            }
            bf16_t* So = c.ssd_S + st_index(dir, b, cidx, 4 * g + r);
#pragma unroll
            for (int nt = 0; nt < 8; ++nt)
#pragma unroll
                for (int pt = 0; pt < 4; ++pt) { u32x2 o; o.x = cvt_pk_bf16(acc[nt][pt][0], acc[nt][pt][1]); o.y = cvt_pk_bf16(acc[nt][pt][2], acc[nt][pt][3]);
                    *(u32x2*)(So + (size_t)(16 * pt + fr) * 128 + 16 * nt + 4 * q) = o; }
        }
        __syncthreads();
    }
}
__device__ __forceinline__ void phase_s2(const Ctx& c) {
    int tid = threadIdx.x; asm volatile("" : "+v"(tid));
    for (int i = blockIdx.x * NTHREADS + tid; i < 2 * 2 * 32 * 64 * 16; i += c.grid * NTHREADS) {
        const int n8 = i & 15, p = (i >> 4) & 63, h = (i >> 10) & 31, b = (i >> 15) & 1, dir = i >> 16;
        float st[8];
#pragma unroll
        for (int j = 0; j < 8; ++j) st[j] = 0.f;
#pragma unroll 1
        for (int s0 = 0; s0 < NC; s0 += 8) {
            u32x4 x[8]; float dec[8];
#pragma unroll
            for (int u = 0; u < 8; ++u) { const int cidx = dir ? NC - 1 - (s0 + u) : s0 + u;
                x[u] = *(const u32x4*)(c.ssd_S + st_index(dir, b, cidx, h) + p * 128 + n8 * 8); dec[u] = c.ssd_tot[((dir * 2 + b) * NC + cidx) * 32 + h]; }
#pragma unroll
            for (int u = 0; u < 8; ++u) { const int cidx = dir ? NC - 1 - (s0 + u) : s0 + u; const float dq = __expf(dec[u]);
                *(u32x4*)(c.ssd_S + st_index(dir, b, cidx, h) + p * 128 + n8 * 8) = pack8((f32x4){st[0], st[1], st[2], st[3]}, (f32x4){st[4], st[5], st[6], st[7]});
                st[0] = st[0] * dq + bflo(x[u].x); st[1] = st[1] * dq + bfhi(x[u].x); st[2] = st[2] * dq + bflo(x[u].y); st[3] = st[3] * dq + bfhi(x[u].y);
                st[4] = st[4] * dq + bflo(x[u].z); st[5] = st[5] * dq + bfhi(x[u].z); st[6] = st[6] * dq + bflo(x[u].w); st[7] = st[7] * dq + bfhi(x[u].w); }
        }
    }
}
template <bool ZRAW>
__device__ __forceinline__ void phase_s3(const Ctx& c, int l, LAS unsigned char* lds) {
    int tid = threadIdx.x;
    LAS float* acf = (LAS float*)(lds + S3_VEC); LAS float* rcb = acf + 512; LAS float* gf = rcb + 512; LAS float* gb = gf + 512; LAS float* dl = gb + 512; LAS float* ssq = dl + 1024;
    for (int item = blockIdx.x; item < 1024; item += c.grid) {
        asm volatile("" : "+v"(tid));
        const int wave = __builtin_amdgcn_readfirstlane(tid >> 6), lane = tid & 63, fr = lane & 15, q = lane >> 4;
        const int g = item & 7, cidx = (item >> 3) & 63, b = item >> 9; const size_t t0 = (size_t)b * 8192 + cidx * 128;
        const int hrow = tid >> 2, hpart = tid & 3;
        u32x4 hreg[4];
        { const bf16_t* src = c.ssd_S + st_index(hrow >> 6, b, cidx, 4 * g) + (size_t)(hrow & 63) * 128 + hpart * 32;
            hreg[0] = *(const u32x4*)src; hreg[1] = *(const u32x4*)(src + 8); hreg[2] = *(const u32x4*)(src + 16); hreg[3] = *(const u32x4*)(src + 24); }
        load_conv<3>(c, l, b, cidx, g, lds, tid);
#pragma unroll
        for (int k = 0; k < 2; ++k) { const int e = tid + 512 * k, dir = e >> 9, r = (e >> 7) & 3, ll = e & 127, h = 4 * g + r;
            const float delta = softplus_fast(c.dtf[(t0 + ll) * 64 + dir * 32 + h] + c.in[I_DTB][l * 64 + dir * 32 + h]);
            dl[e] = delta; acf[e] = -__expf(c.in[I_ALOG][l * 64 + dir * 32 + h]) * delta; }
        __syncthreads();
        (void)cumsum8(acf, wave, lane);
        __syncthreads();
#pragma unroll
        for (int k = 0; k < 2; ++k) { const int e = tid + 512 * k; gf[e] = __logf(dl[e]) - acf[e]; }
        __syncthreads();
        const int lrow = 16 * wave + fr;
        bf16x8 cfrag[4];
#pragma unroll
        for (int k = 0; k < 4; ++k) cfrag[k] = *(const LAS bf16x8*)(lds + R1_OFF + lrow * PITCH + (32 * k + 8 * q) * 2);
        f32x4 cbt[8];
#pragma unroll
        for (int a = 0; a < 8; ++a) { cbt[a] = zero4();
#pragma unroll
            for (int k = 0; k < 4; ++k) { const bf16x8 bf = *(const LAS bf16x8*)(lds + R2_OFF + (16 * a + fr) * PITCH + (32 * k + 8 * q) * 2);
                cbt[a] = __builtin_amdgcn_mfma_f32_16x16x32_bf16(bf, cfrag[k], cbt[a], 0, 0, 0); } }
        __syncthreads();
        float ssq_l = 0.f;
#pragma unroll 1
        for (int r = 0; r < 4; ++r) {
            const int h = 4 * g + r;
            LAS unsigned char* hb = lds + ((r & 1) ? R1_OFF : R2_OFF);
            { LAS u32x4* dst = (LAS u32x4*)(hb + hrow * PITCH + hpart * 64); dst[0] = hreg[0]; dst[1] = hreg[1]; dst[2] = hreg[2]; dst[3] = hreg[3]; }
            if (r < 3) { const bf16_t* src = c.ssd_S + st_index(hrow >> 6, b, cidx, h + 1) + (size_t)(hrow & 63) * 128 + hpart * 32;
                hreg[0] = *(const u32x4*)src; hreg[1] = *(const u32x4*)(src + 8); hreg[2] = *(const u32x4*)(src + 16); hreg[3] = *(const u32x4*)(src + 24); }
            const size_t trow = t0 + lrow;
            u32x2 zpre[4];
#pragma unroll
            for (int pt = 0; pt < 4; ++pt) zpre[pt] = *(const u32x2*)(c.Zb + trow * 2048 + h * 64 + 16 * pt + 4 * q);
            const float af_l = acf[r * 128 + lrow], rb_l = rcb[r * 128 + lrow], dsk = c.in[I_SSDD][l * 32 + h];
            bf16x8 mfrag[4];
#pragma unroll
            for (int kk = 0; kk < 4; ++kk) {
                float m[8];
#pragma unroll
                for (int half = 0; half < 2; ++half) { const int a = 2 * kk + half, s0 = 16 * a + 4 * q;
                    if (a < wave) {
                        const f32x4 gfv = *(const LAS f32x4*)(gf + r * 128 + s0);
#pragma unroll
                        for (int j = 0; j < 4; ++j) m[half * 4 + j] = cbt[a][j] * __expf(af_l + gfv[j]);
                    } else if (a > wave) {
                        const f32x4 gbv = *(const LAS f32x4*)(gb + r * 128 + s0);
#pragma unroll
                        for (int j = 0; j < 4; ++j) m[half * 4 + j] = cbt[a][j] * __expf(rb_l + gbv[j]);
                    } else {
                        const f32x4 gfv = *(const LAS f32x4*)(gf + r * 128 + s0), gbv = *(const LAS f32x4*)(gb + r * 128 + s0);
#pragma unroll
                        for (int j = 0; j < 4; ++j) { const int s = s0 + j;
                            const float tf = (s <= lrow) ? __expf(af_l + gfv[j]) : 0.f, tb = (s >= lrow) ? __expf(rb_l + gbv[j]) : 0.f;
                            m[half * 4 + j] = cbt[a][j] * (tf + tb) + ((s == lrow) ? dsk : 0.f); } } }
                u32x4 y; y.x = cvt_pk_bf16(m[0], m[1]); y.y = cvt_pk_bf16(m[2], m[3]); y.z = cvt_pk_bf16(m[4], m[5]); y.w = cvt_pk_bf16(m[6], m[7]);
                mfrag[kk] = __builtin_bit_cast(bf16x8, y);
            }
            __syncthreads();
            const float ef = __expf(af_l), eb = __expf(rb_l);
#pragma unroll 1
            for (int ph = 0; ph < 2; ++ph) {
                f32x4 accd[2], accf[2], accb[2];
#pragma unroll
                for (int p2 = 0; p2 < 2; ++p2) { accd[p2] = zero4(); accf[p2] = accd[p2]; accb[p2] = accd[p2]; }
#pragma unroll
                for (int kk = 0; kk < 4; ++kk)
#pragma unroll
                    for (int p2 = 0; p2 < 2; ++p2) { const int pt = 2 * ph + p2;
                        const LAS unsigned char* xr = lds + XST_OFF + (r * 64 + 16 * pt + fr) * PITCH + (32 * kk + 4 * q) * 2;
                        const u32x2 x0 = *(const LAS u32x2*)xr, x1 = *(const LAS u32x2*)(xr + 32);
                        const u32x4 xa = (u32x4){x0.x, x0.y, x1.x, x1.y};
                        accd[p2] = __builtin_amdgcn_mfma_f32_16x16x32_bf16(__builtin_bit_cast(bf16x8, xa), mfrag[kk], accd[p2], 0, 0, 0);
                        const bf16x8 hf = *(const LAS bf16x8*)(hb + (16 * pt + fr) * PITCH + (32 * kk + 8 * q) * 2);
                        const bf16x8 hbk = *(const LAS bf16x8*)(hb + (64 + 16 * pt + fr) * PITCH + (32 * kk + 8 * q) * 2);
                        accf[p2] = __builtin_amdgcn_mfma_f32_16x16x32_bf16(hf, cfrag[kk], accf[p2], 0, 0, 0);
                        accb[p2] = __builtin_amdgcn_mfma_f32_16x16x32_bf16(hbk, cfrag[kk], accb[p2], 0, 0, 0);
                    }
#pragma unroll
                for (int p2 = 0; p2 < 2; ++p2) { const int pt = 2 * ph + p2;
                    const int col = h * 64 + 16 * pt + 4 * q;
                    const u32x2 zw = p2 ? (ph ? zpre[3] : zpre[1]) : (ph ? zpre[2] : zpre[0]);
                    float zz[4] = {bflo(zw.x), bfhi(zw.x), bflo(zw.y), bfhi(zw.y)}, yv[4];
#pragma unroll
                    for (int j = 0; j < 4; ++j) { const float zg = ZRAW ? zz[j] * fast_sigmoid(zz[j]) : zz[j]; yv[j] = (accd[p2][j] + ef * accf[p2][j] + eb * accb[p2][j]) * zg; ssq_l += yv[j] * yv[j]; }
                    u32x2 o; o.x = cvt_pk_bf16(yv[0], yv[1]); o.y = cvt_pk_bf16(yv[2], yv[3]);
                    *(u32x2*)(c.yssdb + trow * 2048 + col) = o;
                }
            }
        }
        ssq[lrow * 4 + q] = ssq_l;
        __syncthreads();
        if (tid < 128) c.ssd_ssq[(t0 + tid) * 8 + g] = (ssq[tid * 4] + ssq[tid * 4 + 1]) + (ssq[tid * 4 + 2] + ssq[tid * 4 + 3]);
        __syncthreads();
    }
}
}
namespace s5 {
constexpr int NROWS = 72 * 1024;
__device__ __forceinline__ void prologue(const Ctx& c, int l, int par, LAS unsigned char* lds, int first_wg, int n_wg, int g0, int g1) {
    int tid = threadIdx.x; asm volatile("" : "+v"(tid));
    LAS float* pw = (LAS float*)lds;
    LAS float* bb = pw + 2 * 17 * 64 * 2;
    LAS float* cc = bb + 2 * 64 * 16 * 2;
    LAS float* Kt = cc + 2 * 16 * 130;
    __syncthreads();
    for (int g = (int)blockIdx.x >= first_wg ? g0 + (int)blockIdx.x - first_wg : g1; g < g1; g += n_wg) {
        if (tid < 128) { const int d = tid >> 6, n = tid & 63;
            const float ar = c.in[I_S5ARE][((size_t)(l * 2 + d) * 72 + g) * 64 + n], ai = c.in[I_S5AIM][((size_t)(l * 2 + d) * 72 + g) * 64 + n];
            const float step = __expf(c.in[I_S5LS][(l * 2 + d) * 72 + g]);
            const float mag = __expf(step * ar); const float abr = mag * __cosf(step * ai), abi = mag * __sinf(step * ai);
            const float rden = __builtin_amdgcn_rcpf(ar * ar + ai * ai); const float fr = ((abr - 1.0f) * ar + abi * ai) * rden, fi = (abi * ar - (abr - 1.0f) * ai) * rden;
            { const float* brp = c.in[I_S5BRE] + (((size_t)l * 72 + g) * 64 + n) * 16; const float* bip = c.in[I_S5BIM] + (((size_t)l * 72 + g) * 64 + n) * 16;
              f32x4 brv[4], biv[4];
#pragma unroll
              for (int q4 = 0; q4 < 4; ++q4) { brv[q4] = *(const f32x4*)(brp + 4 * q4); biv[q4] = *(const f32x4*)(bip + 4 * q4); }
#pragma unroll
              for (int ch = 0; ch < 16; ++ch) { const float br = brv[ch >> 2][ch & 3], bi = biv[ch >> 2][ch & 3];
                  bb[((d * 64 + n) * 16 + ch) * 2] = fr * br - fi * bi; bb[((d * 64 + n) * 16 + ch) * 2 + 1] = fr * bi + fi * br; } }
            float pr = 1.0f, pi = 0.0f;
#pragma clang loop unroll(disable)
            for (int j = 0; j <= 16; ++j) { pw[((d * 17 + j) * 64 + n) * 2] = pr; pw[((d * 17 + j) * 64 + n) * 2 + 1] = pi; const float nr = pr * abr - pi * abi, ni = pr * abi + pi * abr; pr = nr; pi = ni; }
            float* a16 = c.s5_a16 + par * wsz::A16; a16[((g * 2 + d) * 64 + n) * 2] = pw[((d * 17 + 16) * 64 + n) * 2]; a16[((g * 2 + d) * 64 + n) * 2 + 1] = pw[((d * 17 + 16) * 64 + n) * 2 + 1]; }
        for (int i = tid; i < 2 * 16 * 64; i += NTHREADS) { const int d = i >> 10, ch = (i >> 6) & 15, n = i & 63;
            cc[(d * 16 + ch) * 130 + n * 2] = c.in[I_S5CRE][(((size_t)(l * 2 + d) * 72 + g) * 16 + ch) * 64 + n]; cc[(d * 16 + ch) * 130 + n * 2 + 1] = c.in[I_S5CIM][(((size_t)(l * 2 + d) * 72 + g) * 16 + ch) * 64 + n]; }
        __syncthreads();
        { const int lane = tid & 63, wv = __builtin_amdgcn_readfirstlane(tid >> 6), d = wv >> 2, r16 = lane & 15, kq = lane >> 4;
          float bre[16], bim[16];
#pragma unroll
          for (int sidx = 0; sidx < 16; ++sidx) { const LAS float* bp = bb + ((d * 64 + 4 * sidx + kq) * 16 + r16) * 2; bre[sidx] = bp[0]; bim[sidx] = bp[1]; }
#pragma clang loop unroll(disable)
          for (int jj = 0; jj < 4; ++jj) { const int j = 4 * (wv & 3) + jj; f32x4 acc = zero4();
#pragma unroll
              for (int sidx = 0; sidx < 16; ++sidx) { const int n = 4 * sidx + kq;
                  const float cr = cc[(d * 16 + r16) * 130 + n * 2], ci = cc[(d * 16 + r16) * 130 + n * 2 + 1], pr = pw[((d * 17 + j) * 64 + n) * 2], pi = pw[((d * 17 + j) * 64 + n) * 2 + 1];
                  const float wr = cr * pr - ci * pi, wi = cr * pi + ci * pr;
                  acc = __builtin_amdgcn_mfma_f32_16x16x4f32(wr, bre[sidx], acc, 0, 0, 0); acc = __builtin_amdgcn_mfma_f32_16x16x4f32(-wi, bim[sidx], acc, 0, 0, 0); }
#pragma unroll
              for (int r = 0; r < 4; ++r) Kt[((d * 16 + j) * 16 + 4 * kq + r) * 16 + r16] = acc[r]; } }
        __syncthreads();
        bf16_t* W1 = c.s5_W1 + par * wsz::S5W1 + (size_t)g * 512 * 256; bf16_t* Qm = c.s5_Q + par * wsz::S5Q + (size_t)g * 256 * 256;
        for (int i = tid; i < 256 * 256 / 2; i += NTHREADS) { const int row = i >> 7, col = (i & 127) * 2; const int l1 = row >> 4, c1 = row & 15, l2 = col >> 4, c2 = col & 15; float v[2];
#pragma unroll
            for (int e = 0; e < 2; ++e) { float s = 0.f; if (l2 <= l1) s += Kt[((0 * 16 + (l1 - l2)) * 16 + c1) * 16 + c2 + e]; if (l2 >= l1) s += Kt[((1 * 16 + (l2 - l1)) * 16 + c1) * 16 + c2 + e]; v[e] = s; }
            *(unsigned*)(W1 + (size_t)row * 256 + col) = cvt_pk_bf16(v[0], v[1]); }
        for (int i = tid; i < 256 * 256 / 2; i += NTHREADS) { const int row = i >> 7, col = (i & 127) * 2; const int d = row >> 7, part = (row >> 6) & 1, n = row & 63, l2 = col >> 4, c2 = col & 15;
            const int j = d ? l2 : 15 - l2; const float pr = pw[((d * 17 + j) * 64 + n) * 2], pi = pw[((d * 17 + j) * 64 + n) * 2 + 1]; float v[2];
#pragma unroll
            for (int e = 0; e < 2; ++e) { const float br = bb[((d * 64 + n) * 16 + c2 + e) * 2], bi = bb[((d * 64 + n) * 16 + c2 + e) * 2 + 1]; v[e] = part ? (pr * bi + pi * br) : (pr * br - pi * bi); }
            *(unsigned*)(W1 + (size_t)(256 + row) * 256 + col) = cvt_pk_bf16(v[0], v[1]); }
        for (int i = tid; i < 256 * 256 / 2; i += NTHREADS) { const int row = i >> 7, col = (i & 127) * 2; const int l1 = row >> 4, c1 = row & 15, d = col >> 7, part = (col >> 6) & 1, n = col & 63;
            const int j = d ? 16 - l1 : l1 + 1; float v[2];
#pragma unroll
            for (int e = 0; e < 2; ++e) { const float cr = cc[(d * 16 + c1) * 130 + (n + e) * 2], ci = cc[(d * 16 + c1) * 130 + (n + e) * 2 + 1], pr = pw[((d * 17 + j) * 64 + n + e) * 2], pi = pw[((d * 17 + j) * 64 + n + e) * 2 + 1];
                v[e] = part ? -(cr * pi + ci * pr) : (cr * pr - ci * pi); }
            *(unsigned*)(Qm + (size_t)row * 256 + col) = cvt_pk_bf16(v[0], v[1]); }
        __syncthreads();
    }
}
struct Order { int nunits, G, c, lgN, rev, mode;
    __device__ __forceinline__ int late_cnt() const { return (nunits > G && nunits <= 2 * G) ? nunits - G : 0; }
    __device__ __forceinline__ bool next(int i, gx::Unit& u) const {
        long L = (long)i * G + c; const int lc = late_cnt();
        if (mode == 2) { const int g3 = 576 % G, off = (g3 + lc <= G) ? g3 : 0, j = c - off; if (i > 0 || j < 0 || j >= lc) return false; L = G + j; }
        else if (L >= nunits || (mode == 1 && lc > 0 && i > 0)) return false;
        int id = xcd_chunk(L, nunits); if (rev) id = nunits - 1 - id; u.pm = (int)(id >> lgN); u.pn = (int)(id & ((1 << lgN) - 1)); u.e = u.pm >> 2; u.f = (mode == 2) ? 1 : 0; return true; } };
struct Epi1 {
    static constexpr bool PERM = true;
    bf16_t* Y; bf16_t* S;
    __device__ __forceinline__ void operator()(const f32x4 (&acc)[2][2][4][2], const gx::Unit& u, int wr, int wc, int fr, int fq) const {
        const int row0 = u.pm * 256 + wr * 64 + fr, cl = wc * 32 + 8 * fq;
#pragma unroll
        for (int ai = 0; ai < 2; ++ai)
#pragma unroll
            for (int m = 0; m < 4; ++m)
#pragma unroll
                for (int bj = 0; bj < 2; ++bj) { const size_t off = (size_t)(row0 + ai * 128 + m * 16) * 256 + bj * 128 + cl;
                    *(u32x4*)((u.pn == 0 ? Y : S) + off) = pack8(acc[ai][bj][m][0], acc[ai][bj][m][1]); }
    }
};
__device__ __forceinline__ void scan(const Ctx& c, int par, LAS unsigned char* lds) {
    int tid = threadIdx.x; asm volatile("" : "+v"(tid)); const int nl = tid & 31, seg = tid >> 5;
    LAS float* seg_r = (LAS float*)lds; LAS float* seg_i = seg_r + 512;
    __syncthreads();
    for (int item = blockIdx.x; item < 576; item += c.grid) {
        const int nh = item & 1, d = (item >> 1) & 1, b = (item >> 2) & 1, g = item >> 3, n = nh * 32 + nl;
        const float ar = c.s5_a16[par * wsz::A16 + ((g * 2 + d) * 64 + n) * 2], ai = c.s5_a16[par * wsz::A16 + ((g * 2 + d) * 64 + n) * 2 + 1];
        const size_t base = ((size_t)g * 1024 + b * 512) * 256 + d * 128 + n;
        float lr[32], li[32];
#pragma unroll
        for (int j = 0; j < 32; ++j) { const int p = 32 * seg + j; const size_t o = base + (size_t)(d ? 511 - p : p) * 256; lr[j] = bf2f(c.s5_Sloc[o]); li[j] = bf2f(c.s5_Sloc[o + 64]); }
        float sr = 0.f, si = 0.f;
#pragma unroll
        for (int j = 0; j < 32; ++j) { const float nr = ar * sr - ai * si + lr[j], ni = ar * si + ai * sr + li[j]; sr = nr; si = ni; }
        seg_r[seg * 32 + nl] = sr; seg_i[seg * 32 + nl] = si;
        float pr = ar, pi = ai;
#pragma unroll
        for (int q = 0; q < 5; ++q) { const float nr = pr * pr - pi * pi, ni = 2.0f * pr * pi; pr = nr; pi = ni; }
        __syncthreads();
        float cr = 0.f, ci = 0.f;
        for (int s2 = 0; s2 < seg; ++s2) { const float er = seg_r[s2 * 32 + nl], ei = seg_i[s2 * 32 + nl]; const float nr = pr * cr - pi * ci + er, ni = pr * ci + pi * cr + ei; cr = nr; ci = ni; }
        sr = cr; si = ci;
#pragma unroll
        for (int j = 0; j < 32; ++j) { const int p = 32 * seg + j; const size_t o = base + (size_t)(d ? 511 - p : p) * 256;
            c.s5_Sin[o] = (bf16_t)f2bf(sr); c.s5_Sin[o + 64] = (bf16_t)f2bf(si);
            const float nr = ar * sr - ai * si + lr[j], ni = ar * si + ai * sr + li[j]; sr = nr; si = ni; }
        __syncthreads();
    }
}
struct Epi2 {
    static constexpr bool PERM = true;
    const bf16_t* Y; const bf16_t* U; const float* dsk; bf16_t* O; int* done;
    __device__ __forceinline__ void operator()(const f32x4 (&acc)[2][2][4][2], const gx::Unit& u, int wr, int wc, int fr, int fq) const {
        const int row0 = u.pm * 256 + wr * 64 + fr, cl = wc * 32 + 8 * fq, g = u.e, c0 = cl & 15;
        const f32x4 d0 = *(const f32x4*)(dsk + g * 16 + c0), d1 = *(const f32x4*)(dsk + g * 16 + c0 + 4);
#pragma unroll
        for (int ai = 0; ai < 2; ++ai) {
            u32x4 yw[4][2], uw[4][2];
#pragma unroll
            for (int m = 0; m < 4; ++m)
#pragma unroll
                for (int bj = 0; bj < 2; ++bj) { const size_t off = (size_t)(row0 + ai * 128 + m * 16) * 256 + bj * 128 + cl; yw[m][bj] = *(const u32x4*)(Y + off); uw[m][bj] = *(const u32x4*)(U + off); }
#pragma unroll
            for (int m = 0; m < 4; ++m)
#pragma unroll
                for (int bj = 0; bj < 2; ++bj) { const int R = row0 + ai * 128 + m * 16, col = bj * 128 + cl; const int tok = (R & 1023) * 16 + (col >> 4);
                    const u32x4 y4 = yw[m][bj], u4 = uw[m][bj];
                    f32x4 v0 = acc[ai][bj][m][0] + (f32x4){bflo(y4.x), bfhi(y4.x), bflo(y4.y), bfhi(y4.y)} + d0 * (f32x4){bflo(u4.x), bfhi(u4.x), bflo(u4.y), bfhi(u4.y)};
                    f32x4 v1 = acc[ai][bj][m][1] + (f32x4){bflo(y4.z), bfhi(y4.z), bflo(y4.w), bfhi(y4.w)} + d1 * (f32x4){bflo(u4.z), bfhi(u4.z), bflo(u4.w), bfhi(u4.w)};
#pragma unroll
                    for (int j = 0; j < 4; ++j) { const float a = v0[j], bq = v1[j];
                        v0[j] = a * fast_sigmoid(1.5957691216f * (a + 0.044715f * a * a * a)); v1[j] = bq * fast_sigmoid(1.5957691216f * (bq + 0.044715f * bq * bq * bq)); }
                    const u32x4 w = pack8(v0, v1); bf16_t* dst = O + (size_t)tok * 1152 + g * 16 + c0;
                    if (u.f) {
                        __hip_atomic_store((unsigned long long*)dst, (unsigned long long)w.x | ((unsigned long long)w.y << 32), __ATOMIC_RELAXED, __HIP_MEMORY_SCOPE_AGENT);
                        __hip_atomic_store((unsigned long long*)dst + 1, (unsigned long long)w.z | ((unsigned long long)w.w << 32), __ATOMIC_RELAXED, __HIP_MEMORY_SCOPE_AGENT);
                    } else *(u32x4*)dst = w; }
        }
        if (u.f) { asm volatile("s_waitcnt vmcnt(0)" ::: "memory"); if ((fr | fq) == 0) (void)__hip_atomic_fetch_add(done, 1, __ATOMIC_RELAXED, __HIP_MEMORY_SCOPE_AGENT); }
    }
};
}
namespace att {
constexpr int KP = 144, VP = 776;
constexpr int K_OFF = 0, VT_OFF = 384 * KP;
typedef float f32x16 __attribute__((ext_vector_type(16)));
__device__ __forceinline__ f32x16 zero16() { float z = 0.f; asm volatile("" : "+v"(z)); return (f32x16){z, z, z, z, z, z, z, z, z, z, z, z, z, z, z, z}; }
__device__ __forceinline__ void phase(const Ctx& c, LAS unsigned char* lds) {
    int tid = threadIdx.x;
    for (int item = ((int)blockIdx.x + c.grid / 2) % c.grid; item < 1152; item += c.grid) {
        asm volatile("" : "+v"(tid));
        const int wave = __builtin_amdgcn_readfirstlane(tid >> 6), lane = tid & 63, lr = lane & 31, hh = lane >> 5;
        const int itm = 1151 - item;
        const int blk = itm & 31, rest = itm >> 5, h = rest % 6, g = (rest / 6) % 3, b = rest / 18;
        const int dil = g == 0 ? 1 : (g == 1 ? 4 : 16), ls = 8192 / dil, ipc = 32 / dil, r = blk / ipc, i0 = (blk % ipc) * 256;
        const float slope = __builtin_amdgcn_exp2f((float)(h * 3 + g + 1) * (-8.0f / 18.0f)) * (float)dil;
        const bf16_t* qkv = c.QKVU + (size_t)b * 8192 * 4608 + g * 384 + h * 64;
        for (int u = tid; u < 384 * 8; u += NTHREADS) { const int kl = u >> 3, part = u & 7, ik = i0 - 64 + kl;
            u32x4 v = uzero4();
            if (ik >= 0 && ik < ls) v = *(const u32x4*)(qkv + (size_t)(ik * dil + r) * 4608 + 1152 + part * 8);
            *(LAS u32x4*)(lds + K_OFF + kl * KP + part * 16) = v; }
        for (int u = tid; u < 192 * 8; u += NTHREADS) { const int part = u / 192, kp = u % 192, ik = i0 - 64 + 2 * kp;
            u32x4 v0 = uzero4(), v1 = v0;
            if (ik >= 0 && ik < ls) v0 = *(const u32x4*)(qkv + (size_t)(ik * dil + r) * 4608 + 2304 + part * 8);
            if (ik + 1 >= 0 && ik + 1 < ls) v1 = *(const u32x4*)(qkv + (size_t)((ik + 1) * dil + r) * 4608 + 2304 + part * 8);
            LAS unsigned char* dst = lds + VT_OFF + (part * 8) * VP + kp * 4;
            *(LAS unsigned*)(dst + 0 * VP) = (v0.x & 0xffffu) | (v1.x << 16); *(LAS unsigned*)(dst + 1 * VP) = (v0.x >> 16) | (v1.x & 0xffff0000u);
            *(LAS unsigned*)(dst + 2 * VP) = (v0.y & 0xffffu) | (v1.y << 16); *(LAS unsigned*)(dst + 3 * VP) = (v0.y >> 16) | (v1.y & 0xffff0000u);
            *(LAS unsigned*)(dst + 4 * VP) = (v0.z & 0xffffu) | (v1.z << 16); *(LAS unsigned*)(dst + 5 * VP) = (v0.z >> 16) | (v1.z & 0xffff0000u);
            *(LAS unsigned*)(dst + 6 * VP) = (v0.w & 0xffffu) | (v1.w << 16); *(LAS unsigned*)(dst + 7 * VP) = (v0.w >> 16) | (v1.w & 0xffff0000u); }
        const int q0 = 32 * wave, iq = i0 + q0 + lr;
        const size_t tq = (size_t)(iq * dil + r);
        bf16x8 qf[4];
#pragma unroll
        for (int ks = 0; ks < 4; ++ks) qf[ks] = *(const bf16x8*)(qkv + tq * 4608 + 16 * ks + 8 * hh);
        __syncthreads();
        f32x16 st[5];
#pragma unroll
        for (int kt = 0; kt < 5; ++kt) { st[kt] = zero16();
#pragma unroll
            for (int ks = 0; ks < 4; ++ks) { const bf16x8 kf = *(const LAS bf16x8*)(lds + K_OFF + (q0 + 32 * kt + lr) * KP + (16 * ks + 8 * hh) * 2);
                st[kt] = __builtin_amdgcn_mfma_f32_32x32x16_bf16(kf, qf[ks], st[kt], 0, 0, 0); } }
        float mx = -1e30f;
        int dlt = 4 * hh - lr; asm volatile("" : "+v"(dlt));
        const int ikb = i0 - 64 + q0 + 4 * hh;
#pragma unroll
        for (int kt = 0; kt < 5; ++kt)
#pragma unroll
            for (int reg = 0; reg < 16; ++reg) { const int kc = 32 * kt + (reg & 3) + 8 * (reg >> 2);
                const int d = kc - 64 + dlt, dist = d < 0 ? -d : d, ik = ikb + kc;
                const bool ok = dist <= 64 && ik >= 0 && ik < ls;
                const float s = ok ? st[kt][reg] * 0.125f - slope * (float)dist : -1e30f;
                st[kt][reg] = s; mx = fmaxf(mx, s); }
        mx = fmaxf(mx, __int_as_float(__builtin_amdgcn_ds_bpermute((lane ^ 32) << 2, __float_as_int(mx))));
        float sum = 0.f;
#pragma unroll
        for (int kt = 0; kt < 5; ++kt)
#pragma unroll
            for (int reg = 0; reg < 16; ++reg) { const float p = st[kt][reg] > -1e29f ? __expf(st[kt][reg] - mx) : 0.f; st[kt][reg] = p; sum += p; }
        sum += __int_as_float(__builtin_amdgcn_ds_bpermute((lane ^ 32) << 2, __float_as_int(sum)));
        f32x16 o[2];
#pragma unroll
        for (int dt = 0; dt < 2; ++dt) o[dt] = zero16();
#pragma unroll
        for (int kt = 0; kt < 5; ++kt)
#pragma unroll
            for (int s2 = 0; s2 < 2; ++s2) {
                u32x4 pw; pw.x = cvt_pk_bf16(st[kt][8 * s2 + 0], st[kt][8 * s2 + 1]); pw.y = cvt_pk_bf16(st[kt][8 * s2 + 2], st[kt][8 * s2 + 3]);
                pw.z = cvt_pk_bf16(st[kt][8 * s2 + 4], st[kt][8 * s2 + 5]); pw.w = cvt_pk_bf16(st[kt][8 * s2 + 6], st[kt][8 * s2 + 7]);
                const bf16x8 pf = __builtin_bit_cast(bf16x8, pw);
#pragma unroll
                for (int dt = 0; dt < 2; ++dt) { const LAS unsigned char* vp = lds + VT_OFF + (32 * dt + lr) * VP + (q0 + 32 * kt + 16 * s2 + 4 * hh) * 2;
                    const u32x2 a0 = *(const LAS u32x2*)vp, a1 = *(const LAS u32x2*)(vp + 16);
                    const u32x4 av = (u32x4){a0.x, a0.y, a1.x, a1.y};
                    o[dt] = __builtin_amdgcn_mfma_f32_32x32x16_bf16(__builtin_bit_cast(bf16x8, av), pf, o[dt], 0, 0, 0); }
            }
        const float inv = __builtin_amdgcn_rcpf(sum); const size_t tglob = (size_t)b * 8192 + tq;
        bf16_t* op = c.attob + ((size_t)g * 16384 + tglob) * 384 + h * 64;
#pragma unroll
        for (int dt = 0; dt < 2; ++dt)
#pragma unroll
            for (int rg = 0; rg < 4; ++rg) { u32x2 w; w.x = cvt_pk_bf16(o[dt][4 * rg + 0] * inv, o[dt][4 * rg + 1] * inv); w.y = cvt_pk_bf16(o[dt][4 * rg + 2] * inv, o[dt][4 * rg + 3] * inv);
                *(u32x2*)(op + 32 * dt + 8 * rg + 4 * hh) = w; }
        if (hh == 0) c.attlse[((size_t)g * 16384 + tglob) * 6 + h] = mx + __logf(sum);
        __syncthreads();
    }
}
__device__ __forceinline__ void combine(const Ctx& c, long i) {
    const int c8 = (int)(i % 48); const long t = i / 48; const int h = c8 >> 3;
    const float l0 = c.attlse[((size_t)0 * 16384 + t) * 6 + h], l1 = c.attlse[((size_t)1 * 16384 + t) * 6 + h], l2 = c.attlse[((size_t)2 * 16384 + t) * 6 + h];
    const float m = fmaxf(l0, fmaxf(l1, l2)); float w0 = __expf(l0 - m), w1 = __expf(l1 - m), w2 = __expf(l2 - m); const float inv = __builtin_amdgcn_rcpf(w0 + w1 + w2); w0 *= inv; w1 *= inv; w2 *= inv;
    const u32x4 a = *(const u32x4*)(c.attob + ((size_t)0 * 16384 + t) * 384 + c8 * 8), bq = *(const u32x4*)(c.attob + ((size_t)1 * 16384 + t) * 384 + c8 * 8), cq = *(const u32x4*)(c.attob + ((size_t)2 * 16384 + t) * 384 + c8 * 8);
    f32x4 v0, v1;
    v0[0] = w0 * bflo(a.x) + w1 * bflo(bq.x) + w2 * bflo(cq.x); v0[1] = w0 * bfhi(a.x) + w1 * bfhi(bq.x) + w2 * bfhi(cq.x);
    v0[2] = w0 * bflo(a.y) + w1 * bflo(bq.y) + w2 * bflo(cq.y); v0[3] = w0 * bfhi(a.y) + w1 * bfhi(bq.y) + w2 * bfhi(cq.y);
    v1[0] = w0 * bflo(a.z) + w1 * bflo(bq.z) + w2 * bflo(cq.z); v1[1] = w0 * bfhi(a.z) + w1 * bfhi(bq.z) + w2 * bfhi(cq.z);
    v1[2] = w0 * bflo(a.w) + w1 * bflo(bq.w) + w2 * bflo(cq.w); v1[3] = w0 * bfhi(a.w) + w1 * bfhi(bq.w) + w2 * bfhi(cq.w);
    *(u32x4*)(c.yattb + t * 384 + c8 * 8) = pack8(v0, v1);
}
}
namespace lnr {
constexpr int XP = 1028;
constexpr int PART_OFF = 16 * XP * 4, CNT_OFF = PART_OFF + 8 * 16 * 32 * 4, GB_OFF = CNT_OFF + 128;
__device__ __forceinline__ void phase(const Ctx& c, int l, LAS unsigned char* lds) {
    int tid = threadIdx.x; asm volatile("" : "+v"(tid)); const int wave = __builtin_amdgcn_readfirstlane(tid >> 6), lane = tid & 63;
    const bf16_t* xin = c.xbf;
    LAS float* xf = (LAS float*)lds; LAS float* part = (LAS float*)(lds + PART_OFF); LAS int* cnt_l = (LAS int*)(lds + CNT_OFF);
    float wreg[2][32];
    { const float* rw = c.in[I_RW] + (size_t)l * 1024 * 32 + (size_t)(128 * wave + 4 * (lane >> 4)) * 32 + (lane & 15);
#pragma unroll
      for (int s4 = 0; s4 < 8; ++s4)
#pragma unroll
        for (int i = 0; i < 4; ++i) { wreg[0][4 * s4 + i] = rw[(16 * s4 + i) * 32]; wreg[1][4 * s4 + i] = rw[(16 * s4 + i) * 32 + 16]; } }
    LAS float* gb = (LAS float*)(lds + GB_OFF);
    __syncthreads();
    for (int i = tid; i < 1024; i += NTHREADS) { gb[i] = c.in[I_LN1G][l * 1024 + i]; gb[1024 + i] = c.in[I_LN1B][l * 1024 + i]; }
    const float rbias = c.in[I_RB][l * 32 + (lane & 31)];
    __syncthreads();
    u32x2 xr[4], mr[4];
#define LNR_LOAD(tok) do { const size_t b0_ = (size_t)(tok) * 1024 + 4 * lane; _Pragma("unroll") for (int jq = 0; jq < 4; ++jq) { xr[jq] = *(const u32x2*)(xin + b0_ + 256 * jq); mr[jq] = *(const u32x2*)(c.mixb + b0_ + 256 * jq); } } while (0)
    if ((int)blockIdx.x < ox_T / 64) LNR_LOAD(blockIdx.x * 64 + wave * 2);
#pragma unroll 1
    for (int gi = blockIdx.x; gi < ox_T / 64; gi += c.grid) {
      if (tid < 32) cnt_l[tid] = 0;
#pragma unroll 1
      for (int q = 0; q < 4; ++q) {
        int tid2 = tid; asm volatile("" : "+v"(tid2)); const int lane = tid2 & 63;
#pragma unroll 1
        for (int tt = 0; tt < 2; ++tt) {
          const int t = gi * 64 + 16 * q + 2 * wave + tt;
          float x[16];
          const size_t base = (size_t)t * 1024 + 4 * lane; float s = 0.f;
#pragma unroll
          for (int jq = 0; jq < 4; ++jq) { x[4 * jq] = md::ALPHA * bflo(xr[jq].x) + bflo(mr[jq].x); x[4 * jq + 1] = md::ALPHA * bfhi(xr[jq].x) + bfhi(mr[jq].x);
              x[4 * jq + 2] = md::ALPHA * bflo(xr[jq].y) + bflo(mr[jq].y); x[4 * jq + 3] = md::ALPHA * bfhi(xr[jq].y) + bfhi(mr[jq].y); }
#pragma unroll
          for (int j = 0; j < 16; ++j) s += x[j];
          { const int tn = tt == 0 ? t + 1 : (q < 3 ? t + 15 : (gi + c.grid < ox_T / 64 ? (gi + c.grid) * 64 + 2 * wave : t)); LNR_LOAD(tn); }
          const float mean = wave_sum(s) * (1.0f / 1024.0f); float qq = 0.f;
#pragma unroll
          for (int j = 0; j < 16; ++j) { x[j] -= mean; qq += x[j] * x[j]; }
          float eps_ = md::EPS; asm volatile("" : "+v"(eps_));
          const float rstd = __builtin_amdgcn_rsqf(wave_sum(qq) * (1.0f / 1024.0f) + eps_);
          LAS float* xrow = xf + (2 * wave + tt) * XP + 4 * lane;
#pragma unroll
          for (int jq = 0; jq < 4; ++jq) { const f32x4 g4 = *(const LAS f32x4*)(gb + 4 * lane + 256 * jq), b4 = *(const LAS f32x4*)(gb + 1024 + 4 * lane + 256 * jq);
              f32x4 y; y[0] = x[4 * jq] * rstd * g4[0] + b4[0]; y[1] = x[4 * jq + 1] * rstd * g4[1] + b4[1]; y[2] = x[4 * jq + 2] * rstd * g4[2] + b4[2]; y[3] = x[4 * jq + 3] * rstd * g4[3] + b4[3];
              u32x2 w; w.x = cvt_pk_bf16(y[0], y[1]); w.y = cvt_pk_bf16(y[2], y[3]);
              *(u32x2*)(c.x1b + base + 256 * jq) = w; *(unsigned*)(c.x1q + base + 256 * jq) = pk4_fp8(y[0], y[1], y[2], y[3]);
              *(LAS f32x4*)(xrow + 256 * jq) = y; }
        }
        __syncthreads();
        {
            f32x4 acc0 = zero4(), acc1 = zero4();
            const LAS float* ap = xf + (lane & 15) * XP + 128 * wave + 4 * (lane >> 4);
#pragma unroll
            for (int s4 = 0; s4 < 8; ++s4) { const f32x4 av = *(const LAS f32x4*)(ap + 16 * s4);
#pragma unroll
                for (int i = 0; i < 4; ++i) { acc0 = __builtin_amdgcn_mfma_f32_16x16x4f32(av[i], wreg[0][4 * s4 + i], acc0, 0, 0, 0); acc1 = __builtin_amdgcn_mfma_f32_16x16x4f32(av[i], wreg[1][4 * s4 + i], acc1, 0, 0, 0); } }
            LAS float* pp = part + (wave * 16 + 4 * (lane >> 4)) * 32 + (lane & 15);
#pragma unroll
            for (int r = 0; r < 4; ++r) { pp[r * 32] = acc0[r]; pp[r * 32 + 16] = acc1[r]; }
        }
        __syncthreads();
        {
            const int tl = 2 * wave + (lane >> 5), t = gi * 64 + 16 * q + tl;
            float v1 = rbias;
#pragma unroll
            for (int w2 = 0; w2 < 8; ++w2) v1 += part[(w2 * 16 + tl) * 32 + (lane & 31)];
            float tv[4]; int ti[4]; float neg_ = -3.0e38f; asm volatile("" : "+v"(neg_));
#pragma unroll
            for (int k = 0; k < 4; ++k) {
                float m = v1;
                m = fmaxf(m, SWZ_XOR(m, 1)); m = fmaxf(m, SWZ_XOR(m, 2)); m = fmaxf(m, SWZ_XOR(m, 4)); m = fmaxf(m, SWZ_XOR(m, 8)); m = fmaxf(m, SWZ_XOR(m, 16));
                const unsigned long long mask = __ballot(v1 == m);
                const unsigned mh = (unsigned)(mask >> (lane & 32));
                const int first = __builtin_ctz(mh);
                tv[k] = m; ti[k] = first;
                if ((lane & 31) == first) v1 = neg_;
            }
            const float e1 = __expf(tv[1] - tv[0]), e2 = __expf(tv[2] - tv[0]), e3 = __expf(tv[3] - tv[0]); const float inv = __builtin_amdgcn_rcpf(1.0f + e1 + e2 + e3);
            const int kk = lane & 31;
            if (kk < 4) { const int te = kk == 0 ? ti[0] : (kk == 1 ? ti[1] : (kk == 2 ? ti[2] : ti[3]));
                c.gate[t * 4 + kk] = (kk == 0 ? 1.0f : (kk == 1 ? e1 : (kk == 2 ? e2 : e3))) * inv; c.topidx[t * 4 + kk] = te; atomicAdd((int*)(cnt_l + te), 1); }
        }
      }
      __syncthreads();
      if (tid < 32) c.moe_cnt[gi * 32 + tid] = cnt_l[tid];
      __syncthreads();
    }
}
#undef LNR_LOAD
}
#endif
typedef const __attribute__((address_space(4))) Ctx* CtxK;
#if defined(__HIP_DEVICE_COMPILE__)
__device__ __forceinline__ const Ctx* ctx_ptr() { CtxK p = (CtxK)__builtin_amdgcn_kernarg_segment_ptr(); asm volatile("" : "+s"(p)); return (const Ctx*)p; }
#endif
#define PH(...) do { const Ctx& c = *ctx_ptr(); __VA_ARGS__ } while (0)

#define RUN(bit, ...) do { PH(__VA_ARGS__); if (REPMASK & (1u << (bit))) PH(__VA_ARGS__); } while (0)
#define LDSP ((LAS unsigned char*)lds)
#ifndef NCV
#define NCV 0
#endif

__global__ void __launch_bounds__(NTHREADS, 2) mk_forward(Ctx cparam) {
#if defined(__HIP_DEVICE_COMPILE__)
    extern __shared__ __attribute__((aligned(16))) unsigned char lds[];
    volatile LAS unsigned* bst = (volatile LAS unsigned*)((LAS unsigned char*)lds + LDS_BYTES - 16);
    if (threadIdx.x == 0) { bst[0] = 0u; bst[1] = 0u; bst[2] = 0u; bst[3] = 0u; }
    __syncthreads();
    XcdBarrier bar = xcd_barrier_post(ctx_ptr()->bar, bst);
    const long T = ox_T; const int depth = ctx_ptr()->depth;
    for (int l = -1; l < depth; ++l) {
        const int par = l & 1;
        if (l >= 0) RUN(0, prologue_weights<false, true>(c, l, par, LDSP, 0, c.grid); );
        else PH( LOOP(T * 128, cvt_x8(c.in[I_X], c.xbf, i)); const u32x4 z4 = uzero4(); LOOP(128, *(u32x4*)(c.x1b + (size_t)ox_T * 1024 + i * 8) = z4); LOOP(1, c.moe_done[320] = 0); LOOP(64, *(u32x4*)(c.x1q + (size_t)ox_T * 1024 + i * 16) = z4); );
        if (l + 1 < depth) { RUN(0, prologue_weights<true, false>(c, l + 1, par ^ 1, LDSP, 0, c.grid); ); RUN(0, const bool sp = (l >= 0 && c.grid == 256);
                                 s5::prologue(c, l + 1, par ^ 1, LDSP, sp ? 192 : (c.grid >= 72 ? c.grid - 72 : 0), sp ? 64 : (c.grid >= 72 ? 72 : c.grid), 0, sp ? 0 : 72); ); }
        if (l >= 0) {
            PH( __syncthreads(); );
            RUN(1, gx::Gemm g{c.xbf, c.Win_t + par * wsz::WIN, 1024, 0}; gx::StaticOrder S; S.init(ox_T, 14080, c.grid, (int)blockIdx.x);
                   EpiInproj<false, true> E{c.Gb, c.Zb, c.XBCb, c.QKVU, c.dtf, c.in[I_BGATE] + (size_t)l * 3072, c.Ug};
                   gx::gemm_phase(LDSP, g, S, E); );
        }
        SYNC();
        if (l < 0) continue;
        RUN(3, att::phase(c, LDSP); );
        RUN(4, gx::Gemm g{c.Ug, c.s5_W1 + par * wsz::S5W1, 256, (size_t)512 * 256 * 2}; s5::Order S{576, c.grid, (int)blockIdx.x, 1, 1}; s5::Epi1 E{c.s5_Yl, c.s5_Sloc}; gx::gemm_phase(LDSP, g, S, E); );
        RUN(2, ssd::phase_s1(c, l, LDSP); );
        SYNC();
        RUN(5, s5::scan(c, par, LDSP); );
        RUN(5, LOOP(T * 48, att::combine(c, i)); );
        PH( ssd::phase_s2(c); );
        SYNC();
        RUN(6, ssd::phase_s3<true>(c, l, LDSP); );
#pragma clang loop unroll(disable)
        for (int ps = 1; ps <= 2; ++ps) {
            if (ps == 2) SYNC();
            PH( gx::Gemm g{c.s5_Sin, c.s5_Q + par * wsz::S5Q, 256, (size_t)256 * 256 * 2}; s5::Order S{288, c.grid, (int)blockIdx.x, 0, 0, ps}; s5::Epi2 E{c.s5_Yl, c.Ug, c.in[I_S5D] + (size_t)l * 1152, c.s5hb, c.moe_done + 320}; gx::gemm_phase(LDSP, g, S, E); );
        }
        if (l + 1 < depth && ctx_ptr()->grid == 256) PH( s5::prologue(c, l + 1, par ^ 1, LDSP, 96, 72, 0, 72); );
        RUN(9, gx::Gemm g{c.yssdb, c.Wbs_t + par * wsz::WBS, 2048, 0}; gx::StaticOrder S; S.init(ox_T, 1024, c.grid, (int)blockIdx.x); EpiBranch<0> E{c.Gb, c.mergedb, c.ssd_ssq}; gx::gemm_phase(LDSP, g, S, E); );
        PH( gx::Gemm g{c.yattb, c.Wba_t + par * wsz::WBA, 384, 0}; gx::StaticOrder S; S.init(ox_T, 1024, c.grid, (int)blockIdx.x); EpiBranch<1> E{c.Gb, c.mergedb, nullptr}; gx::gemm_phase(LDSP, g, S, E); );
        PH( const s5::Order S2{288, c.grid, (int)blockIdx.x, 0, 0, 2}; moe_wait_rows(c.moe_done, 320, (l + 1) * S2.late_cnt() * 8); );
        RUN(8, gx::Gemm g{c.s5hb, c.Wglu_t + par * wsz::WGLU, 1152, 0}; gx::StaticOrder S; S.init(ox_T, 2304, c.grid, (int)blockIdx.x); EpiGlu E{c.ys5b}; gx::gemm_phase(LDSP, g, S, E); );
        SYNC();
        RUN(10, gx::Gemm g{c.ys5b, c.Wb5_t + par * wsz::WB5, 1152, 0}; gx::StaticOrder S; S.init(ox_T, 1024, c.grid, (int)blockIdx.x); EpiBranch<2> E{c.Gb, c.mergedb, nullptr}; gx::gemm_phase(LDSP, g, S, E); );
        SYNC();
        RUN(11, gx::Gemm g{c.mergedb, c.Wout_t + par * wsz::WOUT, 1024, 0}; gx::StaticOrder S; S.init(ox_T, 1024, c.grid, (int)blockIdx.x); EpiBf16 E{c.mixb}; gx::gemm_phase(LDSP, g, S, E); );
        SYNC();
        RUN(12, lnr::phase(c, l, LDSP); );
        SYNC();
        RUN(13, moe_assign(c, LDSP); );
        SYNC();
        RUN(14, const int nb = moe_blocks(c, LDSP); int M, fi; moe_early(nb, c.grid, M, fi); gx::Gemm g{(const bf16_t*)c.x1q, c.Wgu_t, 512, (size_t)2048 * 1024};
                MoeOrder S{(const LAS int*)(LDSP + LDS_TAB), nb * 8, c.grid, (int)blockIdx.x, 3, 0, nb, M, fi};
                EpiSwiglu E{(unsigned char*)c.actb, c.in[I_BGU] + (size_t)l * 32 * 2048, c.moe_done}; gx::gemm_phase<EpiSwiglu, MoeOrder, true, true>(LDSP, g, S, E, c.slot_tok); );
#pragma clang loop unroll(disable)
        for (int ps = 1; ps <= 2; ++ps) {
            if (ps == 2) SYNC();
            RUN(15, const int nb = moe_blocks(c, LDSP); int M, fi; moe_early(nb, c.grid, M, fi); gx::Gemm g{c.actb, c.Wdn_t, 512, (size_t)1024 * 1024};
                    MoeOrder S{(const LAS int*)(LDSP + LDS_TAB), (nb - 8 * M) * 4, c.grid, (int)blockIdx.x, 2, ps, nb, M, fi};
                    gx::Unit u0; if (ps == 1 && S.next(0, u0)) moe_wait_rows(c.moe_done, u0.pm);
                    EpiDown E{c.ys2, c.in[I_BDN] + (size_t)l * 32 * 1024, c.slot_gate}; gx::gemm_phase<EpiDown, MoeOrder, false, true>(LDSP, g, S, E); );
        }
        SYNC();
        RUN(16, moe_combine_ln(c, c.in[I_LN2G] + l * 1024, c.in[I_LN2B] + l * 1024, (l == depth - 1) ? c.out : nullptr); );
        SYNC();
    }
#endif
}

extern "C" void kernel_launch(void* const* d_in, const int* in_sizes, int n_in, void* d_out, int out_size, void* d_ws, size_t ws_size, hipStream_t stream) {
    static int grid = 0;
    Ctx c;
    const size_t need = build_ctx(c, d_in, d_out, d_ws, 4);
    if (grid == 0) {
        if (n_in != N_INPUTS || out_size != 2 * 8192 * 1024 || ws_size < need) { fprintf(stderr, "kernel_launch: unexpected shapes (n_in %d out %d ws %zu need %zu)\n", n_in, out_size, ws_size, need); grid = -1; return; }
        int dev = 0, cus = 0, per_cu = 0;
        (void)hipGetDevice(&dev); (void)hipDeviceGetAttribute(&cus, hipDeviceAttributeMultiprocessorCount, dev);
        if (hipFuncSetAttribute((const void*)mk_forward, hipFuncAttributeMaxDynamicSharedMemorySize, LDS_BYTES) != hipSuccess) { fprintf(stderr, "kernel_launch: hipFuncSetAttribute failed\n"); grid = -1; return; }
        if (hipOccupancyMaxActiveBlocksPerMultiprocessor(&per_cu, (const void*)mk_forward, NTHREADS, LDS_BYTES) != hipSuccess || per_cu < 1) { fprintf(stderr, "kernel_launch: occupancy query says %d\n", per_cu); grid = -1; return; }
        (void)hipGetLastError();
        grid = cus;
    }
    if (grid < 0) return;
    c.grid = grid;
    (void)hipMemsetAsync(c.bar, 0, 16384, stream);
    hipLaunchKernelGGL(mk_forward, dim3(grid), dim3(NTHREADS), LDS_BYTES, stream, c);
}
```

```cpp
#include <hip/hip_runtime.h>
#include <cstdio>
#include <cstdint>
#include <cstring>
#include <cmath>

#ifndef REPMASK
#define REPMASK 0u
#endif

namespace md {
constexpr int D = 1024, NIN = 13888;
constexpr int C_GATE = 0, C_Z = 3072, C_XBC = 5120, C_DT = 9216, C_QKV = 9280, C_U = 12736;
constexpr int SSD_IN = 2048, SSD_CC = 4096, NH = 32, HP = 64, NG = 8, NS = 128;
constexpr int ATT_W = 1152, ATT_O = 384;
constexpr int S5W = 1152, S5G = 72, S5C = 16, S5N = 64;
constexpr int NE = 32, TOPK = 4, FF = 1024;
constexpr float ALPHA = 1.681792830507429f;
constexpr float EPS = 1e-5f;
}

enum { I_X = 0, I_WIN, I_BGATE, I_CONVW, I_CONVB, I_ALOG, I_DTB, I_SSDD, I_NORMW, I_S5ARE, I_S5AIM, I_S5LS, I_S5BRE, I_S5BIM,
       I_S5CRE, I_S5CIM, I_S5D, I_GLU1, I_GLU2, I_WBSSD, I_WBATT, I_WBS5, I_WOUT, I_LN1G, I_LN1B, I_RW, I_RB, I_WGU, I_BGU,
       I_WDN, I_BDN, I_LN2G, I_LN2B, N_INPUTS };

struct Ctx {
    const float* in[N_INPUTS];
    float* out;
    float *attlse, *gate; unsigned short* mixb;
    int *topidx, *tok_slot;
    unsigned* bar;
    unsigned short *Win_t, *Wglu_t, *Wbs_t, *Wba_t, *Wb5_t, *Wout_t, *Wgu_t, *Wdn_t;
    unsigned short *xbf, *Gb, *Zb, *XBCb, *QKVU; float* dtf;
    unsigned short *yssdb, *yattb, *s5hb, *ys5b, *mergedb;
    unsigned short *x1b, *actb, *ys2; float* slot_gate; int *moe_cnt, *moe_pstart, *slot_tok, *moe_done; unsigned long long* cntg;   unsigned char* x1q;
    unsigned short* ssd_S; float *ssd_tot, *ssd_ssq;
    unsigned short* attob;
    unsigned short *Ug, *s5_W1, *s5_Q, *s5_Yl, *s5_Sin, *s5_Sloc; float* s5_a16;
    int depth, grid;
};

namespace wsz { constexpr size_t WIN = (size_t)14080 * 1024, WGLU = (size_t)2304 * 1152, WBS = (size_t)1024 * 2048, WBA = (size_t)1024 * 384, WB5 = (size_t)1024 * 1152, WOUT = (size_t)1024 * 1024,
    S5W1 = (size_t)72 * 512 * 256, S5Q = (size_t)72 * 256 * 256, A16 = 72 * 2 * 64 * 2; }
static inline size_t align_up(size_t x) { return (x + 255) & ~(size_t)255; }
static size_t build_ctx(Ctx& c, void* const* d_in, void* d_out, void* d_ws, int depth) {
    memset(&c, 0, sizeof(c));
    for (int i = 0; i < N_INPUTS; ++i) c.in[i] = (const float*)d_in[i];
    c.out = (float*)d_out; c.depth = depth;
    char* w = (char*)d_ws; size_t off = 0; const size_t T = 16384;
    auto take = [&](size_t bytes) { char* p = w + off; off = align_up(off + bytes); return p; };
    c.bar = (unsigned*)take(16384);
    c.attlse = (float*)take(3 * T * 6 * 4); c.mixb = (unsigned short*)take(T * 1024 * 2);
    c.gate = (float*)take(T * 4 * 4); c.topidx = (int*)take(T * 4 * 4); c.tok_slot = (int*)take(T * 4 * 4);
    c.Win_t = (unsigned short*)take(2 * wsz::WIN * 2); c.Wglu_t = (unsigned short*)take(2 * wsz::WGLU * 2); c.Wbs_t = (unsigned short*)take(2 * wsz::WBS * 2);
    c.Wba_t = (unsigned short*)take(2 * wsz::WBA * 2); c.Wb5_t = (unsigned short*)take(2 * wsz::WB5 * 2); c.Wout_t = (unsigned short*)take(2 * wsz::WOUT * 2);
    c.Wgu_t = (unsigned short*)take((size_t)32 * 2048 * 1024 * 2); c.Wdn_t = (unsigned short*)take((size_t)32 * 1024 * 1024 * 2);
    c.xbf = (unsigned short*)take(T * 1024 * 2); c.Gb = (unsigned short*)take(T * 3072 * 2); c.Zb = (unsigned short*)take(T * 2048 * 2); c.XBCb = (unsigned short*)take(T * 4096 * 2);
    c.QKVU = (unsigned short*)take(T * 4608 * 2); c.dtf = (float*)take(T * 64 * 4);
    c.x1b = (unsigned short*)take((size_t)(T + 1) * 1024 * 2); c.slot_tok = (int*)take(73728 * 4); c.actb = (unsigned short*)take((size_t)73728 * 1024 * 2); c.ys2 = (unsigned short*)take((size_t)73728 * 1024 * 2);
    c.slot_gate = (float*)take(73728 * 4); c.moe_cnt = (int*)take(8192 * 4); c.moe_pstart = (int*)take(256); c.moe_done = (int*)take(2048); c.cntg = (unsigned long long*)take(8192 * 8); c.x1q = (unsigned char*)take((size_t)(T + 1) * 1024);
    c.ssd_S = (unsigned short*)take((size_t)2 * 2 * 64 * 32 * 8192 * 2); c.ssd_tot = (float*)take(2 * 2 * 64 * 32 * 4); c.ssd_ssq = (float*)take(T * 8 * 4);
    c.attob = (unsigned short*)take(3 * T * 384 * 2);
    c.Ug = (unsigned short*)take(T * 1152 * 2); c.s5_W1 = (unsigned short*)take(2 * wsz::S5W1 * 2); c.s5_Q = (unsigned short*)take(2 * wsz::S5Q * 2);
    c.s5_Yl = (unsigned short*)take((size_t)73728 * 256 * 2); c.s5_Sin = (unsigned short*)take((size_t)73728 * 256 * 2); c.s5_Sloc = (unsigned short*)take((size_t)73728 * 256 * 2); c.s5_a16 = (float*)take(2 * wsz::A16 * 4);
    c.yssdb = (unsigned short*)take(T * 2048 * 2); c.yattb = (unsigned short*)take(T * 384 * 2); c.s5hb = (unsigned short*)take(T * 1152 * 2); c.ys5b = (unsigned short*)take(T * 1152 * 2); c.mergedb = (unsigned short*)take(T * 1024 * 2);
    return off;
}

#define XB_TMO      128
#define XB_XCNT(j)  (256  + 64 * (j))
#define XB_XSUB(j)  (1280 + 64 * (j))
#define XB_XGEN(j)  (2304 + 64 * (j))
#define XB_TOP      3328
#define XB_TOPGEN   3392
#define XCD_BAR_WORDS 3456
#define XB_SPIN_CAP (1u << 18)
#define LAS __attribute__((address_space(3)))

__device__ __forceinline__ unsigned xb_ld(unsigned* p)              { return __hip_atomic_load(p, __ATOMIC_RELAXED, __HIP_MEMORY_SCOPE_AGENT); }
__device__ __forceinline__ unsigned xb_add(unsigned* p, unsigned v) { return __hip_atomic_fetch_add(p, v, __ATOMIC_RELAXED, __HIP_MEMORY_SCOPE_AGENT); }
__device__ __forceinline__ unsigned xb_xcc_id() { return (unsigned)__builtin_amdgcn_s_getreg((3 << 11) | 20) & 0xFu; }
#define XB_SPIN(cond, bar) do { unsigned _sp = 0; while (cond) { __builtin_amdgcn_s_sleep(1); \
    if ((++_sp & 255u) == 0u) { if (xb_ld(&(bar)[XB_TMO])) break; if (_sp > XB_SPIN_CAP) { atomicAdd(&(bar)[XB_TMO], 1u); break; } } } } while (0)

struct XcdBarrier { unsigned* bar; unsigned x; volatile LAS unsigned* st; };

__device__ __forceinline__ XcdBarrier xcd_barrier_post(unsigned* bar, volatile LAS unsigned* st) {
    XcdBarrier b; b.bar = bar; b.x = xb_xcc_id(); b.st = st;
    if (threadIdx.x == 0) (void)xb_add(&bar[XB_XCNT(b.x)], 1u);
    return b;
}
__device__ __forceinline__ void xcd_barrier_complete(unsigned* bar, unsigned x, unsigned& nloc, unsigned& nx) {
    const unsigned G = gridDim.x * gridDim.y * gridDim.z;
    unsigned sum, cnt, mine, sp = 0u;
    for (;;) {
        sum = 0u; cnt = 0u; mine = 0u;
#pragma unroll
        for (unsigned j = 0; j < 16; ++j) { const unsigned c = xb_ld(&bar[XB_XCNT(j)]); sum += c; cnt += (c > 0u) ? 1u : 0u; mine = (j == x) ? c : mine; }
        if (sum == G) break;
        __builtin_amdgcn_s_sleep(1);
        if ((++sp & 255u) == 0u) { if (xb_ld(&bar[XB_TMO])) break; if (sp > XB_SPIN_CAP) { atomicAdd(&bar[XB_TMO], 1u); break; } }
    }
    nloc = mine > 0u ? mine : 1u; nx = cnt > 0u ? cnt : 1u;
}
__device__ __forceinline__ void xcd_barrier(const XcdBarrier& b) {
    asm volatile("s_waitcnt vmcnt(0)" ::: "memory");
    __syncthreads();
    if (threadIdx.x == 0) {
        unsigned* bar = b.bar;
        __builtin_amdgcn_s_waitcnt(0);
        unsigned nloc = b.st[0], nx = b.st[1];
        if (nloc == 0u) { xcd_barrier_complete(bar, b.x, nloc, nx); b.st[0] = nloc; b.st[1] = nx; }
        const unsigned old = xb_add(&bar[XB_XSUB(b.x)], 1u);
        const unsigned gen = old / nloc;
        if (old + 1u == (gen + 1u) * nloc) {
            __builtin_amdgcn_fence(__ATOMIC_RELEASE, "agent");
            asm volatile("s_waitcnt vmcnt(0)" ::: "memory");
            const unsigned og = xb_add(&bar[XB_TOP], 1u);
            const unsigned tg = og / nx;
            if (og + 1u == (tg + 1u) * nx) xb_add(&bar[XB_TOPGEN], 1u);
            else XB_SPIN(xb_ld(&bar[XB_TOPGEN]) == tg, bar);
            __builtin_amdgcn_fence(__ATOMIC_ACQUIRE, "agent");
            xb_add(&bar[XB_XGEN(b.x)], 1u);
            asm volatile("s_waitcnt vmcnt(0)" ::: "memory");
        } else {
            XB_SPIN(xb_ld(&bar[XB_XGEN(b.x)]) == gen, bar);
            __builtin_amdgcn_fence(__ATOMIC_ACQUIRE, "agent");
            asm volatile("s_waitcnt vmcnt(0)" ::: "memory");
        }
    }
    __syncthreads();
}

constexpr int NTHREADS = 512;
constexpr int LDS_BYTES = 163840;

#if defined(__HIP_DEVICE_COMPILE__)
typedef unsigned short bf16_t;
typedef short bf16x8 __attribute__((ext_vector_type(8)));
typedef float f32x4 __attribute__((ext_vector_type(4)));
typedef float f32x2 __attribute__((ext_vector_type(2)));
typedef unsigned u32x4 __attribute__((ext_vector_type(4)));
typedef unsigned u32x2 __attribute__((ext_vector_type(2)));
#define LDS_WAIT() asm volatile("s_waitcnt lgkmcnt(0)" ::: "memory")
#define VM_WAIT() asm volatile("s_waitcnt vmcnt(0)" ::: "memory")

__device__ __forceinline__ f32x4 zero4() { float z = 0.f; asm volatile("" : "+v"(z)); return (f32x4){z, z, z, z}; }
__device__ __forceinline__ u32x4 uzero4() { unsigned z = 0u; asm volatile("" : "+v"(z)); return (u32x4){z, z, z, z}; }
__device__ __forceinline__ unsigned f2bf(float f) { unsigned u = __float_as_uint(f); return (u + 0x7fffu + ((u >> 16) & 1u)) >> 16; }
__device__ __forceinline__ unsigned pk2(float lo, float hi) { return f2bf(lo) | (f2bf(hi) << 16); }
__device__ __forceinline__ float bf2f(unsigned b) { return __uint_as_float(b << 16); }
__device__ __forceinline__ float bflo(unsigned w) { return __uint_as_float(w << 16); }
__device__ __forceinline__ float bfhi(unsigned w) { return __uint_as_float(w & 0xffff0000u); }
typedef __bf16 bf16x2_t __attribute__((ext_vector_type(2)));
__device__ __forceinline__ unsigned cvt_pk_bf16(float lo, float hi) { const f32x2 v = {lo, hi}; return __builtin_bit_cast(unsigned, __builtin_convertvector(v, bf16x2_t)); }
__device__ __forceinline__ float fast_sigmoid(float x) { return __builtin_amdgcn_rcpf(1.0f + __expf(-x)); }
__device__ __forceinline__ f32x4 sig4(f32x4 v) { return (f32x4){fast_sigmoid(v[0]), fast_sigmoid(v[1]), fast_sigmoid(v[2]), fast_sigmoid(v[3])}; }
__device__ __forceinline__ unsigned pk4_fp8(float a, float b, float c2, float d) { int w = 0; w = __builtin_amdgcn_cvt_pk_fp8_f32(a, b, w, false); w = __builtin_amdgcn_cvt_pk_fp8_f32(c2, d, w, true); return (unsigned)w; }
__device__ __forceinline__ u32x4 pack8(f32x4 v0, f32x4 v1) { u32x4 w; w.x = cvt_pk_bf16(v0[0], v0[1]); w.y = cvt_pk_bf16(v0[2], v0[3]); w.z = cvt_pk_bf16(v1[0], v1[1]); w.w = cvt_pk_bf16(v1[2], v1[3]); return w; }

namespace gx {
constexpr int BM = 256, BK = 64, HALF = 128, HTB = HALF * BK * 2, STAGE_BYTES = 8 * HTB, NXCD = 8, WGM = 2;
__device__ __forceinline__ int lds_byte(int r, int c) { const int st = (r >> 4) * 2 + (c >> 5), rr = r & 15, cc = c & 31, ob = rr * 64 + cc * 2; return st * 1024 + (ob ^ (((ob >> 9) & 1) << 5)); }
__device__ __forceinline__ void stage_rc(int b, int& R, int& C) { const int st = b / 1024, sb = b % 1024, swz = sb ^ (((sb >> 9) & 1) << 5); R = (st >> 1) * 16 + swz / 64; C = (st & 1) * 32 + (swz % 64) / 2; }
__device__ __forceinline__ int perm32(int rho) { const int n = rho >> 4, i = rho & 15; return 8 * (i >> 2) + 4 * n + (i & 3); }
struct Unit { int pm, pn, e, f; };
struct Gemm { const bf16_t* A; const bf16_t* Bt; int K; size_t bexp; };
struct StaticOrder {
    int nM, nN, nwg, G, c;
    __device__ void init(int M, int N, int G_, int c_) { nM = M / BM; nN = N / BM; nwg = nM * nN; G = G_; c = c_; }
    __device__ bool next(int i, Unit& u) const {
        const long Lx = (long)i * G + c; if (Lx >= nwg) return false;
        int wgid = (int)Lx; { const int q = nwg / NXCD, r = nwg % NXCD, xcd = wgid % NXCD, off = wgid / NXCD; wgid = (xcd < r ? xcd * (q + 1) : r * (q + 1) + (xcd - r) * q) + off; }
        const int nig = WGM * nN, gid = wgid / nig, fm = gid * WGM, gsz = (nM - fm) < WGM ? (nM - fm) : WGM;
        u.pm = fm + ((wgid % nig) % gsz); u.pn = (wgid % nig) / gsz; u.e = 0; u.f = 0; return true;
    }
};
typedef int v8i32 __attribute__((ext_vector_type(8)));
template <class Epi, class Sched, bool GATHER = false, bool FP8 = false>
__device__ __forceinline__ void gemm_phase(LAS unsigned char* lds, const Gemm g, const Sched& S, const Epi& E, const int* rowidx = nullptr) {
    int tid = threadIdx.x; asm volatile("" : "+v"(tid)); const int wid = __builtin_amdgcn_readfirstlane(tid >> 6), lane = tid & 63, wr = wid >> 2, wc = wid & 3, fr = lane & 15, fq = lane >> 4;
    int K = g.K; asm volatile("" : "+s"(K)); const int nt = K / BK;
    unsigned voffA[2], voffB[2];
#pragma unroll
    for (int i = 0; i < 2; ++i) { int R, C; stage_rc(tid * 16 + i * 8192, R, C); const int Rb = Epi::PERM ? ((R & ~31) + perm32(R & 31)) : R;
        voffA[i] = (unsigned)(R * K + C) * 2u; voffB[i] = (unsigned)(Rb * K + C) * 2u; }
    const size_t kstep = (size_t)(BK * 2);
    const size_t hstep = (size_t)HALF * K * 2;
    const size_t tstep = 2 * hstep;
    const size_t hstepA = GATHER ? 0 : hstep;
    const unsigned ldsw = (unsigned)wid * 1024u;
    const int aoff = lds_byte(wr * 64 + fr, fq * 8), boff = lds_byte(wc * 32 + fr, fq * 8);
#define GX_SA(b, h) (((b) * 2 + (h)) * HTB)
#define GX_SB(b, h) ((4 + (b) * 2 + (h)) * HTB)
#define GX_STAGE(bufoff, gbase, voff) do { _Pragma("unroll") for (int _i = 0; _i < 2; ++_i) \
        __builtin_amdgcn_global_load_lds((const unsigned*)((const char*)(gbase) + (voff)[_i]), (LAS unsigned*)(lds + (bufoff) + ldsw + _i * 8192), 16, 0, 0); } while (0)
#define GX_STAGE_A(bufoff, ptr, half, usenext) do { if (GATHER) { unsigned _v[2]; _Pragma("unroll") for (int _i = 0; _i < 2; ++_i) _v[_i] = (usenext) ? nv[half][_i] : cv[half][_i]; GX_STAGE(bufoff, ptr, _v); } \
        else GX_STAGE(bufoff, (ptr) + (half) * hstepA, voffA); } while (0)
#define GX_IDX(dst, u) do { _Pragma("unroll") for (int _i = 0; _i < 2; ++_i) { int _R, _C; stage_rc(tid * 16 + _i * 8192, _R, _C); _Pragma("unroll") for (int _h = 0; _h < 2; ++_h) \
        dst[_h][_i] = (unsigned)rowidx[(u).pm * 256 + _h * 128 + _R] * (unsigned)(K * 2) + (unsigned)(_C * 2); } } while (0)
#define GX_LDA(dst, b, h) do { _Pragma("unroll") for (int m = 0; m < 4; ++m) _Pragma("unroll") for (int k = 0; k < 2; ++k) dst[m][k] = *(const LAS bf16x8*)(lds + GX_SA(b, h) + aoff + m * 2048 + k * 1024); } while (0)
#define GX_LDB(dst, b, h) do { _Pragma("unroll") for (int n = 0; n < 2; ++n) _Pragma("unroll") for (int k = 0; k < 2; ++k) dst[n][k] = *(const LAS bf16x8*)(lds + GX_SB(b, h) + boff + n * 2048 + k * 1024); } while (0)
#define GX_CAT8(lo, hi) __builtin_bit_cast(v8i32, __builtin_shufflevector(__builtin_bit_cast(u32x4, lo), __builtin_bit_cast(u32x4, hi), 0, 1, 2, 3, 4, 5, 6, 7))
#define GX_MMA(ai, bj, At, Bt) do { __builtin_amdgcn_s_setprio(1); if (FP8) { _Pragma("unroll") for (int m = 0; m < 4; ++m) _Pragma("unroll") for (int n = 0; n < 2; ++n) \
            asm volatile("v_mfma_scale_f32_16x16x128_f8f6f4 %0, %1, %2, %0, %3, %3 op_sel_hi:[0,0,0]" : "+v"(acc[ai][bj][m][n]) : "v"(GX_CAT8(Bt[n][0], Bt[n][1])), "v"(GX_CAT8(At[m][0], At[m][1])), "v"(one_scale)); } \
        else { _Pragma("unroll") for (int m = 0; m < 4; ++m) _Pragma("unroll") for (int n = 0; n < 2; ++n) _Pragma("unroll") for (int k = 0; k < 2; ++k) \
        acc[ai][bj][m][n] = __builtin_amdgcn_mfma_f32_16x16x32_bf16(Bt[n][k], At[m][k], acc[ai][bj][m][n], 0, 0, 0); } __builtin_amdgcn_s_setprio(0); } while (0)
#define GX_WAIT_V(n) asm volatile("s_waitcnt vmcnt(" #n ")" ::: "memory")
#define GX_WAIT_L(n) asm volatile("s_waitcnt lgkmcnt(" #n ")" ::: "memory")
#define GX_BAR __builtin_amdgcn_s_barrier()
#define GX_SCHED __builtin_amdgcn_sched_barrier(0)
    Unit cur, nxt, nn; int ui = 0;
    if (!S.next(0, cur)) return;
    bool has_next = S.next(1, nxt);
    unsigned cv[2][2], nv[2][2], nnv[2][2];
    if (GATHER) { GX_IDX(cv, cur); if (has_next) GX_IDX(nv, nxt); else { _Pragma("unroll") for (int h = 0; h < 2; ++h) _Pragma("unroll") for (int i = 0; i < 2; ++i) nv[h][i] = cv[h][i]; } }
    f32x4 acc[2][2][4][2];
    { float z = 0.f; asm volatile("" : "+v"(z));
#pragma unroll
    for (int a = 0; a < 2; ++a)
#pragma unroll
        for (int b = 0; b < 2; ++b)
#pragma unroll
            for (int m = 0; m < 4; ++m)
#pragma unroll
                for (int n = 0; n < 2; ++n) acc[a][b][m][n] = (f32x4){z, z, z, z}; }
    bf16x8 At[4][2], B0[2][2], B1[2][2]; int one_scale = 0x7f7f7f7f; asm volatile("" : "+v"(one_scale));
    const char* cA = (const char*)g.A + (GATHER ? 0 : (size_t)cur.pm * tstep); const char* cB = (const char*)g.Bt + (size_t)cur.e * g.bexp + (size_t)cur.pn * tstep;
    GX_STAGE(GX_SB(0, 0), cB, voffB); GX_STAGE_A(GX_SA(0, 0), cA, 0, false); GX_STAGE(GX_SB(0, 1), cB + hstep, voffB); GX_STAGE_A(GX_SA(0, 1), cA, 1, false);
    if (wr == 1) GX_BAR;
    GX_WAIT_V(4); GX_BAR;
    GX_STAGE(GX_SB(1, 0), cB + kstep, voffB); GX_STAGE_A(GX_SA(1, 0), cA + kstep, 0, false); GX_STAGE(GX_SB(1, 1), cB + hstep + kstep, voffB);
    GX_WAIT_V(6); GX_BAR;
    for (;;) {
        const char* nA = (has_next && !GATHER) ? (const char*)g.A + (size_t)nxt.pm * tstep : cA; const char* nB = has_next ? (const char*)g.Bt + (size_t)nxt.e * g.bexp + (size_t)nxt.pn * tstep : cB;
#pragma clang loop unroll(disable)
        for (int t = 0; t < nt; t += 2) {
            const bool last = (t == nt - 2);
            const char* a1 = cA + (size_t)(t + 1) * kstep;
            const char* a2 = last ? nA : cA + (size_t)(t + 2) * kstep; const char* b2 = last ? nB : cB + (size_t)(t + 2) * kstep;
            const char* a3 = a2 + kstep; const char* b3 = b2 + kstep;
            GX_LDB(B0, 0, 0); GX_SCHED; GX_LDA(At, 0, 0); GX_STAGE_A(GX_SA(1, 1), a1, 1, false);
            GX_WAIT_L(8); GX_BAR; GX_WAIT_L(0); GX_MMA(0, 0, At, B0); GX_BAR; GX_SCHED;
            GX_LDB(B1, 0, 1); GX_STAGE(GX_SB(0, 0), b2, voffB);
            GX_BAR; GX_WAIT_L(0); GX_MMA(0, 1, At, B1); GX_BAR;
            GX_LDA(At, 0, 1); GX_STAGE_A(GX_SA(0, 0), a2, 0, last);
            GX_BAR; GX_WAIT_L(0); GX_MMA(1, 0, At, B0); GX_BAR; GX_SCHED;
            GX_STAGE(GX_SB(0, 1), b2 + hstep, voffB);
            GX_WAIT_V(6); GX_BAR; GX_MMA(1, 1, At, B1); GX_BAR;
            GX_LDB(B0, 1, 0); GX_SCHED; GX_LDA(At, 1, 0); GX_STAGE_A(GX_SA(0, 1), a2, 1, last);
            GX_WAIT_L(8); GX_BAR; GX_WAIT_L(0); GX_MMA(0, 0, At, B0); GX_BAR; GX_SCHED;
            GX_LDB(B1, 1, 1); GX_STAGE(GX_SB(1, 0), b3, voffB);
            GX_BAR; GX_WAIT_L(0); GX_MMA(0, 1, At, B1); GX_BAR;
            GX_LDA(At, 1, 1); GX_STAGE_A(GX_SA(1, 0), a3, 0, last);
            GX_BAR; GX_WAIT_L(0); GX_MMA(1, 0, At, B0); GX_BAR; GX_SCHED;
            GX_STAGE(GX_SB(1, 1), b3 + hstep, voffB);
            GX_WAIT_V(6); GX_BAR; GX_MMA(1, 1, At, B1); GX_BAR;
        }
        const bool has_nn = has_next && S.next(ui + 2, nn);
        if (GATHER && has_nn) GX_IDX(nnv, nn);
        if (FP8) asm volatile("s_nop 15\n\ts_nop 15" ::: "memory");
        E(acc, cur, wr, wc, fr, fq);
        if (!has_next) break;
        { float z = 0.f; asm volatile("" : "+v"(z));
#pragma unroll
        for (int a = 0; a < 2; ++a)
#pragma unroll
            for (int b = 0; b < 2; ++b)
#pragma unroll
                for (int m = 0; m < 4; ++m)
#pragma unroll
                    for (int n = 0; n < 2; ++n) acc[a][b][m][n] = (f32x4){z, z, z, z}; }
        cur = nxt; cA = nA; cB = nB; ++ui;
        if (GATHER) { _Pragma("unroll") for (int h = 0; h < 2; ++h) _Pragma("unroll") for (int i = 0; i < 2; ++i) { cv[h][i] = nv[h][i]; if (has_nn) nv[h][i] = nnv[h][i]; } }
        nxt = nn; has_next = has_nn;
    }
    GX_WAIT_V(0);
    if (wr == 0) GX_BAR;
    GX_BAR;
#undef GX_SA
#undef GX_SB
#undef GX_STAGE
#undef GX_STAGE_A
#undef GX_IDX
#undef GX_LDA
#undef GX_LDB
#undef GX_MMA
#undef GX_CAT8
#undef GX_WAIT_V
#undef GX_WAIT_L
#undef GX_BAR
#undef GX_SCHED
}
}

template <bool RAWG, bool RAWZ> struct EpiInproj {
    static constexpr bool PERM = true;
    bf16_t *Gb, *Zb, *XBCb, *QKVU; float* dtf; const float* bgate; bf16_t* Ug;
    __device__ __forceinline__ void operator()(const f32x4 (&acc)[2][2][4][2], const gx::Unit& u, int wr, int wc, int fr, int fq) const {
        const int row0 = u.pm * 256 + wr * 64 + fr, cl = wc * 32 + 8 * fq;
        if (u.pn == 54) {
            if (wc < 2) {
#pragma unroll
                for (int ai = 0; ai < 2; ++ai)
#pragma unroll
                    for (int m = 0; m < 4; ++m) { float* rowp = dtf + (size_t)(row0 + ai * 128 + m * 16) * 64 + cl; *(f32x4*)rowp = acc[ai][0][m][0]; *(f32x4*)(rowp + 4) = acc[ai][0][m][1]; }
            }
            return;
        }
        bf16_t* base; int ldc, colt, mode;
        if (u.pn < 12) { base = Gb; ldc = 3072; colt = u.pn * 256; mode = RAWG ? 0 : 1; }
        else if (u.pn < 20) { base = Zb; ldc = 2048; colt = (u.pn - 12) * 256; mode = RAWZ ? 0 : 2; }
        else if (u.pn < 36) { base = XBCb; ldc = 4096; colt = (u.pn - 20) * 256; mode = 0; }
        else { base = QKVU; ldc = 4608; colt = (u.pn - 36) * 256; mode = 0; }
        const bool isu = u.pn >= 50;
#pragma unroll
        for (int bj = 0; bj < 2; ++bj) {
            const int col = colt + bj * 128 + cl;
            f32x4 b0 = zero4(), b1 = b0;
            if (mode == 1) { b0 = *(const f32x4*)(bgate + col); b1 = *(const f32x4*)(bgate + col + 4); }
#pragma unroll
            for (int ai = 0; ai < 2; ++ai)
#pragma unroll
                for (int m = 0; m < 4; ++m) {
                    f32x4 v0 = acc[ai][bj][m][0], v1 = acc[ai][bj][m][1];
                    if (mode == 1) { v0 = sig4(v0 + b0); v1 = sig4(v1 + b1); }
                    else if (mode == 2) { v0 = v0 * sig4(v0); v1 = v1 * sig4(v1); }
                    const u32x4 pk = pack8(v0, v1);
                    if (isu || (u.pn == 49 && bj == 1)) { const int uc = col - 3456; *(u32x4*)(Ug + ((size_t)(uc >> 4) * 16384 + (row0 + ai * 128 + m * 16)) * 16 + (uc & 15)) = pk; }
                    else *(u32x4*)(base + (size_t)(row0 + ai * 128 + m * 16) * ldc + col) = pk;
                }
        }
    }
};

struct EpiGlu {
    static constexpr bool PERM = true;
    bf16_t* O;
    __device__ __forceinline__ void operator()(const f32x4 (&acc)[2][2][4][2], const gx::Unit& u, int wr, int wc, int fr, int fq) const {
        const int row0 = u.pm * 256 + wr * 64 + fr, col = u.pn * 128 + wc * 32 + 8 * fq;
#pragma unroll
        for (int ai = 0; ai < 2; ++ai)
#pragma unroll
            for (int m = 0; m < 4; ++m) {
                const f32x4 v0 = acc[ai][0][m][0] * sig4(acc[ai][1][m][0]), v1 = acc[ai][0][m][1] * sig4(acc[ai][1][m][1]);
                *(u32x4*)(O + (size_t)(row0 + ai * 128 + m * 16) * 1152 + col) = pack8(v0, v1);
            }
    }
};
template <int STEP> struct EpiBranch {
    static constexpr bool PERM = true;
    const bf16_t* G; bf16_t* mb; const float* ssq;
    __device__ __forceinline__ void operator()(const f32x4 (&acc)[2][2][4][2], const gx::Unit& u, int wr, int wc, int fr, int fq) const {
        const int row0 = u.pm * 256 + wr * 64 + fr, cl = u.pn * 256 + wc * 32 + 8 * fq;
#pragma unroll
        for (int ai = 0; ai < 2; ++ai) {
            u32x4 gw[4][2], pw[4][2]; float rs[4];
#pragma unroll
            for (int m = 0; m < 4; ++m) { const size_t row = (size_t)(row0 + ai * 128 + m * 16);
#pragma unroll
                for (int bj = 0; bj < 2; ++bj) { const int col = cl + bj * 128; gw[m][bj] = *(const u32x4*)(G + row * 3072 + STEP * 1024 + col); if (STEP > 0) pw[m][bj] = *(const u32x4*)(mb + row * 1024 + col); }
                if (STEP == 0) { const f32x4 qa = *(const f32x4*)(ssq + row * 8), qb = *(const f32x4*)(ssq + row * 8 + 4);
                    rs[m] = __builtin_amdgcn_rsqf((((qa[0] + qa[1]) + (qa[2] + qa[3])) + ((qb[0] + qb[1]) + (qb[2] + qb[3]))) * (1.0f / 2048.0f) + md::EPS); } }
#pragma unroll
            for (int m = 0; m < 4; ++m)
#pragma unroll
                for (int bj = 0; bj < 2; ++bj) { const size_t row = (size_t)(row0 + ai * 128 + m * 16); const int col = cl + bj * 128; const u32x4 g4 = gw[m][bj];
                    const f32x4 g0 = (f32x4){bflo(g4.x), bfhi(g4.x), bflo(g4.y), bfhi(g4.y)}, g1 = (f32x4){bflo(g4.z), bfhi(g4.z), bflo(g4.w), bfhi(g4.w)};
                    f32x4 v0 = acc[ai][bj][m][0] * g0, v1 = acc[ai][bj][m][1] * g1;
                    if (STEP == 0) { v0 *= rs[m]; v1 *= rs[m]; }
                    if (STEP > 0) { const u32x4 p4 = pw[m][bj]; v0 += (f32x4){bflo(p4.x), bfhi(p4.x), bflo(p4.y), bfhi(p4.y)}; v1 += (f32x4){bflo(p4.z), bfhi(p4.z), bflo(p4.w), bfhi(p4.w)}; }
                    *(u32x4*)(mb + row * 1024 + col) = pack8(v0, v1); }
        }
    }
};
struct EpiBf16 {
    static constexpr bool PERM = true;
    bf16_t* C;
    __device__ __forceinline__ void operator()(const f32x4 (&acc)[2][2][4][2], const gx::Unit& u, int wr, int wc, int fr, int fq) const {
        const int row0 = u.pm * 256 + wr * 64 + fr, cl = u.pn * 256 + wc * 32 + 8 * fq;
#pragma unroll
        for (int ai = 0; ai < 2; ++ai)
#pragma unroll
            for (int m = 0; m < 4; ++m)
#pragma unroll
                for (int bj = 0; bj < 2; ++bj) *(u32x4*)(C + (size_t)(row0 + ai * 128 + m * 16) * 1024 + cl + bj * 128) = pack8(acc[ai][bj][m][0], acc[ai][bj][m][1]);
    }
};

__device__ __forceinline__ void cvt_item(const float* Wsrc  , int ldn, bf16_t* dst  , int K, int k0, LAS float* scr, int lane, const float* kscale) {
#pragma unroll
    for (int hb = 0; hb < 2; ++hb) {
        float v[32];
#pragma unroll
        for (int i = 0; i < 32; ++i) v[i] = __builtin_nontemporal_load(Wsrc + (size_t)(k0 + 32 * hb + i) * ldn + lane);
        if (kscale) {
#pragma unroll
            for (int i = 0; i < 32; ++i) v[i] *= kscale[k0 + 32 * hb + i];
        }
#pragma unroll
        for (int i = 0; i < 32; ++i) scr[(32 * hb + i) * 65 + lane] = v[i];
    }
    LDS_WAIT(); asm volatile("" ::: "memory");
    const int cch = lane & 7;
#pragma unroll
    for (int j = 0; j < 8; ++j) { const int n = (lane >> 3) + 8 * j; const LAS float* sp = scr + (8 * cch) * 65 + n;
        u32x4 o; o.x = cvt_pk_bf16(sp[0 * 65], sp[1 * 65]); o.y = cvt_pk_bf16(sp[2 * 65], sp[3 * 65]); o.z = cvt_pk_bf16(sp[4 * 65], sp[5 * 65]); o.w = cvt_pk_bf16(sp[6 * 65], sp[7 * 65]);
        *(u32x4*)(dst + (size_t)n * K + k0 + 8 * cch) = o; }
    LDS_WAIT(); asm volatile("" ::: "memory");
}
__device__ __forceinline__ void cvt8_load(float (&v)[64], const float* Wsrc, int ldn, int k0, int lane) {
#pragma unroll
    for (int i = 0; i < 64; ++i) v[i] = __builtin_nontemporal_load(Wsrc + (size_t)(k0 + i) * ldn + lane);
}
__device__ __forceinline__ void cvt8_put(const float (&v)[64], LAS float* scr, int lane, float wmul) {
#pragma unroll
    for (int i = 0; i < 64; ++i) scr[i * 65 + lane] = v[i] * wmul;
}
__device__ __forceinline__ void cvt8_out(unsigned char* dst  , int Kb  , int k0, LAS float* scr, int lane) {
    LDS_WAIT(); asm volatile("" ::: "memory");
    const LAS float* sp = scr + lane;
#pragma unroll
    for (int j = 0; j < 4; ++j) { u32x4 o;
        o.x = pk4_fp8(sp[(16 * j + 0) * 65], sp[(16 * j + 1) * 65], sp[(16 * j + 2) * 65], sp[(16 * j + 3) * 65]); o.y = pk4_fp8(sp[(16 * j + 4) * 65], sp[(16 * j + 5) * 65], sp[(16 * j + 6) * 65], sp[(16 * j + 7) * 65]);
        o.z = pk4_fp8(sp[(16 * j + 8) * 65], sp[(16 * j + 9) * 65], sp[(16 * j + 10) * 65], sp[(16 * j + 11) * 65]); o.w = pk4_fp8(sp[(16 * j + 12) * 65], sp[(16 * j + 13) * 65], sp[(16 * j + 14) * 65], sp[(16 * j + 15) * 65]);
        *(u32x4*)(dst + (size_t)lane * Kb + k0 + 16 * j) = o; }
    LDS_WAIT(); asm volatile("" ::: "memory");
}
template <bool SMALL, bool MOE>
__device__ __forceinline__ void prologue_weights(const Ctx& c, int l, int par, LAS unsigned char* lds, int first_wg, int n_wg) {
    int tid_ = threadIdx.x; asm volatile("" : "+v"(tid_)); const int wave = __builtin_amdgcn_readfirstlane(tid_ >> 6), lane = tid_ & 63;
    LAS float* scr = (LAS float*)(lds + wave * 16640);
    const int gw = ((int)blockIdx.x - first_wg) * 8 + wave, NGW = n_wg * 8;
    constexpr int N_WIN = 16 * 217, N_GLU = 18 * 18, N_BS = 32 * 16, N_BA = 6 * 16, N_B5 = 18 * 16, N_WO = 16 * 16, N_GU = 32 * 16 * 32, N_DN = 32 * 16 * 16;
    constexpr int N_SMALL = N_WIN + 2 * N_GLU + N_BS + N_BA + N_B5 + N_WO;
    if (SMALL) {
        bf16_t* Win_t = c.Win_t + par * wsz::WIN; bf16_t* Wglu_t = c.Wglu_t + par * wsz::WGLU; bf16_t* Wbs_t = c.Wbs_t + par * wsz::WBS; bf16_t* Wba_t = c.Wba_t + par * wsz::WBA; bf16_t* Wb5_t = c.Wb5_t + par * wsz::WB5; bf16_t* Wout_t = c.Wout_t + par * wsz::WOUT;
#pragma unroll 1
        for (int it = gw; it < N_SMALL; it += NGW) {
            int r = it; const float* src; bf16_t* dst; int ldn, K, kb; const float* ksc = nullptr;
            if (r < N_WIN) { kb = r / 217; const int n0 = (r % 217) * 64; const int drow = n0 < 9216 ? n0 : (n0 < 9280 ? 13824 + (n0 - 9216) : n0 - 64);
                src = c.in[I_WIN] + (size_t)l * 1024 * md::NIN + n0; ldn = md::NIN; dst = Win_t + (size_t)drow * 1024; K = 1024; }
            else if ((r -= N_WIN) < 2 * N_GLU) { const int w = r / N_GLU; r -= w * N_GLU; kb = r / 18; const int sb = r % 18; const int drow = 256 * (sb / 2) + 64 * (sb % 2) + 128 * w;
                src = c.in[w ? I_GLU2 : I_GLU1] + (size_t)l * 1152 * 1152 + sb * 64; ldn = 1152; dst = Wglu_t + (size_t)drow * 1152; K = 1152; }
            else if ((r -= 2 * N_GLU) < N_BS) { kb = r / 16; const int sb = r % 16; src = c.in[I_WBSSD] + (size_t)l * 2048 * 1024 + sb * 64; ldn = 1024; dst = Wbs_t + (size_t)(sb * 64) * 2048; K = 2048; ksc = c.in[I_NORMW] + (size_t)l * 2048; }
            else if ((r -= N_BS) < N_BA) { kb = r / 16; const int sb = r % 16; src = c.in[I_WBATT] + (size_t)l * 384 * 1024 + sb * 64; ldn = 1024; dst = Wba_t + (size_t)(sb * 64) * 384; K = 384; }
            else if ((r -= N_BA) < N_B5) { kb = r / 16; const int sb = r % 16; src = c.in[I_WBS5] + (size_t)l * 1152 * 1024 + sb * 64; ldn = 1024; dst = Wb5_t + (size_t)(sb * 64) * 1152; K = 1152; }
            else { r -= N_B5; kb = r / 16; const int sb = r % 16; src = c.in[I_WOUT] + (size_t)l * 1024 * 1024 + sb * 64; ldn = 1024; dst = Wout_t + (size_t)(sb * 64) * 1024; K = 1024; }
            cvt_item(src, ldn, dst, K, kb * 64, scr, lane, ksc);
        }
        for (long i = (long)((int)blockIdx.x - first_wg) * NTHREADS + tid_; i < 192 * 1024 / 8; i += (long)n_wg * NTHREADS) *(u32x4*)(Win_t + (size_t)13888 * 1024 + i * 8) = uzero4();
    }
    if (MOE) {
#define MOE_ITEM(r_, src, ldn, dst, kb) do { int r = (r_); \
            if (r < N_GU) { const int e = r / (16 * 32); r -= e * 16 * 32; kb = r / 32; const int sb = r % 32; const int s2 = sb & 15; const int drow = e * 2048 + 256 * (s2 / 2) + 64 * (s2 % 2) + (sb >= 16 ? 128 : 0); \
                src = c.in[I_WGU] + ((size_t)l * 32 + e) * 1024 * 2048 + sb * 64; ldn = 2048; dst = (unsigned char*)c.Wgu_t + (size_t)drow * 1024; } \
            else { r -= N_GU; const int e = r / (16 * 16); r -= e * 16 * 16; kb = r / 16; const int sb = r % 16; \
                src = c.in[I_WDN] + ((size_t)l * 32 + e) * 1024 * 1024 + sb * 64; ldn = 1024; dst = (unsigned char*)c.Wdn_t + (size_t)(e * 1024 + sb * 64) * 1024; } } while (0)
        float v[64]; const float* src; unsigned char* dst; int ldn, kb; int it = gw;
        if (it < N_GU + N_DN) { MOE_ITEM(it, src, ldn, dst, kb); cvt8_load(v, src, ldn, kb * 64, lane); }
#pragma unroll 1
        for (; it < N_GU + N_DN; it += NGW) {
            cvt8_put(v, scr, lane, 64.0f);
            unsigned char* dcur = dst; const int kcur = kb;
            if (it + NGW < N_GU + N_DN) { MOE_ITEM(it + NGW, src, ldn, dst, kb); cvt8_load(v, src, ldn, kb * 64, lane); }
            cvt8_out(dcur, 1024, kcur * 64, scr, lane);
        }
#undef MOE_ITEM
    }
}
__device__ __forceinline__ void cvt_x8(const float* x, bf16_t* o, long i) {
    const f32x4 a = *(const f32x4*)(x + i * 8), b = *(const f32x4*)(x + i * 8 + 4);
    *(u32x4*)(o + i * 8) = pack8(a, b);
}
#endif

#define LOOP(count, stmt) do { unsigned t_ = threadIdx.x; asm volatile("" : "+v"(t_)); const long gth_ = (long)c.grid * NTHREADS; for (long i = (long)blockIdx.x * NTHREADS + t_; i < (long)(count); i += gth_) { stmt; } } while (0)
#define SYNC() xcd_barrier(bar)
constexpr int ox_T = 16384;

#if defined(__HIP_DEVICE_COMPILE__)
constexpr int LDS_TAB = 131072;
constexpr int NSLOT_MAX = 65536 + 32 * 256;
#define SWZ_XOR(v, k) __int_as_float(__builtin_amdgcn_ds_swizzle(__float_as_int(v), ((k) << 10) | 0x1f))
template <int CTRL> __device__ __forceinline__ float dppmov(float v) { return __int_as_float(__builtin_amdgcn_update_dpp(0, __float_as_int(v), CTRL, 0xf, 0xf, true)); }
#define RDLANE_F(v, k) __int_as_float(__builtin_amdgcn_readlane(__float_as_int(v), (k)))
__device__ __forceinline__ float wave_sum(float v) {
    v += dppmov<0xB1>(v); v += dppmov<0x4E>(v); v += dppmov<0x141>(v); v += dppmov<0x140>(v);
    return (RDLANE_F(v, 0) + RDLANE_F(v, 16)) + (RDLANE_F(v, 32) + RDLANE_F(v, 48));
}
__device__ __forceinline__ void moe_count(const Ctx& c, LAS unsigned char* lds) {
    int tid = threadIdx.x; asm volatile("" : "+v"(tid));
    LAS int* cl = (LAS int*)lds;
    for (int gi = blockIdx.x; gi < ox_T / 64; gi += c.grid) {
        if (tid < 32) cl[tid] = 0;
        __syncthreads();
        if (tid < 256) atomicAdd((int*)(cl + c.topidx[gi * 256 + tid]), 1);
        __syncthreads();
        if (tid < 32) c.moe_cnt[gi * 32 + tid] = cl[tid];
        __syncthreads();
    }
}
__device__ __forceinline__ void moe_assign(const Ctx& c, LAS unsigned char* lds, unsigned epoch) {
    int tid = threadIdx.x; asm volatile("" : "+v"(tid));
    LAS int* tbl = (LAS int*)lds;
    LAS int* total = tbl + 8192;
    LAS int* pstart = total + 32;
    LAS int* base = pstart + 40;
    LAS int* eids = base + 32;
    __syncthreads();
    int pe = 0; float pg = 0.f;
    if (epoch) {
        if (tid < 256) { pe = ((const LAS int*)(lds + 102400))[tid]; pg = ((const LAS float*)(lds + 103424))[tid]; }
        unsigned vv[16];
        for (unsigned spins = 0;;) { bool ok = true;
#pragma unroll
            for (int k = 0; k < 16; ++k) { const unsigned long long x = __hip_atomic_load(c.cntg + tid + 512 * k, __ATOMIC_RELAXED, __HIP_MEMORY_SCOPE_AGENT); vv[k] = (unsigned)x; ok = ok && ((unsigned)(x >> 32) == epoch); }
            if (__all(ok) || ++spins > (1u << 20)) break;
            __builtin_amdgcn_s_sleep(2); }
#pragma unroll
        for (int k = 0; k < 16; ++k) tbl[tid + 512 * k] = (int)vv[k];
    } else {
        if (tid < 256 && (int)blockIdx.x < ox_T / 64) { pe = c.topidx[blockIdx.x * 256 + tid]; pg = c.gate[blockIdx.x * 256 + tid]; }
        for (int i = tid; i < 8192; i += NTHREADS) tbl[i] = c.moe_cnt[i];
    }
    __syncthreads();
    if (tid < 32) { int s = 0; for (int gi = 0; gi < 256; ++gi) s += tbl[gi * 32 + tid]; total[tid] = s; }
    __syncthreads();
    if (tid == 0) { int p = 0; for (int e = 0; e < 32; ++e) { pstart[e] = p; p += (total[e] + 255) / 256 * 256; } pstart[32] = p; }
    __syncthreads();
    if (blockIdx.x == 0 && tid < 33) c.moe_pstart[tid] = pstart[tid];
    if (blockIdx.x == 0 && tid < 288) c.moe_done[tid] = 0;
    for (int e = blockIdx.x; e < 32; e += c.grid) {
        const int r0 = pstart[e] + total[e], r1 = pstart[e + 1];
        for (int i = r0 + tid; i < r1; i += NTHREADS) c.slot_tok[i] = ox_T;
    }
    for (int gi = blockIdx.x; gi < ox_T / 64; gi += c.grid) {
        if (tid < 32) { int s = pstart[tid]; for (int g2 = 0; g2 < gi; ++g2) s += tbl[g2 * 32 + tid]; base[tid] = s; }
        const bool first = (gi == (int)blockIdx.x);
        if (tid < 256) { if (!first) { pe = c.topidx[gi * 256 + tid]; pg = c.gate[gi * 256 + tid]; } eids[tid] = pe; }
        __syncthreads();
        if (tid < 256) { const int e = eids[tid]; int r = 0; for (int a = 0; a < tid; ++a) r += (eids[a] == e) ? 1 : 0;
            const int slot = base[e] + r; c.tok_slot[gi * 256 + tid] = slot; c.slot_gate[slot] = pg; c.slot_tok[slot] = gi * 64 + (tid >> 2); }
        __syncthreads();
    }
}
__device__ __forceinline__ int xcd_chunk(long L, int n) { const int q = n / 8, r = n % 8, xcd = (int)(L % 8), off = (int)(L / 8); return (xcd < r ? xcd * (q + 1) : r * (q + 1) + (xcd - r) * q) + off; }
__device__ __forceinline__ void moe_early(int nb, int G, int& M, int& first_idle) {
    const int rem = (nb * 8) % G; first_idle = rem; const int idle = rem ? G - rem : 0, left = (nb * 4) % G;
    int m = (left + 31) / 32; if (m > 7 || 32 * m > idle) m = 0;
    M = m;
}
struct MoeOrder {
    const LAS int* blkexp; int nunits, G, c, lgN, mode, nb, M, first_idle;
    __device__ __forceinline__ int base(int x) const { return (x * nb + 7) / 8 + 20; }
    __device__ __forceinline__ bool next(int i, gx::Unit& u) const {
        if (mode == 1) { const int j = c - first_idle; if (i > 0 || j < 0 || j >= 32 * M) return false; const int t = j >> 3; u.pm = base(j & 7) + (t >> 2); u.pn = t & 3; u.e = blkexp[u.pm]; u.f = 0; return true; }
        const long L = (long)i * G + c; if (L >= nunits) return false;
        int id = xcd_chunk(L, nunits); if (mode == 2) id = nunits - 1 - id;
        int pm = id >> lgN, f = 0; u.pn = id & ((1 << lgN) - 1);
        if (mode == 2) { for (int x = 0; x < 8; ++x) pm += (pm >= base(x)) ? M : 0; }
        else { for (int x = 0; x < 8; ++x) f |= ((unsigned)(pm - base(x)) < (unsigned)M) ? 1 : 0; }
        u.pm = pm; u.e = blkexp[pm]; u.f = f; return true;
    }
};
__device__ __forceinline__ void moe_wait_rows(const int* done, int rb, int need = 64) {
    int tid = threadIdx.x; asm volatile("" : "+v"(tid));
    if (tid == 0) { unsigned sp = 0; while (__hip_atomic_load(done + rb, __ATOMIC_RELAXED, __HIP_MEMORY_SCOPE_AGENT) < need && ++sp < (1u << 22)) __builtin_amdgcn_s_sleep(2); }
    __syncthreads();
    __builtin_amdgcn_fence(__ATOMIC_ACQUIRE, "agent");
}
__device__ __forceinline__ int moe_blocks(const Ctx& c, LAS unsigned char* lds) {
    int tid = threadIdx.x; asm volatile("" : "+v"(tid));
    LAS int* blkexp = (LAS int*)(lds + LDS_TAB); LAS int* ps = blkexp + 288;
    if (tid < 33) ps[tid] = c.moe_pstart[tid];
    __syncthreads();
    const int nb = ps[32] / 256;
    if (tid < nb) { int e = 0; for (int k = 1; k < 32; ++k) e += (ps[k] <= tid * 256) ? 1 : 0; blkexp[tid] = e; }
    __syncthreads();
    return nb;
}
struct EpiSwiglu {
    static constexpr bool PERM = true;
    unsigned char* O; const float* bgu; int* done;
    __device__ __forceinline__ void operator()(const f32x4 (&acc)[2][2][4][2], const gx::Unit& u, int wr, int wc, int fr, int fq) const {
        const int row0 = u.pm * 256 + wr * 64 + fr, col = u.pn * 128 + wc * 32 + 8 * fq;
        const float* bp = bgu + (size_t)u.e * 2048 + col;
        const f32x4 bg0 = *(const f32x4*)bp, bg1 = *(const f32x4*)(bp + 4), bl0 = *(const f32x4*)(bp + 1024), bl1 = *(const f32x4*)(bp + 1028);
#pragma unroll
        for (int ai = 0; ai < 2; ++ai)
#pragma unroll
            for (int m = 0; m < 4; ++m) {
                f32x4 o[2];
#pragma unroll
                for (int n = 0; n < 2; ++n) {
                    const f32x4 xg = acc[ai][0][m][n] * (1.0f / 64.0f) + (n ? bg1 : bg0), xl = acc[ai][1][m][n] * (1.0f / 64.0f) + (n ? bl1 : bl0);
#pragma unroll
                    for (int j = 0; j < 4; ++j) { const float a = fminf(xg[j], 7.0f), b = fminf(fmaxf(xl[j], -7.0f), 7.0f); o[n][j] = a * fast_sigmoid(1.702f * a) * (b + 1.0f); }
                }
                u32x2 w; w.x = pk4_fp8(o[0][0], o[0][1], o[0][2], o[0][3]); w.y = pk4_fp8(o[1][0], o[1][1], o[1][2], o[1][3]); unsigned char* dst = O + (size_t)(row0 + ai * 128 + m * 16) * 1024 + col;
                if (u.f) __hip_atomic_store((unsigned long long*)dst, (unsigned long long)w.x | ((unsigned long long)w.y << 32), __ATOMIC_RELAXED, __HIP_MEMORY_SCOPE_AGENT);
                else *(u32x2*)dst = w;
            }
        if (u.f) { asm volatile("s_waitcnt vmcnt(0)" ::: "memory"); if ((fr | fq) == 0) (void)__hip_atomic_fetch_add(done + u.pm, 1, __ATOMIC_RELAXED, __HIP_MEMORY_SCOPE_AGENT); }
    }
};
struct EpiDown {
    static constexpr bool PERM = true;
    bf16_t* O; const float* bdn; const float* sg;
    __device__ __forceinline__ void operator()(const f32x4 (&acc)[2][2][4][2], const gx::Unit& u, int wr, int wc, int fr, int fq) const {
        const int row0 = u.pm * 256 + wr * 64 + fr, cl = u.pn * 256 + wc * 32 + 8 * fq;
        f32x4 b[2][2];
#pragma unroll
        for (int bj = 0; bj < 2; ++bj) { b[bj][0] = *(const f32x4*)(bdn + (size_t)u.e * 1024 + cl + bj * 128); b[bj][1] = *(const f32x4*)(bdn + (size_t)u.e * 1024 + cl + bj * 128 + 4); }
#pragma unroll
        for (int ai = 0; ai < 2; ++ai)
#pragma unroll
            for (int m = 0; m < 4; ++m) { const size_t row = (size_t)(row0 + ai * 128 + m * 16); const float gt = sg[row];
#pragma unroll
                for (int bj = 0; bj < 2; ++bj) *(u32x4*)(O + row * 1024 + cl + bj * 128) = pack8((acc[ai][bj][m][0] * (1.0f / 64.0f) + b[bj][0]) * gt, (acc[ai][bj][m][1] * (1.0f / 64.0f) + b[bj][1]) * gt); }
    }
};
__device__ __forceinline__ void moe_combine_ln(const Ctx& c, const float* g, const float* b, float* out  ) {
    int tid = threadIdx.x; asm volatile("" : "+v"(tid)); const int wave = __builtin_amdgcn_readfirstlane(tid >> 6), lane = tid & 63;
    const int stride = c.grid * 8; int t = blockIdx.x * 8 + wave;
    if (t >= ox_T) return;
    u32x2 xa[4]; u32x2 ya[4][4]; int sn[4];
#define CMB_SLOTS(dst, tt) do { _Pragma("unroll") for (int k = 0; k < 4; ++k) dst[k] = c.tok_slot[(tt) * 4 + k]; } while (0)
#define CMB_ROWS(xd, yd, tt, sl) do { _Pragma("unroll") for (int j = 0; j < 4; ++j) { const int col = lane * 4 + 256 * j; xd[j] = *(const u32x2*)(c.x1b + (size_t)(tt) * 1024 + col); \
        _Pragma("unroll") for (int k = 0; k < 4; ++k) yd[k][j] = *(const u32x2*)(c.ys2 + (size_t)sl[k] * 1024 + col); } } while (0)
    CMB_SLOTS(sn, t); CMB_ROWS(xa, ya, t, sn);
    { const int t1 = t + stride < ox_T ? t + stride : t; CMB_SLOTS(sn, t1); }
#pragma unroll 1
    for (; t < ox_T; t += stride) {
        f32x4 v[4]; float s = 0.f;
#pragma unroll
        for (int j = 0; j < 4; ++j) { f32x4 a = (f32x4){bflo(xa[j].x), bfhi(xa[j].x), bflo(xa[j].y), bfhi(xa[j].y)} * md::ALPHA;
            a[0] += (bflo(ya[0][j].x) + bflo(ya[1][j].x)) + (bflo(ya[2][j].x) + bflo(ya[3][j].x)); a[1] += (bfhi(ya[0][j].x) + bfhi(ya[1][j].x)) + (bfhi(ya[2][j].x) + bfhi(ya[3][j].x));
            a[2] += (bflo(ya[0][j].y) + bflo(ya[1][j].y)) + (bflo(ya[2][j].y) + bflo(ya[3][j].y)); a[3] += (bfhi(ya[0][j].y) + bfhi(ya[1][j].y)) + (bfhi(ya[2][j].y) + bfhi(ya[3][j].y));
            v[j] = a; s += (a[0] + a[1]) + (a[2] + a[3]); }
        { const int t1 = t + stride < ox_T ? t + stride : t, t2 = t + 2 * stride < ox_T ? t + 2 * stride : t; CMB_ROWS(xa, ya, t1, sn); CMB_SLOTS(sn, t2); }
        const float mean = wave_sum(s) * (1.0f / 1024.0f); float q = 0.f;
#pragma unroll
        for (int j = 0; j < 4; ++j) { v[j] = v[j] - mean; q += (v[j][0] * v[j][0] + v[j][1] * v[j][1]) + (v[j][2] * v[j][2] + v[j][3] * v[j][3]); }
        const float rstd = __builtin_amdgcn_rsqf(wave_sum(q) * (1.0f / 1024.0f) + md::EPS);
#pragma unroll
        for (int j = 0; j < 4; ++j) { const int col = lane * 4 + 256 * j; const f32x4 gg = *(const f32x4*)(g + col), bb = *(const f32x4*)(b + col);
            const f32x4 y = v[j] * rstd * gg + bb; if (out) *(f32x4*)(out + (size_t)t * 1024 + col) = y;
            u32x2 w; w.x = cvt_pk_bf16(y[0], y[1]); w.y = cvt_pk_bf16(y[2], y[3]); *(u32x2*)(c.xbf + (size_t)t * 1024 + col) = w; }
    }
#undef CMB_SLOTS
#undef CMB_ROWS
}
namespace ssd {
constexpr int PITCH = 272;
constexpr int XST_OFF = 0;
constexpr int R1_OFF = 69632;
constexpr int R2_OFF = 104448;
constexpr int S1_VEC = 104448;
constexpr int S3_VEC = 139264;
constexpr int NC = 64;
__device__ __forceinline__ size_t st_index(int dir, int b, int cidx, int h) { return ((((size_t)dir * 2 + b) * NC + cidx) * 32 + h) * 8192; }

__device__ __forceinline__ float softplus_fast(float x) { const float e = __expf(-fabsf(x)); return fmaxf(x, 0.0f) + (e < 1e-3f ? e * (1.0f - 0.5f * e) : __logf(1.0f + e)); }

__device__ __forceinline__ float cumsum8(LAS float* a, int wave, int lane) {
    LAS float* p = a + wave * 128 + 2 * lane;
    const float a0 = p[0], a1 = p[1];
    float v = a0 + a1;
#pragma unroll
    for (int off = 1; off < 64; off <<= 1) { const float t = __int_as_float(__builtin_amdgcn_ds_bpermute((lane - off) << 2, __float_as_int(v))); if (lane >= off) v += t; }
    const float total = __int_as_float(__builtin_amdgcn_readlane(__float_as_int(v), 63));
    if (wave < 4) { p[0] = v - a1; p[1] = v; } else { p[0] = total - (v - a1 - a0); p[1] = total - (v - a1); }
    return total;
}
template <int MODE>
__device__ __forceinline__ void load_conv(const Ctx& c, int l, int b, int cidx, int g, LAS unsigned char* lds, int tid) {
    const int cg = tid & 63, lg = tid >> 6;
    if (MODE == 1 && cg >= 48) return;
    const int col = cg < 32 ? 256 * g + 8 * cg : (cg < 48 ? 2048 + 128 * g + 8 * (cg - 32) : 3072 + 128 * g + 8 * (cg - 48));
    const float* cw = c.in[I_CONVW] + (size_t)l * 5 * 4096 + col; const float* cb = c.in[I_CONVB] + (size_t)l * 4096 + col;
    float w[5][8], bias[8];
#pragma unroll
    for (int k = 0; k < 5; ++k) { const f32x4 a = *(const f32x4*)(cw + k * 4096), bq = *(const f32x4*)(cw + k * 4096 + 4);
        w[k][0] = a[0]; w[k][1] = a[1]; w[k][2] = a[2]; w[k][3] = a[3]; w[k][4] = bq[0]; w[k][5] = bq[1]; w[k][6] = bq[2]; w[k][7] = bq[3]; }
    { const f32x4 a = *(const f32x4*)cb, bq = *(const f32x4*)(cb + 4); bias[0] = a[0]; bias[1] = a[1]; bias[2] = a[2]; bias[3] = a[3]; bias[4] = bq[0]; bias[5] = bq[1]; bias[6] = bq[2]; bias[7] = bq[3]; }
    const int tl0 = cidx * 128 + lg * 16 - 2;
    const bf16_t* src = c.XBCb + ((size_t)b * 8192) * 4096 + col;
    u32x4 rows[20];
#pragma unroll
    for (int i = 0; i < 20; ++i) { const int tl = tl0 + i; rows[i] = (tl >= 0 && tl < 8192) ? *(const u32x4*)(src + (size_t)tl * 4096) : uzero4(); }
    unsigned outp[8][8];
#pragma unroll
    for (int lo = 0; lo < 16; lo += 2) {
        float v[2][8];
#pragma unroll
        for (int d = 0; d < 2; ++d) {
#pragma unroll
            for (int j = 0; j < 8; ++j) v[d][j] = bias[j];
#pragma unroll
            for (int k = 0; k < 5; ++k) { const u32x4 r = rows[lo + d + k];
                v[d][0] += w[k][0] * bflo(r.x); v[d][1] += w[k][1] * bfhi(r.x); v[d][2] += w[k][2] * bflo(r.y); v[d][3] += w[k][3] * bfhi(r.y);
                v[d][4] += w[k][4] * bflo(r.z); v[d][5] += w[k][5] * bfhi(r.z); v[d][6] += w[k][6] * bflo(r.w); v[d][7] += w[k][7] * bfhi(r.w); }
#pragma unroll
            for (int j = 0; j < 8; ++j) v[d][j] = v[d][j] * fast_sigmoid(v[d][j]);
        }
        if (MODE == 3 && cg >= 32) {
            LAS unsigned char* base = lds + (cg < 48 ? R2_OFF : R1_OFF) + (8 * (cg < 48 ? cg - 32 : cg - 48)) * 2;
#pragma unroll
            for (int d = 0; d < 2; ++d) { f32x4 v0 = (f32x4){v[d][0], v[d][1], v[d][2], v[d][3]}, v1 = (f32x4){v[d][4], v[d][5], v[d][6], v[d][7]};
                *(LAS u32x4*)(base + (lg * 16 + lo + d) * PITCH) = pack8(v0, v1); }
        } else {
#pragma unroll
            for (int j = 0; j < 8; ++j) outp[j][lo >> 1] = cvt_pk_bf16(v[0][j], v[1][j]);
        }
    }
    if (!(MODE == 3 && cg >= 32)) {
        LAS unsigned char* base = lds + (cg < 32 ? XST_OFF + (8 * cg) * PITCH : R1_OFF + (8 * (cg - 32)) * PITCH) + (lg * 16) * 2;
#pragma unroll
        for (int j = 0; j < 8; ++j) { *(LAS u32x4*)(base + j * PITCH) = (u32x4){outp[j][0], outp[j][1], outp[j][2], outp[j][3]}; *(LAS u32x4*)(base + j * PITCH + 16) = (u32x4){outp[j][4], outp[j][5], outp[j][6], outp[j][7]}; }
    }
}

__device__ __forceinline__ void phase_s1(const Ctx& c, int l, LAS unsigned char* lds) {
    int tid = threadIdx.x;
    LAS float* dl = (LAS float*)(lds + S1_VEC); LAS float* ac = dl + 1024; LAS float* wv = ac + 1024;
    for (int item_ = blockIdx.x; item_ < 1024; item_ += c.grid) { const int item = 1023 - item_;
        asm volatile("" : "+v"(tid));
        const int wave = __builtin_amdgcn_readfirstlane(tid >> 6), lane = tid & 63, fr = lane & 15, q = lane >> 4;
        const int g = item & 7, cidx = (item >> 3) & 63, b = item >> 9; const size_t t0 = (size_t)b * 8192 + cidx * 128;
        load_conv<1>(c, l, b, cidx, g, lds, tid);
#pragma unroll
        for (int k = 0; k < 2; ++k) { const int e = tid + 512 * k, dir = e >> 9, r = (e >> 7) & 3, ll = e & 127, h = 4 * g + r;
            const float delta = softplus_fast(c.dtf[(t0 + ll) * 64 + dir * 32 + h] + c.in[I_DTB][l * 64 + dir * 32 + h]);
            dl[e] = delta; ac[e] = -__expf(c.in[I_ALOG][l * 64 + dir * 32 + h]) * delta; }
        __syncthreads();
        { const float tot = cumsum8(ac, wave, lane); if (lane == 0) c.ssd_tot[(((wave >> 2) * 2 + b) * NC + cidx) * 32 + 4 * g + (wave & 3)] = tot; }
        __syncthreads();
#pragma unroll
        for (int k = 0; k < 2; ++k) { const int e = tid + 512 * k, dir = e >> 9; const float tot = ac[(e & ~127) + (dir ? 0 : 127)]; wv[e] = dl[e] * __expf(tot - ac[e]); }
        __syncthreads();
        {
            const int r = wave & 3, dir = wave >> 2;
            f32x4 acc[8][4];
#pragma unroll
            for (int nt = 0; nt < 8; ++nt)
#pragma unroll
                for (int pt = 0; pt < 4; ++pt) acc[nt][pt] = zero4();
#pragma unroll
            for (int k = 0; k < 4; ++k) {
                const LAS float* wp = wv + (dir * 4 + r) * 128 + 32 * k + 8 * q;
                const f32x4 w0 = *(const LAS f32x4*)wp, w1 = *(const LAS f32x4*)(wp + 4);
                bf16x8 bfrag[4];
#pragma unroll
                for (int pt = 0; pt < 4; ++pt) { const u32x4 x = *(const LAS u32x4*)(lds + XST_OFF + (r * 64 + 16 * pt + fr) * PITCH + (32 * k + 8 * q) * 2);
                    u32x4 y; y.x = cvt_pk_bf16(bflo(x.x) * w0[0], bfhi(x.x) * w0[1]); y.y = cvt_pk_bf16(bflo(x.y) * w0[2], bfhi(x.y) * w0[3]);
                    y.z = cvt_pk_bf16(bflo(x.z) * w1[0], bfhi(x.z) * w1[1]); y.w = cvt_pk_bf16(bflo(x.w) * w1[2], bfhi(x.w) * w1[3]);
                    bfrag[pt] = __builtin_bit_cast(bf16x8, y); }
#pragma unroll
                for (int nt = 0; nt < 8; ++nt) { const bf16x8 af = *(const LAS bf16x8*)(lds + R1_OFF + (16 * nt + fr) * PITCH + (32 * k + 8 * q) * 2);
#pragma unroll
                    for (int pt = 0; pt < 4; ++pt) acc[nt][pt] = __builtin_amdgcn_mfma_f32_16x16x32_bf16(af, bfrag[pt], acc[nt][pt], 0, 0, 0); }
            }
            bf16_t* So = c.ssd_S + st_index(dir, b, cidx, 4 * g + r);
#pragma unroll
            for (int nt = 0; nt < 8; ++nt)
#pragma unroll
                for (int pt = 0; pt < 4; ++pt) { u32x2 o; o.x = cvt_pk_bf16(acc[nt][pt][0], acc[nt][pt][1]); o.y = cvt_pk_bf16(acc[nt][pt][2], acc[nt][pt][3]);
                    *(u32x2*)(So + (size_t)(16 * pt + fr) * 128 + 16 * nt + 4 * q) = o; }
        }
        __syncthreads();
    }
}
__device__ __forceinline__ void phase_s2(const Ctx& c) {
    int tid = threadIdx.x; asm volatile("" : "+v"(tid));
    for (int i = blockIdx.x * NTHREADS + tid; i < 2 * 2 * 32 * 64 * 16; i += c.grid * NTHREADS) {
        const int n8 = i & 15, p = (i >> 4) & 63, h = (i >> 10) & 31, b = (i >> 15) & 1, dir = i >> 16;
        float st[8];
#pragma unroll
        for (int j = 0; j < 8; ++j) st[j] = 0.f;
#pragma unroll 1
        for (int s0 = 0; s0 < NC; s0 += 8) {
            u32x4 x[8]; float dec[8];
#pragma unroll
            for (int u = 0; u < 8; ++u) { const int cidx = dir ? NC - 1 - (s0 + u) : s0 + u;
                x[u] = *(const u32x4*)(c.ssd_S + st_index(dir, b, cidx, h) + p * 128 + n8 * 8); dec[u] = c.ssd_tot[((dir * 2 + b) * NC + cidx) * 32 + h]; }
#pragma unroll
            for (int u = 0; u < 8; ++u) { const int cidx = dir ? NC - 1 - (s0 + u) : s0 + u; const float dq = __expf(dec[u]);
                *(u32x4*)(c.ssd_S + st_index(dir, b, cidx, h) + p * 128 + n8 * 8) = pack8((f32x4){st[0], st[1], st[2], st[3]}, (f32x4){st[4], st[5], st[6], st[7]});
                st[0] = st[0] * dq + bflo(x[u].x); st[1] = st[1] * dq + bfhi(x[u].x); st[2] = st[2] * dq + bflo(x[u].y); st[3] = st[3] * dq + bfhi(x[u].y);
                st[4] = st[4] * dq + bflo(x[u].z); st[5] = st[5] * dq + bfhi(x[u].z); st[6] = st[6] * dq + bflo(x[u].w); st[7] = st[7] * dq + bfhi(x[u].w); }
        }
    }
}
template <bool ZRAW>
__device__ __forceinline__ void phase_s3(const Ctx& c, int l, LAS unsigned char* lds) {
    int tid = threadIdx.x;
    LAS float* acf = (LAS float*)(lds + S3_VEC); LAS float* rcb = acf + 512; LAS float* gf = rcb + 512; LAS float* gb = gf + 512; LAS float* dl = gb + 512; LAS float* ssq = dl + 1024;
    for (int item = blockIdx.x; item < 1024; item += c.grid) {
        asm volatile("" : "+v"(tid));
        const int wave = __builtin_amdgcn_readfirstlane(tid >> 6), lane = tid & 63, fr = lane & 15, q = lane >> 4;
        const int g = item & 7, cidx = (item >> 3) & 63, b = item >> 9; const size_t t0 = (size_t)b * 8192 + cidx * 128;
        const int hrow = tid >> 2, hpart = tid & 3;
        u32x4 hreg[4];
        { const bf16_t* src = c.ssd_S + st_index(hrow >> 6, b, cidx, 4 * g) + (size_t)(hrow & 63) * 128 + hpart * 32;
            hreg[0] = *(const u32x4*)src; hreg[1] = *(const u32x4*)(src + 8); hreg[2] = *(const u32x4*)(src + 16); hreg[3] = *(const u32x4*)(src + 24); }
        load_conv<3>(c, l, b, cidx, g, lds, tid);
#pragma unroll
        for (int k = 0; k < 2; ++k) { const int e = tid + 512 * k, dir = e >> 9, r = (e >> 7) & 3, ll = e & 127, h = 4 * g + r;
            const float delta = softplus_fast(c.dtf[(t0 + ll) * 64 + dir * 32 + h] + c.in[I_DTB][l * 64 + dir * 32 + h]);
            dl[e] = delta; acf[e] = -__expf(c.in[I_ALOG][l * 64 + dir * 32 + h]) * delta; }
        __syncthreads();
        (void)cumsum8(acf, wave, lane);
        __syncthreads();
#pragma unroll
        for (int k = 0; k < 2; ++k) { const int e = tid + 512 * k; gf[e] = __logf(dl[e]) - acf[e]; }
        __syncthreads();
        const int lrow = 16 * wave + fr;
        bf16x8 cfrag[4];
#pragma unroll
        for (int k = 0; k < 4; ++k) cfrag[k] = *(const LAS bf16x8*)(lds + R1_OFF + lrow * PITCH + (32 * k + 8 * q) * 2);
        f32x4 cbt[8];
#pragma unroll
        for (int a = 0; a < 8; ++a) { cbt[a] = zero4();
#pragma unroll
            for (int k = 0; k < 4; ++k) { const bf16x8 bf = *(const LAS bf16x8*)(lds + R2_OFF + (16 * a + fr) * PITCH + (32 * k + 8 * q) * 2);
                cbt[a] = __builtin_amdgcn_mfma_f32_16x16x32_bf16(bf, cfrag[k], cbt[a], 0, 0, 0); } }
        __syncthreads();
        float ssq_l = 0.f;
#pragma unroll 1
        for (int r = 0; r < 4; ++r) {
            const int h = 4 * g + r;
            LAS unsigned char* hb = lds + ((r & 1) ? R1_OFF : R2_OFF);
            { LAS u32x4* dst = (LAS u32x4*)(hb + hrow * PITCH + hpart * 64); dst[0] = hreg[0]; dst[1] = hreg[1]; dst[2] = hreg[2]; dst[3] = hreg[3]; }
            if (r < 3) { const bf16_t* src = c.ssd_S + st_index(hrow >> 6, b, cidx, h + 1) + (size_t)(hrow & 63) * 128 + hpart * 32;
                hreg[0] = *(const u32x4*)src; hreg[1] = *(const u32x4*)(src + 8); hreg[2] = *(const u32x4*)(src + 16); hreg[3] = *(const u32x4*)(src + 24); }
            const size_t trow = t0 + lrow;
            u32x2 zpre[4];
#pragma unroll
            for (int pt = 0; pt < 4; ++pt) zpre[pt] = *(const u32x2*)(c.Zb + trow * 2048 + h * 64 + 16 * pt + 4 * q);
            const float af_l = acf[r * 128 + lrow], rb_l = rcb[r * 128 + lrow], dsk = c.in[I_SSDD][l * 32 + h];
            bf16x8 mfrag[4];
#pragma unroll
            for (int kk = 0; kk < 4; ++kk) {
                float m[8];
#pragma unroll
                for (int half = 0; half < 2; ++half) { const int a = 2 * kk + half, s0 = 16 * a + 4 * q;
                    if (a < wave) {
                        const f32x4 gfv = *(const LAS f32x4*)(gf + r * 128 + s0);
#pragma unroll
                        for (int j = 0; j < 4; ++j) m[half * 4 + j] = cbt[a][j] * __expf(af_l + gfv[j]);
                    } else if (a > wave) {
                        const f32x4 gbv = *(const LAS f32x4*)(gb + r * 128 + s0);
#pragma unroll
                        for (int j = 0; j < 4; ++j) m[half * 4 + j] = cbt[a][j] * __expf(rb_l + gbv[j]);
                    } else {
                        const f32x4 gfv = *(const LAS f32x4*)(gf + r * 128 + s0), gbv = *(const LAS f32x4*)(gb + r * 128 + s0);
#pragma unroll
                        for (int j = 0; j < 4; ++j) { const int s = s0 + j;
                            const float tf = (s <= lrow) ? __expf(af_l + gfv[j]) : 0.f, tb = (s >= lrow) ? __expf(rb_l + gbv[j]) : 0.f;
                            m[half * 4 + j] = cbt[a][j] * (tf + tb) + ((s == lrow) ? dsk : 0.f); } } }
                u32x4 y; y.x = cvt_pk_bf16(m[0], m[1]); y.y = cvt_pk_bf16(m[2], m[3]); y.z = cvt_pk_bf16(m[4], m[5]); y.w = cvt_pk_bf16(m[6], m[7]);
                mfrag[kk] = __builtin_bit_cast(bf16x8, y);
            }
            __syncthreads();
            const float ef = __expf(af_l), eb = __expf(rb_l);
#pragma unroll 1
            for (int ph = 0; ph < 2; ++ph) {
                f32x4 accd[2], accf[2], accb[2];
#pragma unroll
                for (int p2 = 0; p2 < 2; ++p2) { accd[p2] = zero4(); accf[p2] = accd[p2]; accb[p2] = accd[p2]; }
#pragma unroll
                for (int kk = 0; kk < 4; ++kk)
#pragma unroll
                    for (int p2 = 0; p2 < 2; ++p2) { const int pt = 2 * ph + p2;
                        const LAS unsigned char* xr = lds + XST_OFF + (r * 64 + 16 * pt + fr) * PITCH + (32 * kk + 4 * q) * 2;
                        const u32x2 x0 = *(const LAS u32x2*)xr, x1 = *(const LAS u32x2*)(xr + 32);
                        const u32x4 xa = (u32x4){x0.x, x0.y, x1.x, x1.y};
                        accd[p2] = __builtin_amdgcn_mfma_f32_16x16x32_bf16(__builtin_bit_cast(bf16x8, xa), mfrag[kk], accd[p2], 0, 0, 0);
                        const bf16x8 hf = *(const LAS bf16x8*)(hb + (16 * pt + fr) * PITCH + (32 * kk + 8 * q) * 2);
                        const bf16x8 hbk = *(const LAS bf16x8*)(hb + (64 + 16 * pt + fr) * PITCH + (32 * kk + 8 * q) * 2);
                        accf[p2] = __builtin_amdgcn_mfma_f32_16x16x32_bf16(hf, cfrag[kk], accf[p2], 0, 0, 0);
                        accb[p2] = __builtin_amdgcn_mfma_f32_16x16x32_bf16(hbk, cfrag[kk], accb[p2], 0, 0, 0);
                    }
#pragma unroll
                for (int p2 = 0; p2 < 2; ++p2) { const int pt = 2 * ph + p2;
                    const int col = h * 64 + 16 * pt + 4 * q;
                    const u32x2 zw = p2 ? (ph ? zpre[3] : zpre[1]) : (ph ? zpre[2] : zpre[0]);
                    float zz[4] = {bflo(zw.x), bfhi(zw.x), bflo(zw.y), bfhi(zw.y)}, yv[4];
#pragma unroll
                    for (int j = 0; j < 4; ++j) { const float zg = ZRAW ? zz[j] * fast_sigmoid(zz[j]) : zz[j]; yv[j] = (accd[p2][j] + ef * accf[p2][j] + eb * accb[p2][j]) * zg; ssq_l += yv[j] * yv[j]; }
                    u32x2 o; o.x = cvt_pk_bf16(yv[0], yv[1]); o.y = cvt_pk_bf16(yv[2], yv[3]);
                    *(u32x2*)(c.yssdb + trow * 2048 + col) = o;
                }
            }
        }
        ssq[lrow * 4 + q] = ssq_l;
        __syncthreads();
        if (tid < 128) c.ssd_ssq[(t0 + tid) * 8 + g] = (ssq[tid * 4] + ssq[tid * 4 + 1]) + (ssq[tid * 4 + 2] + ssq[tid * 4 + 3]);
        __syncthreads();
    }
}
}
namespace s5 {
constexpr int NROWS = 72 * 1024;
__device__ __forceinline__ void prologue(const Ctx& c, int l, int par, LAS unsigned char* lds, int first_wg, int n_wg, int g0, int g1) {
    int tid = threadIdx.x; asm volatile("" : "+v"(tid));
    LAS float* pw = (LAS float*)lds;
    LAS float* bb = pw + 2 * 17 * 64 * 2;
    LAS float* cc = bb + 2 * 64 * 16 * 2;
    LAS float* Kt = cc + 2 * 16 * 130;
    __syncthreads();
    for (int g = (int)blockIdx.x >= first_wg ? g0 + (int)blockIdx.x - first_wg : g1; g < g1; g += n_wg) {
        if (tid < 128) { const int d = tid >> 6, n = tid & 63;
            const float ar = c.in[I_S5ARE][((size_t)(l * 2 + d) * 72 + g) * 64 + n], ai = c.in[I_S5AIM][((size_t)(l * 2 + d) * 72 + g) * 64 + n];
            const float step = __expf(c.in[I_S5LS][(l * 2 + d) * 72 + g]);
            const float mag = __expf(step * ar); const float abr = mag * __cosf(step * ai), abi = mag * __sinf(step * ai);
            const float rden = __builtin_amdgcn_rcpf(ar * ar + ai * ai); const float fr = ((abr - 1.0f) * ar + abi * ai) * rden, fi = (abi * ar - (abr - 1.0f) * ai) * rden;
            { const float* brp = c.in[I_S5BRE] + (((size_t)l * 72 + g) * 64 + n) * 16; const float* bip = c.in[I_S5BIM] + (((size_t)l * 72 + g) * 64 + n) * 16;
              f32x4 brv[4], biv[4];
#pragma unroll
              for (int q4 = 0; q4 < 4; ++q4) { brv[q4] = *(const f32x4*)(brp + 4 * q4); biv[q4] = *(const f32x4*)(bip + 4 * q4); }
#pragma unroll
              for (int ch = 0; ch < 16; ++ch) { const float br = brv[ch >> 2][ch & 3], bi = biv[ch >> 2][ch & 3];
                  bb[((d * 64 + n) * 16 + ch) * 2] = fr * br - fi * bi; bb[((d * 64 + n) * 16 + ch) * 2 + 1] = fr * bi + fi * br; } }
            float pr = 1.0f, pi = 0.0f;
#pragma clang loop unroll(disable)
            for (int j = 0; j <= 16; ++j) { pw[((d * 17 + j) * 64 + n) * 2] = pr; pw[((d * 17 + j) * 64 + n) * 2 + 1] = pi; const float nr = pr * abr - pi * abi, ni = pr * abi + pi * abr; pr = nr; pi = ni; }
            float* a16 = c.s5_a16 + par * wsz::A16; a16[((g * 2 + d) * 64 + n) * 2] = pw[((d * 17 + 16) * 64 + n) * 2]; a16[((g * 2 + d) * 64 + n) * 2 + 1] = pw[((d * 17 + 16) * 64 + n) * 2 + 1]; }
        for (int i = tid; i < 2 * 16 * 64; i += NTHREADS) { const int d = i >> 10, ch = (i >> 6) & 15, n = i & 63;
            cc[(d * 16 + ch) * 130 + n * 2] = c.in[I_S5CRE][(((size_t)(l * 2 + d) * 72 + g) * 16 + ch) * 64 + n]; cc[(d * 16 + ch) * 130 + n * 2 + 1] = c.in[I_S5CIM][(((size_t)(l * 2 + d) * 72 + g) * 16 + ch) * 64 + n]; }
        __syncthreads();
        { const int lane = tid & 63, wv = __builtin_amdgcn_readfirstlane(tid >> 6), d = wv >> 2, r16 = lane & 15, kq = lane >> 4;
          float bre[16], bim[16];
#pragma unroll
          for (int sidx = 0; sidx < 16; ++sidx) { const LAS float* bp = bb + ((d * 64 + 4 * sidx + kq) * 16 + r16) * 2; bre[sidx] = bp[0]; bim[sidx] = bp[1]; }
#pragma clang loop unroll(disable)
          for (int jj = 0; jj < 4; ++jj) { const int j = 4 * (wv & 3) + jj; f32x4 acc = zero4();
#pragma unroll
              for (int sidx = 0; sidx < 16; ++sidx) { const int n = 4 * sidx + kq;
                  const float cr = cc[(d * 16 + r16) * 130 + n * 2], ci = cc[(d * 16 + r16) * 130 + n * 2 + 1], pr = pw[((d * 17 + j) * 64 + n) * 2], pi = pw[((d * 17 + j) * 64 + n) * 2 + 1];
                  const float wr = cr * pr - ci * pi, wi = cr * pi + ci * pr;
                  acc = __builtin_amdgcn_mfma_f32_16x16x4f32(wr, bre[sidx], acc, 0, 0, 0); acc = __builtin_amdgcn_mfma_f32_16x16x4f32(-wi, bim[sidx], acc, 0, 0, 0); }
#pragma unroll
              for (int r = 0; r < 4; ++r) Kt[((d * 16 + j) * 16 + 4 * kq + r) * 16 + r16] = acc[r]; } }
        __syncthreads();
        bf16_t* W1 = c.s5_W1 + par * wsz::S5W1 + (size_t)g * 512 * 256; bf16_t* Qm = c.s5_Q + par * wsz::S5Q + (size_t)g * 256 * 256;
        for (int i = tid; i < 256 * 256 / 2; i += NTHREADS) { const int row = i >> 7, col = (i & 127) * 2; const int l1 = row >> 4, c1 = row & 15, l2 = col >> 4, c2 = col & 15; float v[2];
#pragma unroll
            for (int e = 0; e < 2; ++e) { float s = 0.f; if (l2 <= l1) s += Kt[((0 * 16 + (l1 - l2)) * 16 + c1) * 16 + c2 + e]; if (l2 >= l1) s += Kt[((1 * 16 + (l2 - l1)) * 16 + c1) * 16 + c2 + e]; v[e] = s; }
            *(unsigned*)(W1 + (size_t)row * 256 + col) = cvt_pk_bf16(v[0], v[1]); }
        for (int i = tid; i < 256 * 256 / 2; i += NTHREADS) { const int row = i >> 7, col = (i & 127) * 2; const int d = row >> 7, part = (row >> 6) & 1, n = row & 63, l2 = col >> 4, c2 = col & 15;
            const int j = d ? l2 : 15 - l2; const float pr = pw[((d * 17 + j) * 64 + n) * 2], pi = pw[((d * 17 + j) * 64 + n) * 2 + 1]; float v[2];
#pragma unroll
            for (int e = 0; e < 2; ++e) { const float br = bb[((d * 64 + n) * 16 + c2 + e) * 2], bi = bb[((d * 64 + n) * 16 + c2 + e) * 2 + 1]; v[e] = part ? (pr * bi + pi * br) : (pr * br - pi * bi); }
            *(unsigned*)(W1 + (size_t)(256 + row) * 256 + col) = cvt_pk_bf16(v[0], v[1]); }
        for (int i = tid; i < 256 * 256 / 2; i += NTHREADS) { const int row = i >> 7, col = (i & 127) * 2; const int l1 = row >> 4, c1 = row & 15, d = col >> 7, part = (col >> 6) & 1, n = col & 63;
            const int j = d ? 16 - l1 : l1 + 1; float v[2];
#pragma unroll
            for (int e = 0; e < 2; ++e) { const float cr = cc[(d * 16 + c1) * 130 + (n + e) * 2], ci = cc[(d * 16 + c1) * 130 + (n + e) * 2 + 1], pr = pw[((d * 17 + j) * 64 + n + e) * 2], pi = pw[((d * 17 + j) * 64 + n + e) * 2 + 1];
                v[e] = part ? -(cr * pi + ci * pr) : (cr * pr - ci * pi); }
            *(unsigned*)(Qm + (size_t)row * 256 + col) = cvt_pk_bf16(v[0], v[1]); }
        __syncthreads();
    }
}
struct Order { int nunits, G, c, lgN, rev, mode;
    __device__ __forceinline__ int late_cnt() const { return (nunits > G && nunits <= 2 * G) ? nunits - G : 0; }
    __device__ __forceinline__ bool next(int i, gx::Unit& u) const {
        long L = (long)i * G + c; const int lc = late_cnt();
        if (mode == 2) { const int g3 = 576 % G, off = (g3 + lc <= G) ? g3 : 0, j = c - off; if (i > 0 || j < 0 || j >= lc) return false; L = G + j; }
        else if (L >= nunits || (mode == 1 && lc > 0 && i > 0)) return false;
        int id = xcd_chunk(L, nunits); if (rev) id = nunits - 1 - id; u.pm = (int)(id >> lgN); u.pn = (int)(id & ((1 << lgN) - 1)); u.e = u.pm >> 2; u.f = (mode == 2) ? 1 : 0; return true; } };
struct Epi1 {
    static constexpr bool PERM = true;
    bf16_t* Y; bf16_t* S;
    __device__ __forceinline__ void operator()(const f32x4 (&acc)[2][2][4][2], const gx::Unit& u, int wr, int wc, int fr, int fq) const {
        const int row0 = u.pm * 256 + wr * 64 + fr, cl = wc * 32 + 8 * fq;
#pragma unroll
        for (int ai = 0; ai < 2; ++ai)
#pragma unroll
            for (int m = 0; m < 4; ++m)
#pragma unroll
                for (int bj = 0; bj < 2; ++bj) { const size_t off = (size_t)(row0 + ai * 128 + m * 16) * 256 + bj * 128 + cl;
                    *(u32x4*)((u.pn == 0 ? Y : S) + off) = pack8(acc[ai][bj][m][0], acc[ai][bj][m][1]); }
    }
};
__device__ __forceinline__ void scan(const Ctx& c, int par, LAS unsigned char* lds) {
    int tid = threadIdx.x; asm volatile("" : "+v"(tid)); const int nl = tid & 31, seg = tid >> 5;
    LAS float* seg_r = (LAS float*)lds; LAS float* seg_i = seg_r + 512;
    __syncthreads();
    for (int item = blockIdx.x; item < 576; item += c.grid) {
        const int nh = item & 1, d = (item >> 1) & 1, b = (item >> 2) & 1, g = item >> 3, n = nh * 32 + nl;
        const float ar = c.s5_a16[par * wsz::A16 + ((g * 2 + d) * 64 + n) * 2], ai = c.s5_a16[par * wsz::A16 + ((g * 2 + d) * 64 + n) * 2 + 1];
        const size_t base = ((size_t)g * 1024 + b * 512) * 256 + d * 128 + n;
        float lr[32], li[32];
#pragma unroll
        for (int j = 0; j < 32; ++j) { const int p = 32 * seg + j; const size_t o = base + (size_t)(d ? 511 - p : p) * 256; lr[j] = bf2f(c.s5_Sloc[o]); li[j] = bf2f(c.s5_Sloc[o + 64]); }
        float sr = 0.f, si = 0.f;
#pragma unroll
        for (int j = 0; j < 32; ++j) { const float nr = ar * sr - ai * si + lr[j], ni = ar * si + ai * sr + li[j]; sr = nr; si = ni; }
        seg_r[seg * 32 + nl] = sr; seg_i[seg * 32 + nl] = si;
        float pr = ar, pi = ai;
#pragma unroll
        for (int q = 0; q < 5; ++q) { const float nr = pr * pr - pi * pi, ni = 2.0f * pr * pi; pr = nr; pi = ni; }
        __syncthreads();
        float cr = 0.f, ci = 0.f;
        for (int s2 = 0; s2 < seg; ++s2) { const float er = seg_r[s2 * 32 + nl], ei = seg_i[s2 * 32 + nl]; const float nr = pr * cr - pi * ci + er, ni = pr * ci + pi * cr + ei; cr = nr; ci = ni; }
        sr = cr; si = ci;
#pragma unroll
        for (int j = 0; j < 32; ++j) { const int p = 32 * seg + j; const size_t o = base + (size_t)(d ? 511 - p : p) * 256;
            c.s5_Sin[o] = (bf16_t)f2bf(sr); c.s5_Sin[o + 64] = (bf16_t)f2bf(si);
            const float nr = ar * sr - ai * si + lr[j], ni = ar * si + ai * sr + li[j]; sr = nr; si = ni; }
        __syncthreads();
    }
}
struct Epi2 {
    static constexpr bool PERM = true;
    const bf16_t* Y; const bf16_t* U; const float* dsk; bf16_t* O; int* done;
    __device__ __forceinline__ void operator()(const f32x4 (&acc)[2][2][4][2], const gx::Unit& u, int wr, int wc, int fr, int fq) const {
        const int row0 = u.pm * 256 + wr * 64 + fr, cl = wc * 32 + 8 * fq, g = u.e, c0 = cl & 15;
        const f32x4 d0 = *(const f32x4*)(dsk + g * 16 + c0), d1 = *(const f32x4*)(dsk + g * 16 + c0 + 4);
#pragma unroll
        for (int ai = 0; ai < 2; ++ai) {
            u32x4 yw[4][2], uw[4][2];
#pragma unroll
            for (int m = 0; m < 4; ++m)
#pragma unroll
                for (int bj = 0; bj < 2; ++bj) { const size_t off = (size_t)(row0 + ai * 128 + m * 16) * 256 + bj * 128 + cl; yw[m][bj] = *(const u32x4*)(Y + off); uw[m][bj] = *(const u32x4*)(U + off); }
#pragma unroll
            for (int m = 0; m < 4; ++m)
#pragma unroll
                for (int bj = 0; bj < 2; ++bj) { const int R = row0 + ai * 128 + m * 16, col = bj * 128 + cl; const int tok = (R & 1023) * 16 + (col >> 4);
                    const u32x4 y4 = yw[m][bj], u4 = uw[m][bj];
                    f32x4 v0 = acc[ai][bj][m][0] + (f32x4){bflo(y4.x), bfhi(y4.x), bflo(y4.y), bfhi(y4.y)} + d0 * (f32x4){bflo(u4.x), bfhi(u4.x), bflo(u4.y), bfhi(u4.y)};
                    f32x4 v1 = acc[ai][bj][m][1] + (f32x4){bflo(y4.z), bfhi(y4.z), bflo(y4.w), bfhi(y4.w)} + d1 * (f32x4){bflo(u4.z), bfhi(u4.z), bflo(u4.w), bfhi(u4.w)};
#pragma unroll
                    for (int j = 0; j < 4; ++j) { const float a = v0[j], bq = v1[j];
                        v0[j] = a * fast_sigmoid(1.5957691216f * (a + 0.044715f * a * a * a)); v1[j] = bq * fast_sigmoid(1.5957691216f * (bq + 0.044715f * bq * bq * bq)); }
                    const u32x4 w = pack8(v0, v1); bf16_t* dst = O + (size_t)tok * 1152 + g * 16 + c0;
                    if (u.f) {
                        __hip_atomic_store((unsigned long long*)dst, (unsigned long long)w.x | ((unsigned long long)w.y << 32), __ATOMIC_RELAXED, __HIP_MEMORY_SCOPE_AGENT);
                        __hip_atomic_store((unsigned long long*)dst + 1, (unsigned long long)w.z | ((unsigned long long)w.w << 32), __ATOMIC_RELAXED, __HIP_MEMORY_SCOPE_AGENT);
                    } else *(u32x4*)dst = w; }
        }
        if (u.f) { asm volatile("s_waitcnt vmcnt(0)" ::: "memory"); if ((fr | fq) == 0) (void)__hip_atomic_fetch_add(done, 1, __ATOMIC_RELAXED, __HIP_MEMORY_SCOPE_AGENT); }
    }
};
}
namespace att {
constexpr int KP = 144, VP = 776;
constexpr int K_OFF = 0, VT_OFF = 384 * KP;
typedef float f32x16 __attribute__((ext_vector_type(16)));
__device__ __forceinline__ f32x16 zero16() { float z = 0.f; asm volatile("" : "+v"(z)); return (f32x16){z, z, z, z, z, z, z, z, z, z, z, z, z, z, z, z}; }
__device__ __forceinline__ void phase(const Ctx& c, LAS unsigned char* lds) {
    int tid = threadIdx.x;
    for (int item = ((int)blockIdx.x + c.grid / 2) % c.grid; item < 1152; item += c.grid) {
        asm volatile("" : "+v"(tid));
        const int wave = __builtin_amdgcn_readfirstlane(tid >> 6), lane = tid & 63, lr = lane & 31, hh = lane >> 5;
        const int itm = 1151 - item;
        const int blk = itm & 31, rest = itm >> 5, h = rest % 6, g = (rest / 6) % 3, b = rest / 18;
        const int dil = g == 0 ? 1 : (g == 1 ? 4 : 16), ls = 8192 / dil, ipc = 32 / dil, r = blk / ipc, i0 = (blk % ipc) * 256;
        const float slope = __builtin_amdgcn_exp2f((float)(h * 3 + g + 1) * (-8.0f / 18.0f)) * (float)dil;
        const bf16_t* qkv = c.QKVU + (size_t)b * 8192 * 4608 + g * 384 + h * 64;
        for (int u = tid; u < 384 * 8; u += NTHREADS) { const int kl = u >> 3, part = u & 7, ik = i0 - 64 + kl;
            u32x4 v = uzero4();
            if (ik >= 0 && ik < ls) v = *(const u32x4*)(qkv + (size_t)(ik * dil + r) * 4608 + 1152 + part * 8);
            *(LAS u32x4*)(lds + K_OFF + kl * KP + part * 16) = v; }
        for (int u = tid; u < 192 * 8; u += NTHREADS) { const int part = u / 192, kp = u % 192, ik = i0 - 64 + 2 * kp;
            u32x4 v0 = uzero4(), v1 = v0;
            if (ik >= 0 && ik < ls) v0 = *(const u32x4*)(qkv + (size_t)(ik * dil + r) * 4608 + 2304 + part * 8);
            if (ik + 1 >= 0 && ik + 1 < ls) v1 = *(const u32x4*)(qkv + (size_t)((ik + 1) * dil + r) * 4608 + 2304 + part * 8);
            LAS unsigned char* dst = lds + VT_OFF + (part * 8) * VP + kp * 4;
            *(LAS unsigned*)(dst + 0 * VP) = (v0.x & 0xffffu) | (v1.x << 16); *(LAS unsigned*)(dst + 1 * VP) = (v0.x >> 16) | (v1.x & 0xffff0000u);
            *(LAS unsigned*)(dst + 2 * VP) = (v0.y & 0xffffu) | (v1.y << 16); *(LAS unsigned*)(dst + 3 * VP) = (v0.y >> 16) | (v1.y & 0xffff0000u);
            *(LAS unsigned*)(dst + 4 * VP) = (v0.z & 0xffffu) | (v1.z << 16); *(LAS unsigned*)(dst + 5 * VP) = (v0.z >> 16) | (v1.z & 0xffff0000u);
            *(LAS unsigned*)(dst + 6 * VP) = (v0.w & 0xffffu) | (v1.w << 16); *(LAS unsigned*)(dst + 7 * VP) = (v0.w >> 16) | (v1.w & 0xffff0000u); }
        const int q0 = 32 * wave, iq = i0 + q0 + lr;
        const size_t tq = (size_t)(iq * dil + r);
        bf16x8 qf[4];
#pragma unroll
        for (int ks = 0; ks < 4; ++ks) qf[ks] = *(const bf16x8*)(qkv + tq * 4608 + 16 * ks + 8 * hh);
        __syncthreads();
        f32x16 st[5];
#pragma unroll
        for (int kt = 0; kt < 5; ++kt) { st[kt] = zero16();
#pragma unroll
            for (int ks = 0; ks < 4; ++ks) { const bf16x8 kf = *(const LAS bf16x8*)(lds + K_OFF + (q0 + 32 * kt + lr) * KP + (16 * ks + 8 * hh) * 2);
                st[kt] = __builtin_amdgcn_mfma_f32_32x32x16_bf16(kf, qf[ks], st[kt], 0, 0, 0); } }
        float mx = -1e30f;
        int dlt = 4 * hh - lr; asm volatile("" : "+v"(dlt));
        const int ikb = i0 - 64 + q0 + 4 * hh;
#pragma unroll
        for (int kt = 0; kt < 5; ++kt)
#pragma unroll
            for (int reg = 0; reg < 16; ++reg) { const int kc = 32 * kt + (reg & 3) + 8 * (reg >> 2);
                const int d = kc - 64 + dlt, dist = d < 0 ? -d : d, ik = ikb + kc;
                const bool ok = dist <= 64 && ik >= 0 && ik < ls;
                const float s = ok ? st[kt][reg] * 0.125f - slope * (float)dist : -1e30f;
                st[kt][reg] = s; mx = fmaxf(mx, s); }
        mx = fmaxf(mx, __int_as_float(__builtin_amdgcn_ds_bpermute((lane ^ 32) << 2, __float_as_int(mx))));
        float sum = 0.f;
#pragma unroll
        for (int kt = 0; kt < 5; ++kt)
#pragma unroll
            for (int reg = 0; reg < 16; ++reg) { const float p = st[kt][reg] > -1e29f ? __expf(st[kt][reg] - mx) : 0.f; st[kt][reg] = p; sum += p; }
        sum += __int_as_float(__builtin_amdgcn_ds_bpermute((lane ^ 32) << 2, __float_as_int(sum)));
        f32x16 o[2];
#pragma unroll
        for (int dt = 0; dt < 2; ++dt) o[dt] = zero16();
#pragma unroll
        for (int kt = 0; kt < 5; ++kt)
#pragma unroll
            for (int s2 = 0; s2 < 2; ++s2) {
                u32x4 pw; pw.x = cvt_pk_bf16(st[kt][8 * s2 + 0], st[kt][8 * s2 + 1]); pw.y = cvt_pk_bf16(st[kt][8 * s2 + 2], st[kt][8 * s2 + 3]);
                pw.z = cvt_pk_bf16(st[kt][8 * s2 + 4], st[kt][8 * s2 + 5]); pw.w = cvt_pk_bf16(st[kt][8 * s2 + 6], st[kt][8 * s2 + 7]);
                const bf16x8 pf = __builtin_bit_cast(bf16x8, pw);
#pragma unroll
                for (int dt = 0; dt < 2; ++dt) { const LAS unsigned char* vp = lds + VT_OFF + (32 * dt + lr) * VP + (q0 + 32 * kt + 16 * s2 + 4 * hh) * 2;
                    const u32x2 a0 = *(const LAS u32x2*)vp, a1 = *(const LAS u32x2*)(vp + 16);
                    const u32x4 av = (u32x4){a0.x, a0.y, a1.x, a1.y};
                    o[dt] = __builtin_amdgcn_mfma_f32_32x32x16_bf16(__builtin_bit_cast(bf16x8, av), pf, o[dt], 0, 0, 0); }
            }
        const float inv = __builtin_amdgcn_rcpf(sum); const size_t tglob = (size_t)b * 8192 + tq;
        bf16_t* op = c.attob + ((size_t)g * 16384 + tglob) * 384 + h * 64;
#pragma unroll
        for (int dt = 0; dt < 2; ++dt)
#pragma unroll
            for (int rg = 0; rg < 4; ++rg) { u32x2 w; w.x = cvt_pk_bf16(o[dt][4 * rg + 0] * inv, o[dt][4 * rg + 1] * inv); w.y = cvt_pk_bf16(o[dt][4 * rg + 2] * inv, o[dt][4 * rg + 3] * inv);
                *(u32x2*)(op + 32 * dt + 8 * rg + 4 * hh) = w; }
        if (hh == 0) c.attlse[((size_t)g * 16384 + tglob) * 6 + h] = mx + __logf(sum);
        __syncthreads();
    }
}
__device__ __forceinline__ void combine(const Ctx& c, long i) {
    const int c8 = (int)(i % 48); const long t = i / 48; const int h = c8 >> 3;
    const float l0 = c.attlse[((size_t)0 * 16384 + t) * 6 + h], l1 = c.attlse[((size_t)1 * 16384 + t) * 6 + h], l2 = c.attlse[((size_t)2 * 16384 + t) * 6 + h];
    const float m = fmaxf(l0, fmaxf(l1, l2)); float w0 = __expf(l0 - m), w1 = __expf(l1 - m), w2 = __expf(l2 - m); const float inv = __builtin_amdgcn_rcpf(w0 + w1 + w2); w0 *= inv; w1 *= inv; w2 *= inv;
    const u32x4 a = *(const u32x4*)(c.attob + ((size_t)0 * 16384 + t) * 384 + c8 * 8), bq = *(const u32x4*)(c.attob + ((size_t)1 * 16384 + t) * 384 + c8 * 8), cq = *(const u32x4*)(c.attob + ((size_t)2 * 16384 + t) * 384 + c8 * 8);
    f32x4 v0, v1;
    v0[0] = w0 * bflo(a.x) + w1 * bflo(bq.x) + w2 * bflo(cq.x); v0[1] = w0 * bfhi(a.x) + w1 * bfhi(bq.x) + w2 * bfhi(cq.x);
    v0[2] = w0 * bflo(a.y) + w1 * bflo(bq.y) + w2 * bflo(cq.y); v0[3] = w0 * bfhi(a.y) + w1 * bfhi(bq.y) + w2 * bfhi(cq.y);
    v1[0] = w0 * bflo(a.z) + w1 * bflo(bq.z) + w2 * bflo(cq.z); v1[1] = w0 * bfhi(a.z) + w1 * bfhi(bq.z) + w2 * bfhi(cq.z);
    v1[2] = w0 * bflo(a.w) + w1 * bflo(bq.w) + w2 * bflo(cq.w); v1[3] = w0 * bfhi(a.w) + w1 * bfhi(bq.w) + w2 * bfhi(cq.w);
    *(u32x4*)(c.yattb + t * 384 + c8 * 8) = pack8(v0, v1);
}
}
namespace lnr {
constexpr int XP = 1028;
constexpr int PART_OFF = 16 * XP * 4, CNT_OFF = PART_OFF + 8 * 16 * 32 * 4, GB_OFF = CNT_OFF + 128;
__device__ __forceinline__ void phase(const Ctx& c, int l, LAS unsigned char* lds) {
    int tid = threadIdx.x; asm volatile("" : "+v"(tid)); const int wave = __builtin_amdgcn_readfirstlane(tid >> 6), lane = tid & 63;
    const bf16_t* xin = c.xbf;
    LAS float* xf = (LAS float*)lds; LAS float* part = (LAS float*)(lds + PART_OFF); LAS int* cnt_l = (LAS int*)(lds + CNT_OFF);
    float wreg[2][32];
    { const float* rw = c.in[I_RW] + (size_t)l * 1024 * 32 + (size_t)(128 * wave + 4 * (lane >> 4)) * 32 + (lane & 15);
#pragma unroll
      for (int s4 = 0; s4 < 8; ++s4)
#pragma unroll
        for (int i = 0; i < 4; ++i) { wreg[0][4 * s4 + i] = rw[(16 * s4 + i) * 32]; wreg[1][4 * s4 + i] = rw[(16 * s4 + i) * 32 + 16]; } }
    LAS float* gb = (LAS float*)(lds + GB_OFF);
    __syncthreads();
    for (int i = tid; i < 1024; i += NTHREADS) { gb[i] = c.in[I_LN1G][l * 1024 + i]; gb[1024 + i] = c.in[I_LN1B][l * 1024 + i]; }
    const float rbias = c.in[I_RB][l * 32 + (lane & 31)];
    __syncthreads();
    u32x2 xr[4], mr[4];
#define LNR_LOAD(tok) do { const size_t b0_ = (size_t)(tok) * 1024 + 4 * lane; _Pragma("unroll") for (int jq = 0; jq < 4; ++jq) { xr[jq] = *(const u32x2*)(xin + b0_ + 256 * jq); mr[jq] = *(const u32x2*)(c.mixb + b0_ + 256 * jq); } } while (0)
    if ((int)blockIdx.x < ox_T / 64) LNR_LOAD(blockIdx.x * 64 + wave * 2);
#pragma unroll 1
    for (int gi = blockIdx.x; gi < ox_T / 64; gi += c.grid) {
      if (tid < 32) cnt_l[tid] = 0;
#pragma unroll 1
      for (int q = 0; q < 4; ++q) {
        int tid2 = tid; asm volatile("" : "+v"(tid2)); const int lane = tid2 & 63;
#pragma unroll 1
        for (int tt = 0; tt < 2; ++tt) {
          const int t = gi * 64 + 16 * q + 2 * wave + tt;
          float x[16];
          const size_t base = (size_t)t * 1024 + 4 * lane; float s = 0.f;
#pragma unroll
          for (int jq = 0; jq < 4; ++jq) { x[4 * jq] = md::ALPHA * bflo(xr[jq].x) + bflo(mr[jq].x); x[4 * jq + 1] = md::ALPHA * bfhi(xr[jq].x) + bfhi(mr[jq].x);
              x[4 * jq + 2] = md::ALPHA * bflo(xr[jq].y) + bflo(mr[jq].y); x[4 * jq + 3] = md::ALPHA * bfhi(xr[jq].y) + bfhi(mr[jq].y); }
#pragma unroll
          for (int j = 0; j < 16; ++j) s += x[j];
          { const int tn = tt == 0 ? t + 1 : (q < 3 ? t + 15 : (gi + c.grid < ox_T / 64 ? (gi + c.grid) * 64 + 2 * wave : t)); LNR_LOAD(tn); }
          const float mean = wave_sum(s) * (1.0f / 1024.0f); float qq = 0.f;
#pragma unroll
          for (int j = 0; j < 16; ++j) { x[j] -= mean; qq += x[j] * x[j]; }
          float eps_ = md::EPS; asm volatile("" : "+v"(eps_));
          const float rstd = __builtin_amdgcn_rsqf(wave_sum(qq) * (1.0f / 1024.0f) + eps_);
          LAS float* xrow = xf + (2 * wave + tt) * XP + 4 * lane;
#pragma unroll
          for (int jq = 0; jq < 4; ++jq) { const f32x4 g4 = *(const LAS f32x4*)(gb + 4 * lane + 256 * jq), b4 = *(const LAS f32x4*)(gb + 1024 + 4 * lane + 256 * jq);
              f32x4 y; y[0] = x[4 * jq] * rstd * g4[0] + b4[0]; y[1] = x[4 * jq + 1] * rstd * g4[1] + b4[1]; y[2] = x[4 * jq + 2] * rstd * g4[2] + b4[2]; y[3] = x[4 * jq + 3] * rstd * g4[3] + b4[3];
              u32x2 w; w.x = cvt_pk_bf16(y[0], y[1]); w.y = cvt_pk_bf16(y[2], y[3]);
              *(u32x2*)(c.x1b + base + 256 * jq) = w; *(unsigned*)(c.x1q + base + 256 * jq) = pk4_fp8(y[0], y[1], y[2], y[3]);
              *(LAS f32x4*)(xrow + 256 * jq) = y; }
        }
        __syncthreads();
        {
            f32x4 acc0 = zero4(), acc1 = zero4();
            const LAS float* ap = xf + (lane & 15) * XP + 128 * wave + 4 * (lane >> 4);
#pragma unroll
            for (int s4 = 0; s4 < 8; ++s4) { const f32x4 av = *(const LAS f32x4*)(ap + 16 * s4);
#pragma unroll
                for (int i = 0; i < 4; ++i) { acc0 = __builtin_amdgcn_mfma_f32_16x16x4f32(av[i], wreg[0][4 * s4 + i], acc0, 0, 0, 0); acc1 = __builtin_amdgcn_mfma_f32_16x16x4f32(av[i], wreg[1][4 * s4 + i], acc1, 0, 0, 0); } }
            LAS float* pp = part + (wave * 16 + 4 * (lane >> 4)) * 32 + (lane & 15);
#pragma unroll
            for (int r = 0; r < 4; ++r) { pp[r * 32] = acc0[r]; pp[r * 32 + 16] = acc1[r]; }
        }
        __syncthreads();
        {
            const int tl = 2 * wave + (lane >> 5), t = gi * 64 + 16 * q + tl;
            float v1 = rbias;
#pragma unroll
            for (int w2 = 0; w2 < 8; ++w2) v1 += part[(w2 * 16 + tl) * 32 + (lane & 31)];
            float tv[4]; int ti[4]; float neg_ = -3.0e38f; asm volatile("" : "+v"(neg_));
#pragma unroll
            for (int k = 0; k < 4; ++k) {
                float m = v1;
                m = fmaxf(m, dppmov<0xB1>(m)); m = fmaxf(m, dppmov<0x4E>(m)); m = fmaxf(m, dppmov<0x141>(m)); m = fmaxf(m, dppmov<0x140>(m));
                m = (lane & 32) ? fmaxf(RDLANE_F(m, 32), RDLANE_F(m, 48)) : fmaxf(RDLANE_F(m, 0), RDLANE_F(m, 16));
                const unsigned long long mask = __ballot(v1 == m);
                const unsigned mh = (unsigned)(mask >> (lane & 32));
                const int first = __builtin_ctz(mh);
                tv[k] = m; ti[k] = first;
                if ((lane & 31) == first) v1 = neg_;
            }
            const float e1 = __expf(tv[1] - tv[0]), e2 = __expf(tv[2] - tv[0]), e3 = __expf(tv[3] - tv[0]); const float inv = __builtin_amdgcn_rcpf(1.0f + e1 + e2 + e3);
            const int kk = lane & 31;
            if (kk < 4) { const int te = kk == 0 ? ti[0] : (kk == 1 ? ti[1] : (kk == 2 ? ti[2] : ti[3]));
                const float gv = (kk == 0 ? 1.0f : (kk == 1 ? e1 : (kk == 2 ? e2 : e3))) * inv;
                c.gate[t * 4 + kk] = gv; c.topidx[t * 4 + kk] = te; atomicAdd((int*)(cnt_l + te), 1);
                ((LAS int*)(lds + 102400))[(16 * q + tl) * 4 + kk] = te; ((LAS float*)(lds + 103424))[(16 * q + tl) * 4 + kk] = gv; }
        }
      }
      __syncthreads();
      if (tid < 32) { c.moe_cnt[gi * 32 + tid] = cnt_l[tid]; __hip_atomic_store(c.cntg + gi * 32 + tid, ((unsigned long long)(unsigned)(l + 1) << 32) | (unsigned)cnt_l[tid], __ATOMIC_RELAXED, __HIP_MEMORY_SCOPE_AGENT); }
      __syncthreads();
    }
}
#undef LNR_LOAD
}
#endif
typedef const __attribute__((address_space(4))) Ctx* CtxK;
#if defined(__HIP_DEVICE_COMPILE__)
__device__ __forceinline__ const Ctx* ctx_ptr() { CtxK p = (CtxK)__builtin_amdgcn_kernarg_segment_ptr(); asm volatile("" : "+s"(p)); return (const Ctx*)p; }
#endif
#define PH(...) do { const Ctx& c = *ctx_ptr(); __VA_ARGS__ } while (0)

#define RUN(bit, ...) do { PH(__VA_ARGS__); if (REPMASK & (1u << (bit))) PH(__VA_ARGS__); } while (0)
#define LDSP ((LAS unsigned char*)lds)
#ifndef NCV
#define NCV 0
#endif

__global__ void __launch_bounds__(NTHREADS, 2) mk_forward(Ctx cparam) {
#if defined(__HIP_DEVICE_COMPILE__)
    extern __shared__ __attribute__((aligned(16))) unsigned char lds[];
    volatile LAS unsigned* bst = (volatile LAS unsigned*)((LAS unsigned char*)lds + LDS_BYTES - 16);
    if (threadIdx.x == 0) { bst[0] = 0u; bst[1] = 0u; bst[2] = 0u; bst[3] = 0u; }
    __syncthreads();
    XcdBarrier bar = xcd_barrier_post(ctx_ptr()->bar, bst);
    const long T = ox_T; const int depth = ctx_ptr()->depth;
    for (int l = -1; l < depth; ++l) {
        const int par = l & 1;
        if (l >= 0) RUN(0, prologue_weights<false, true>(c, l, par, LDSP, 0, c.grid); );
        else PH( LOOP(T * 128, cvt_x8(c.in[I_X], c.xbf, i)); const u32x4 z4 = uzero4(); LOOP(128, *(u32x4*)(c.x1b + (size_t)ox_T * 1024 + i * 8) = z4); LOOP(1, c.moe_done[320] = 0); LOOP(8192, c.cntg[i] = 0ull); LOOP(64, *(u32x4*)(c.x1q + (size_t)ox_T * 1024 + i * 16) = z4); );
        if (l + 1 < depth) { RUN(0, prologue_weights<true, false>(c, l + 1, par ^ 1, LDSP, 0, c.grid); ); RUN(0, const bool g256 = (c.grid == 256);
                                 const int pl = (g256 && l == 0) ? 0 : l + 1; s5::prologue(c, pl, pl & 1, LDSP, c.grid >= 72 ? c.grid - 72 : 0, c.grid >= 72 ? 72 : c.grid, 0, g256 ? (l == 0 ? 72 : 0) : 72); ); }
        if (l >= 0) {
            PH( __syncthreads(); );
            RUN(1, gx::Gemm g{c.xbf, c.Win_t + par * wsz::WIN, 1024, 0}; gx::StaticOrder S; S.init(ox_T, 14080, c.grid, (int)blockIdx.x);
                   EpiInproj<false, true> E{c.Gb, c.Zb, c.XBCb, c.QKVU, c.dtf, c.in[I_BGATE] + (size_t)l * 3072, c.Ug};
                   gx::gemm_phase(LDSP, g, S, E); );
        }
        SYNC();
        if (l < 0) continue;
        RUN(3, att::phase(c, LDSP); );
        RUN(4, gx::Gemm g{c.Ug, c.s5_W1 + par * wsz::S5W1, 256, (size_t)512 * 256 * 2}; s5::Order S{576, c.grid, (int)blockIdx.x, 1, 1}; s5::Epi1 E{c.s5_Yl, c.s5_Sloc}; gx::gemm_phase(LDSP, g, S, E); );
        RUN(2, ssd::phase_s1(c, l, LDSP); );
        SYNC();
        RUN(5, s5::scan(c, par, LDSP); );
        RUN(5, LOOP(T * 48, att::combine(c, i)); );
        PH( ssd::phase_s2(c); );
        SYNC();
        RUN(6, ssd::phase_s3<true>(c, l, LDSP); );
#pragma clang loop unroll(disable)
        for (int ps = 1; ps <= 2; ++ps) {
            if (ps == 2) SYNC();
            PH( gx::Gemm g{c.s5_Sin, c.s5_Q + par * wsz::S5Q, 256, (size_t)256 * 256 * 2}; s5::Order S{288, c.grid, (int)blockIdx.x, 0, 0, ps}; s5::Epi2 E{c.s5_Yl, c.Ug, c.in[I_S5D] + (size_t)l * 1152, c.s5hb, c.moe_done + 320}; gx::gemm_phase(LDSP, g, S, E); );
        }
        if (l + 1 < depth && ctx_ptr()->grid == 256) PH( s5::prologue(c, l + 1, par ^ 1, LDSP, 96, 72, 0, 72); );
        RUN(9, gx::Gemm g{c.yssdb, c.Wbs_t + par * wsz::WBS, 2048, 0}; gx::StaticOrder S; S.init(ox_T, 1024, c.grid, (int)blockIdx.x); EpiBranch<0> E{c.Gb, c.mergedb, c.ssd_ssq}; gx::gemm_phase(LDSP, g, S, E); );
        PH( gx::Gemm g{c.yattb, c.Wba_t + par * wsz::WBA, 384, 0}; gx::StaticOrder S; S.init(ox_T, 1024, c.grid, (int)blockIdx.x); EpiBranch<1> E{c.Gb, c.mergedb, nullptr}; gx::gemm_phase(LDSP, g, S, E); );
        PH( const s5::Order S2{288, c.grid, (int)blockIdx.x, 0, 0, 2}; moe_wait_rows(c.moe_done, 320, (l + 1) * S2.late_cnt() * 8); );
        RUN(8, gx::Gemm g{c.s5hb, c.Wglu_t + par * wsz::WGLU, 1152, 0}; gx::StaticOrder S; S.init(ox_T, 2304, c.grid, (int)blockIdx.x); EpiGlu E{c.ys5b}; gx::gemm_phase(LDSP, g, S, E); );
        SYNC();
        RUN(10, gx::Gemm g{c.ys5b, c.Wb5_t + par * wsz::WB5, 1152, 0}; gx::StaticOrder S; S.init(ox_T, 1024, c.grid, (int)blockIdx.x); EpiBranch<2> E{c.Gb, c.mergedb, nullptr}; gx::gemm_phase(LDSP, g, S, E); );
        SYNC();
        RUN(11, gx::Gemm g{c.mergedb, c.Wout_t + par * wsz::WOUT, 1024, 0}; gx::StaticOrder S; S.init(ox_T, 1024, c.grid, (int)blockIdx.x); EpiBf16 E{c.mixb}; gx::gemm_phase(LDSP, g, S, E); );
        SYNC();
        RUN(12, lnr::phase(c, l, LDSP); );
        if (ctx_ptr()->grid == ox_T / 64) { PH( moe_assign(c, LDSP, (unsigned)(l + 1)); ); }
        else { SYNC(); PH( moe_assign(c, LDSP, 0u); ); }
        SYNC();
        RUN(14, const int nb = moe_blocks(c, LDSP); int M, fi; moe_early(nb, c.grid, M, fi); gx::Gemm g{(const bf16_t*)c.x1q, c.Wgu_t, 512, (size_t)2048 * 1024};
                MoeOrder S{(const LAS int*)(LDSP + LDS_TAB), nb * 8, c.grid, (int)blockIdx.x, 3, 0, nb, M, fi};
                EpiSwiglu E{(unsigned char*)c.actb, c.in[I_BGU] + (size_t)l * 32 * 2048, c.moe_done}; gx::gemm_phase<EpiSwiglu, MoeOrder, true, true>(LDSP, g, S, E, c.slot_tok); );
#pragma clang loop unroll(disable)
        for (int ps = 1; ps <= 2; ++ps) {
            if (ps == 2) SYNC();
            RUN(15, const int nb = moe_blocks(c, LDSP); int M, fi; moe_early(nb, c.grid, M, fi); gx::Gemm g{c.actb, c.Wdn_t, 512, (size_t)1024 * 1024};
                    MoeOrder S{(const LAS int*)(LDSP + LDS_TAB), (nb - 8 * M) * 4, c.grid, (int)blockIdx.x, 2, ps, nb, M, fi};
                    gx::Unit u0; if (ps == 1 && S.next(0, u0)) moe_wait_rows(c.moe_done, u0.pm);
                    EpiDown E{c.ys2, c.in[I_BDN] + (size_t)l * 32 * 1024, c.slot_gate}; gx::gemm_phase<EpiDown, MoeOrder, false, true>(LDSP, g, S, E); );
        }
        SYNC();
        RUN(16, moe_combine_ln(c, c.in[I_LN2G] + l * 1024, c.in[I_LN2B] + l * 1024, (l == depth - 1) ? c.out : nullptr); );
        SYNC();
    }
#endif
}

extern "C" void kernel_launch(void* const* d_in, const int* in_sizes, int n_in, void* d_out, int out_size, void* d_ws, size_t ws_size, hipStream_t stream) {
    static int grid = 0;
    Ctx c;
    const size_t need = build_ctx(c, d_in, d_out, d_ws, 4);
    if (grid == 0) {
        if (n_in != N_INPUTS || out_size != 2 * 8192 * 1024 || ws_size < need) { fprintf(stderr, "kernel_launch: unexpected shapes (n_in %d out %d ws %zu need %zu)\n", n_in, out_size, ws_size, need); grid = -1; return; }
        int dev = 0, cus = 0, per_cu = 0;
        (void)hipGetDevice(&dev); (void)hipDeviceGetAttribute(&cus, hipDeviceAttributeMultiprocessorCount, dev);
        if (hipFuncSetAttribute((const void*)mk_forward, hipFuncAttributeMaxDynamicSharedMemorySize, LDS_BYTES) != hipSuccess) { fprintf(stderr, "kernel_launch: hipFuncSetAttribute failed\n"); grid = -1; return; }
        if (hipOccupancyMaxActiveBlocksPerMultiprocessor(&per_cu, (const void*)mk_forward, NTHREADS, LDS_BYTES) != hipSuccess || per_cu < 1) { fprintf(stderr, "kernel_launch: occupancy query says %d\n", per_cu); grid = -1; return; }
        (void)hipGetLastError();
        grid = cus;
    }
    if (grid < 0) return;
    c.grid = grid;
    (void)hipMemsetAsync(c.bar, 0, 16384, stream);
    hipLaunchKernelGGL(mk_forward, dim3(grid), dim3(NTHREADS), LDS_BYTES, stream, c);
}
```
